# Optimizing an MI355X kernel written in HIP

```python
import math
import jax, jax.numpy as jnp
from jax import lax
import numpy as np

D_MODEL = 2048
BATCH = 2
SEQ = 4096
DEPTH = 2

HEAD_DIM = 128
N_GROUPS = 4
GROUP_HEADS = (D_MODEL // HEAD_DIM) // N_GROUPS
GROUP_WIDTH = GROUP_HEADS * HEAD_DIM
MIX_WIDTH = N_GROUPS * GROUP_WIDTH
DIFF_HEADS = GROUP_HEADS
DIFF_QK_DIM = HEAD_DIM // 2
CONV_CH = GROUP_WIDTH
CONV_WIDTH = 31
GQA_Q_HEADS = GROUP_HEADS
GQA_KV_HEADS = GROUP_HEADS // 2
NA_HEADS = GROUP_HEADS
NA_KH_MAX = 8
NA_KW = 16
GRID_W = 64
Q_BLOCK = 128
ROPE_THETA = 10000.0
FFN_HIDDEN = ((8 * D_MODEL + 3 * 256 - 1) // (3 * 256)) * 256
EPS = 1e-6

SPLIT_SIZES = (
    DIFF_HEADS * 2 * DIFF_QK_DIM, DIFF_HEADS * 2 * DIFF_QK_DIM, DIFF_HEADS * HEAD_DIM,
    2 * CONV_CH,
    GQA_Q_HEADS * HEAD_DIM, GQA_KV_HEADS * HEAD_DIM, GQA_KV_HEADS * HEAD_DIM,
    NA_HEADS * HEAD_DIM, NA_HEADS * HEAD_DIM, NA_HEADS * HEAD_DIM,
)
IN_COLS = sum(SPLIT_SIZES)

kernel_name = "hybrid_parallel_heads_encoder"


def rmsnorm(x, g):
    xf = x.astype(jnp.float32)
    y = xf * lax.rsqrt(jnp.mean(xf * xf, axis=-1, keepdims=True) + EPS)
    return (y * g.astype(jnp.float32)).astype(x.dtype)


def layernorm(x, g, b):
    xf = x.astype(jnp.float32)
    mu = jnp.mean(xf, axis=-1, keepdims=True)
    var = jnp.mean(jnp.square(xf - mu), axis=-1, keepdims=True)
    y = (xf - mu) * lax.rsqrt(var + EPS)
    return (y * g.astype(jnp.float32) + b.astype(jnp.float32)).astype(x.dtype)


def rope(x, pos):
    d = x.shape[-1]
    half = d // 2
    inv = jnp.power(ROPE_THETA, -jnp.arange(0, d, 2, dtype=jnp.float32) / d)
    ang = pos[:, None] * inv[None, :]
    cos, sin = jnp.cos(ang), jnp.sin(ang)
    xf = x.astype(jnp.float32)
    x1, x2 = xf[..., :half], xf[..., half:]
    return jnp.concatenate([x1 * cos - x2 * sin, x1 * sin + x2 * cos], axis=-1).astype(x.dtype)


def axial_rope(x, row, col):
    half = x.shape[-1] // 2
    return jnp.concatenate([rope(x[..., :half], row), rope(x[..., half:], col)], axis=-1)


def diff_attention(q, k, v, lam_params, subln_g, layer_idx):
    B, S, _ = q.shape
    H, DK = DIFF_HEADS, DIFF_QK_DIM
    pos = jnp.arange(S, dtype=jnp.float32)
    q = rope(q.reshape(B, S, H, 2, DK).transpose(0, 2, 3, 1, 4), pos)
    k = rope(k.reshape(B, S, H, 2, DK).transpose(0, 2, 3, 1, 4), pos)
    v = v.reshape(B, S, H, HEAD_DIM).transpose(0, 2, 1, 3)
    lam_init = 0.8 - 0.6 * math.exp(-0.3 * layer_idx)
    lp = lam_params.astype(jnp.float32)
    lam = jnp.exp(jnp.sum(lp[0] * lp[1])) - jnp.exp(jnp.sum(lp[2] * lp[3])) + lam_init
    scale = DK ** -0.5
    nb = S // Q_BLOCK
    qb = q.reshape(B, H, 2, nb, Q_BLOCK, DK).transpose(3, 0, 1, 2, 4, 5)

    def block(qi):
        s = jnp.einsum('bhmqd,bhmkd->bhmqk', qi, k).astype(jnp.float32) * scale
        p = jax.nn.softmax(s, axis=-1)
        w = (p[:, :, 0] - lam * p[:, :, 1]).astype(v.dtype)
        return jnp.einsum('bhqk,bhkd->bhqd', w, v)

    o = lax.map(block, qb)
    o = rmsnorm(o, subln_g) * (1.0 - lam_init)
    return o.transpose(1, 0, 3, 2, 4).reshape(B, S, H * HEAD_DIM)


def conformer_conv(h, dw, dw_b, ln_g, ln_b, pw, pw_b):
    a, g = jnp.split(h, 2, axis=-1)
    u = a * jax.nn.sigmoid(g)
    pad = CONV_WIDTH // 2
    u = lax.conv_general_dilated(u, dw[:, None, :], window_strides=(1,), padding=[(pad, pad)],
                                 dimension_numbers=('NWC', 'WIO', 'NWC'),
                                 feature_group_count=CONV_CH) + dw_b
    u = jax.nn.silu(layernorm(u, ln_g, ln_b))
    return u @ pw + pw_b


def gqa_axial_attention(q, k, v, q_norm, k_norm):
    B, S, _ = q.shape
    HQ, HKV, R = GQA_Q_HEADS, GQA_KV_HEADS, GQA_Q_HEADS // GQA_KV_HEADS
    t = jnp.arange(S)
    row = (t // GRID_W).astype(jnp.float32)
    col = (t % GRID_W).astype(jnp.float32)
    q = axial_rope(rmsnorm(q.reshape(B, S, HQ, HEAD_DIM), q_norm).transpose(0, 2, 1, 3), row, col)
    k = axial_rope(rmsnorm(k.reshape(B, S, HKV, HEAD_DIM), k_norm).transpose(0, 2, 1, 3), row, col)
    v = v.reshape(B, S, HKV, HEAD_DIM).transpose(0, 2, 1, 3)
    scale = HEAD_DIM ** -0.5
    nb = S // Q_BLOCK
    qb = q.reshape(B, HKV, R, nb, Q_BLOCK, HEAD_DIM).transpose(3, 0, 1, 2, 4, 5)

    def block(qi):
        s = jnp.einsum('bgrqd,bgkd->bgrqk', qi, k).astype(jnp.float32) * scale
        p = jax.nn.softmax(s, axis=-1).astype(v.dtype)
        return jnp.einsum('bgrqk,bgkd->bgrqd', p, v)

    o = lax.map(block, qb)
    return o.transpose(1, 0, 4, 2, 3, 5).reshape(B, S, HQ * HEAD_DIM)


def neighbourhood_attention(q, k, v, rpb):
    B, S, _ = q.shape
    H = NA_HEADS
    rows = S // GRID_W
    kh = min(NA_KH_MAX, rows)
    kw = min(NA_KW, GRID_W)
    qr_blk = Q_BLOCK // GRID_W
    nb = S // Q_BLOCK
    band = min(kh + qr_blk - 1, rows)
    q = q.reshape(B, S, H, HEAD_DIM).transpose(0, 2, 1, 3).reshape(B, H, nb, Q_BLOCK, HEAD_DIM)
    k = k.reshape(B, S, H, HEAD_DIM).transpose(0, 2, 1, 3).reshape(B, H, rows, GRID_W, HEAD_DIM)
    v = v.reshape(B, S, H, HEAD_DIM).transpose(0, 2, 1, 3).reshape(B, H, rows, GRID_W, HEAD_DIM)
    blk = jnp.arange(nb)
    band_start = jnp.clip(blk * qr_blk - kh // 2, 0, rows - band)
    key_rows = band_start[:, None] + jnp.arange(band)
    kb = k[:, :, key_rows].reshape(B, H, nb, band * GRID_W, HEAD_DIM)
    vb = v[:, :, key_rows].reshape(B, H, nb, band * GRID_W, HEAD_DIM)
    q_local = jnp.arange(Q_BLOCK)
    q_row = blk[:, None] * qr_blk + (q_local // GRID_W)[None, :]
    q_col = jnp.broadcast_to((q_local % GRID_W)[None, :], (nb, Q_BLOCK))
    k_row = jnp.repeat(key_rows, GRID_W, axis=1)[:, None, :]
    k_col = jnp.tile(jnp.arange(GRID_W), band)[None, None, :]
    win_r = jnp.clip(q_row - kh // 2, 0, rows - kh)[:, :, None]
    win_c = jnp.clip(q_col - kw // 2, 0, GRID_W - kw)[:, :, None]
    mask = (k_row >= win_r) & (k_row < win_r + kh) & (k_col >= win_c) & (k_col < win_c + kw)
    ir = jnp.clip(k_row - q_row[:, :, None] + NA_KH_MAX - 1, 0, 2 * NA_KH_MAX - 2)
    ic = jnp.clip(k_col - q_col[:, :, None] + NA_KW - 1, 0, 2 * NA_KW - 2)
    bias = rpb[:, ir, ic].astype(jnp.float32)
    s = jnp.einsum('bhnqd,bhnkd->bhnqk', q, kb).astype(jnp.float32) * (HEAD_DIM ** -0.5) + bias[None]
    s = jnp.where(mask[None, None], s, -1e30)
    p = jax.nn.softmax(s, axis=-1).astype(vb.dtype)
    o = jnp.einsum('bhnqk,bhnkd->bhnqd', p, vb)
    return o.transpose(0, 2, 3, 1, 4).reshape(B, S, H * HEAD_DIM)


def setup_inputs(seed: int = 0) -> dict:
    key = jax.random.key(seed)
    ks = jax.random.split(key, 24)
    L, D, F = DEPTH, D_MODEL, FFN_HIDDEN
    f32 = jnp.float32

    def nrm(k, shape, scale):
        return jax.random.normal(k, shape, f32) * scale

    def gain(k, shape):
        return 1.0 + 0.05 * jax.random.normal(k, shape, f32)

    return {
        "x": nrm(ks[0], (BATCH, SEQ, D), 1.0),
        "norm_mix_pre": gain(ks[1], (L, D)),
        "norm_mix_post": gain(ks[2], (L, D)),
        "norm_ffn_pre": gain(ks[3], (L, D)),
        "norm_ffn_post": gain(ks[4], (L, D)),
        "w_in": nrm(ks[5], (L, D, IN_COLS), D ** -0.5),
        "w_out": nrm(ks[6], (L, MIX_WIDTH, D), MIX_WIDTH ** -0.5),
        "diff_lambda": nrm(ks[7], (L, 4, DIFF_QK_DIM), 0.1),
        "diff_subln": gain(ks[8], (L, HEAD_DIM)),
        "conv_dw": nrm(ks[9], (L, CONV_WIDTH, CONV_CH), CONV_WIDTH ** -0.5),
        "conv_dw_b": nrm(ks[10], (L, CONV_CH), 0.02),
        "conv_ln_g": gain(ks[11], (L, CONV_CH)),
        "conv_ln_b": nrm(ks[12], (L, CONV_CH), 0.02),
        "conv_pw": nrm(ks[13], (L, CONV_CH, CONV_CH), CONV_CH ** -0.5),
        "conv_pw_b": nrm(ks[14], (L, CONV_CH), 0.02),
        "gqa_q_norm": gain(ks[15], (L, HEAD_DIM)),
        "gqa_k_norm": gain(ks[16], (L, HEAD_DIM)),
        "na_rpb": nrm(ks[17], (L, NA_HEADS, 2 * NA_KH_MAX - 1, 2 * NA_KW - 1), 0.1),
        "ffn_gate": nrm(ks[18], (L, D, F), D ** -0.5),
        "ffn_up": nrm(ks[19], (L, D, F), D ** -0.5),
        "ffn_down": nrm(ks[20], (L, F, D), F ** -0.5),
    }


def reference(x, norm_mix_pre, norm_mix_post, norm_ffn_pre, norm_ffn_post, w_in, w_out,
              diff_lambda, diff_subln, conv_dw, conv_dw_b, conv_ln_g, conv_ln_b, conv_pw,
              conv_pw_b, gqa_q_norm, gqa_k_norm, na_rpb, ffn_gate, ffn_up, ffn_down):
    split_at = np.cumsum(SPLIT_SIZES)[:-1].tolist()
    for l in range(DEPTH):
        h = rmsnorm(x, norm_mix_pre[l])
        proj = h @ w_in[l]
        a_q, a_k, a_v, b_glu, c_q, c_k, c_v, d_q, d_k, d_v = jnp.split(proj, split_at, axis=-1)
        out_a = diff_attention(a_q, a_k, a_v, diff_lambda[l], diff_subln[l], l)
        out_b = conformer_conv(b_glu, conv_dw[l], conv_dw_b[l], conv_ln_g[l], conv_ln_b[l],
                               conv_pw[l], conv_pw_b[l])
        out_c = gqa_axial_attention(c_q, c_k, c_v, gqa_q_norm[l], gqa_k_norm[l])
        out_d = neighbourhood_attention(d_q, d_k, d_v, na_rpb[l])
        mixed = jnp.concatenate([out_a, out_b, out_c, out_d], axis=-1) @ w_out[l]
        x = x + rmsnorm(mixed, norm_mix_post[l])
        h = rmsnorm(x, norm_ffn_pre[l])
        f = (jax.nn.silu(h @ ffn_gate[l]) * (h @ ffn_up[l])) @ ffn_down[l]
        x = x + rmsnorm(f, norm_ffn_post[l])
    return x
```

```cpp
#include <hip/hip_runtime.h>
#include <hip/hip_cooperative_groups.h>
#include <cstdio>
#include <cstdint>
namespace cg = cooperative_groups;
__device__ __forceinline__ int opaque_tid() { int t = threadIdx.x; asm volatile("" : "+v"(t)); return t; }
namespace pg8 {
#define PG8_LAS __attribute__((address_space(3)))
typedef unsigned short bf16_t;
typedef short bf16x8 __attribute__((ext_vector_type(8)));
typedef float f32x4 __attribute__((ext_vector_type(4)));
typedef unsigned u32x4 __attribute__((ext_vector_type(4)));
constexpr int BM = 256, BK = 64, HALF = 128, HTB = HALF * BK * 2  , STAGE_BYTES = 8 * HTB, NXCD = 8, WGM = 8;

__host__ __device__ __forceinline__ int lds_byte(int r, int c) { const int st = (r >> 4) * 2 + (c >> 5), rr = r & 15, cc = c & 31, ob = rr * 64 + cc * 2; return st * 1024 + (ob ^ (((ob >> 9) & 1) << 5)); }
__host__ __device__ __forceinline__ void stage_rc(int b, int& R, int& C) { const int st = b / 1024, sb = b % 1024, swz = sb ^ (((sb >> 9) & 1) << 5); R = (st >> 1) * 16 + swz / 64; C = (st & 1) * 32 + (swz % 64) / 2; }
__host__ __device__ __forceinline__ int perm32(int rho) { const int n = rho >> 4, i = rho & 15; return 8 * (i >> 2) + 4 * n + (i & 3); }

struct Unit { int pm, pn; };
struct Gemm { const bf16_t* A; const bf16_t* Bt; int M, N, K; };

struct StaticOrder {
    int nM, nN, nwg, G, c;
    __host__ __device__ void init(int M, int N, int G_, int c_) { nM = M / BM; nN = N / BM; nwg = nM * nN; G = G_; c = c_; }
    __host__ __device__ bool next(int i, Unit& u) const {
        const long L = (long)i * G + c; if (L >= nwg) return false;
        int wgid = (int)L; { const int q = nwg / NXCD, r = nwg % NXCD, xcd = wgid % NXCD, off = wgid / NXCD; wgid = (xcd < r ? xcd * (q + 1) : r * (q + 1) + (xcd - r) * q) + off; }
        const int nig = WGM * nN, gid = wgid / nig, fm = gid * WGM, gsz = (nM - fm) < WGM ? (nM - fm) : WGM;
        u.pm = fm + ((wgid % nig) % gsz); u.pn = (wgid % nig) / gsz; return true;
    }
    __device__ __forceinline__ void a_ready(const Unit&) const {}
    __device__ __forceinline__ void done(const Unit&) const {}
};

__device__ __forceinline__ unsigned cvt_pk_bf16(float lo, float hi) { unsigned r; asm volatile("v_cvt_pk_bf16_f32 %0, %1, %2" : "=v"(r) : "v"(lo), "v"(hi)); return r; }
typedef float f32x2 __attribute__((ext_vector_type(2)));
__device__ __forceinline__ f32x2 gelu_pk(f32x2 v) {
    const f32x2 av = __builtin_elementwise_abs(v), d = av * 0.2316418882f + 1.0f;
    f32x2 t; t.x = __builtin_amdgcn_rcpf(d.x); t.y = __builtin_amdgcn_rcpf(d.y);
    f32x2 q = t * 0.5307027145f + (-0.7265760135f); q = q * t + 0.7107068705f; q = q * t + (-0.142248368f); q = q * t + 0.127414796f; q = q * t;
    const f32x2 s = (v * v) * (-0.72134752044f);
    f32x2 e; e.x = __builtin_amdgcn_exp2f(s.x); e.y = __builtin_amdgcn_exp2f(s.y);
    const f32x2 m = v * (q * e), r = v - m;
    f32x2 o; o.x = v.x < 0.f ? m.x : r.x; o.y = v.y < 0.f ? m.y : r.y; return o;
}

template <int ACT  > struct EpiBf16 {
    static constexpr bool PERM = true, AFTER_DRAIN = false; static_assert(ACT == 0 || ACT == 1, "EpiBf16: ACT is 0 (none) or 1 (gelu_pk)");
    bf16_t* O; int ldc; const float* bias; int split_cols; size_t split_stride; float scale0;
    __device__ __forceinline__ void operator()(const f32x4 (&acc)[2][2][4][2], const Unit& u, int wr, int wc, int fr, int fq) const {
        const int row0 = u.pm * BM + wr * 64 + fr; int colt = u.pn * BM; bf16_t* base = O;
        float sc = 1.f; if (split_cols) { const int t = colt / split_cols; base += (size_t)t * split_stride; colt -= t * split_cols; if (t == 0) sc = scale0; }
        const int col0 = colt + wc * 32 + 8 * fq, bcol0 = u.pn * BM + wc * 32 + 8 * fq;
        f32x4 bv[2][2];
#pragma unroll
        for (int bj = 0; bj < 2; ++bj)
#pragma unroll
            for (int n = 0; n < 2; ++n) bv[bj][n] = bias ? *(const f32x4*)(bias + bcol0 + bj * HALF + 4 * n) : (f32x4){0.f, 0.f, 0.f, 0.f};
#pragma unroll
        for (int ai = 0; ai < 2; ++ai)
#pragma unroll
            for (int m = 0; m < 4; ++m) { bf16_t* rowp = base + (size_t)(row0 + ai * HALF + m * 16) * ldc + col0;
#pragma unroll
                for (int bj = 0; bj < 2; ++bj) { f32x4 v0 = acc[ai][bj][m][0] + bv[bj][0], v1 = acc[ai][bj][m][1] + bv[bj][1];
                    if (ACT == 1) { f32x2 a = gelu_pk((f32x2){v0[0], v0[1]}), b = gelu_pk((f32x2){v0[2], v0[3]}), c = gelu_pk((f32x2){v1[0], v1[1]}), d = gelu_pk((f32x2){v1[2], v1[3]});
                        v0 = (f32x4){a.x, a.y, b.x, b.y}; v1 = (f32x4){c.x, c.y, d.x, d.y}; }
                    v0 = v0 * sc; v1 = v1 * sc; u32x4 w; w.x = cvt_pk_bf16(v0[0], v0[1]); w.y = cvt_pk_bf16(v0[2], v0[3]); w.z = cvt_pk_bf16(v1[0], v1[1]); w.w = cvt_pk_bf16(v1[2], v1[3]);
                    *(u32x4*)(rowp + bj * HALF) = w; } }
    }
};
struct EpiF32 {
    static constexpr bool PERM = false, AFTER_DRAIN = false;
    float* O; int ldc;
    __device__ __forceinline__ void operator()(const f32x4 (&acc)[2][2][4][2], const Unit& u, int wr, int wc, int fr, int fq) const {
        const int row0 = u.pm * BM + wr * 64 + fr, col0 = u.pn * BM + wc * 32 + 4 * fq;
#pragma unroll
        for (int ai = 0; ai < 2; ++ai)
#pragma unroll
            for (int m = 0; m < 4; ++m) { float* rowp = O + (size_t)(row0 + ai * HALF + m * 16) * ldc + col0;
#pragma unroll
                for (int bj = 0; bj < 2; ++bj)
#pragma unroll
                    for (int n = 0; n < 2; ++n) *(f32x4*)(rowp + bj * HALF + n * 16) = acc[ai][bj][m][n]; }
    }
};
__device__ __forceinline__ float swiglu1(float g, float u) { return g * u * __builtin_amdgcn_rcpf(1.0f + __expf(-g)); }
struct EpiSwiGLU {
    static constexpr bool PERM = true, AFTER_DRAIN = false;
    bf16_t* O; int ldc;
    __device__ __forceinline__ void operator()(const f32x4 (&acc)[2][2][4][2], const Unit& u, int wr, int wc, int fr, int fq) const {
        const int row0 = u.pm * BM + wr * 64 + fr, col0 = u.pn * HALF + wc * 32 + 8 * fq;
#pragma unroll
        for (int ai = 0; ai < 2; ++ai)
#pragma unroll
            for (int m = 0; m < 4; ++m) { bf16_t* rowp = O + (size_t)(row0 + ai * HALF + m * 16) * ldc + col0;
                const f32x4 g0 = acc[ai][0][m][0], g1 = acc[ai][0][m][1], u0 = acc[ai][1][m][0], u1 = acc[ai][1][m][1];
                u32x4 w; w.x = cvt_pk_bf16(swiglu1(g0[0], u0[0]), swiglu1(g0[1], u0[1])); w.y = cvt_pk_bf16(swiglu1(g0[2], u0[2]), swiglu1(g0[3], u0[3]));
                w.z = cvt_pk_bf16(swiglu1(g1[0], u1[0]), swiglu1(g1[1], u1[1])); w.w = cvt_pk_bf16(swiglu1(g1[2], u1[2]), swiglu1(g1[3], u1[3]));
                *(u32x4*)rowp = w; }
    }
};

struct PanelSS {
    unsigned* xbuf;
    unsigned* cnt;
    float inv_n, eps;
    __device__ __forceinline__ void run(const f32x4 (&v)[2][2][4][2], const Unit& u, int wr, int wc, int fr, int fq, PG8_LAS unsigned char* lds, int wid, int lane) const {
        PG8_LAS float* P = (PG8_LAS float*)lds;
        PG8_LAS float* S = (PG8_LAS float*)(lds + 4096);
#pragma unroll
        for (int ai = 0; ai < 2; ++ai)
#pragma unroll
            for (int m = 0; m < 4; ++m) {
                float q = 0.f;
#pragma unroll
                for (int bj = 0; bj < 2; ++bj)
#pragma unroll
                    for (int n = 0; n < 2; ++n) { const f32x4 x = v[ai][bj][m][n]; q += (x[0] * x[0] + x[1] * x[1]) + (x[2] * x[2] + x[3] * x[3]); }
                q += __shfl_xor(q, 16); q += __shfl_xor(q, 32);
                if (fq == 0) P[(ai * HALF + wr * 64 + m * 16 + fr) * 4 + wc] = q;
            }
        asm volatile("s_waitcnt lgkmcnt(0)" ::: "memory"); __builtin_amdgcn_s_barrier(); asm volatile("" ::: "memory");
        const int row = wid * 32 + (lane & 31);
        unsigned* slot = xbuf + ((size_t)(u.pm * BM + row) * 8);
        if (lane < 32) { const float q = (P[row * 4 + 0] + P[row * 4 + 1]) + (P[row * 4 + 2] + P[row * 4 + 3]);
            __hip_atomic_store(slot + u.pn, __float_as_uint(q), __ATOMIC_RELAXED, __HIP_MEMORY_SCOPE_AGENT); }
        asm volatile("s_waitcnt vmcnt(0)" ::: "memory");
        if (lane == 0) __hip_atomic_fetch_add(cnt + 64 * u.pm, 1u, __ATOMIC_RELAXED, __HIP_MEMORY_SCOPE_AGENT);
        if (wid == 0) {
            unsigned sp = 0;
            while ((unsigned)__builtin_amdgcn_readfirstlane(__hip_atomic_load(cnt + 64 * u.pm, __ATOMIC_RELAXED, __HIP_MEMORY_SCOPE_AGENT)) < 64u) { __builtin_amdgcn_s_sleep(2); if (++sp > (1u << 22)) break; }
            __builtin_amdgcn_fence(__ATOMIC_ACQUIRE, "agent");
        }
        asm volatile("s_waitcnt vmcnt(0) lgkmcnt(0)" ::: "memory"); __builtin_amdgcn_s_barrier(); asm volatile("" ::: "memory");
        if (lane < 32) { float q = 0.f;
#pragma unroll
            for (int t = 0; t < 8; ++t) q += __uint_as_float(__hip_atomic_load(slot + t, __ATOMIC_RELAXED, __HIP_MEMORY_SCOPE_AGENT));
            S[row] = 1.0f / sqrtf(q * inv_n + eps); }
        asm volatile("s_waitcnt lgkmcnt(0)" ::: "memory"); __builtin_amdgcn_s_barrier(); asm volatile("" ::: "memory");
    }
};
struct EpiRmsResRms {
    static constexpr bool PERM = false, AFTER_DRAIN = true;
    const float* base; float* out; bf16_t* xn; int ldc; const float* g1; const float* g2; PanelSS st1, st2;
    __device__ __forceinline__ void operator()(const f32x4 (&)[2][2][4][2], const Unit&, int, int, int, int) const {}
    __device__ __forceinline__ void fused(f32x4 (&acc)[2][2][4][2], const Unit& u, int wr, int wc, int fr, int fq, PG8_LAS unsigned char* lds, int wid, int lane) const {
        typedef unsigned u32x2v __attribute__((ext_vector_type(2)));
        const PG8_LAS float* S = (const PG8_LAS float*)(lds + 4096);
        const int col0 = u.pn * BM + wc * 32 + 4 * fq;
        st1.run(acc, u, wr, wc, fr, fq, lds, wid, lane);
        {
            f32x4 gv[2][2];
#pragma unroll
            for (int bj = 0; bj < 2; ++bj)
#pragma unroll
                for (int n = 0; n < 2; ++n) gv[bj][n] = *(const f32x4*)(g1 + col0 + bj * HALF + n * 16);
#pragma unroll
            for (int ai = 0; ai < 2; ++ai)
#pragma unroll
                for (int m = 0; m < 4; ++m) { const int r = ai * HALF + wr * 64 + m * 16 + fr; const float sr = S[r]; const size_t off = (size_t)(u.pm * BM + r) * ldc + col0;
#pragma unroll
                    for (int bj = 0; bj < 2; ++bj)
#pragma unroll
                        for (int n = 0; n < 2; ++n) { const f32x4 bs = *(const f32x4*)(base + off + bj * HALF + n * 16); acc[ai][bj][m][n] = bs + acc[ai][bj][m][n] * sr * gv[bj][n]; }
                    asm volatile("" : "+v"(acc[ai][0][m][0]), "+v"(acc[ai][0][m][1]), "+v"(acc[ai][1][m][0]), "+v"(acc[ai][1][m][1]));
                    if (m & 1) asm volatile("" ::: "memory"); }
        }
        if (g2) {
            st2.run(acc, u, wr, wc, fr, fq, lds, wid, lane);
            f32x4 gv[2][2];
#pragma unroll
            for (int bj = 0; bj < 2; ++bj)
#pragma unroll
                for (int n = 0; n < 2; ++n) gv[bj][n] = *(const f32x4*)(g2 + col0 + bj * HALF + n * 16);
#pragma unroll
            for (int ai = 0; ai < 2; ++ai)
#pragma unroll
                for (int m = 0; m < 4; ++m) { const int r = ai * HALF + wr * 64 + m * 16 + fr; const float sr = S[r]; const size_t off = (size_t)(u.pm * BM + r) * ldc + col0;
#pragma unroll
                    for (int bj = 0; bj < 2; ++bj)
#pragma unroll
                        for (int n = 0; n < 2; ++n) { const f32x4 x1 = acc[ai][bj][m][n]; *(f32x4*)(out + off + bj * HALF + n * 16) = x1;
                            const f32x4 o = x1 * sr * gv[bj][n]; u32x2v w; w.x = cvt_pk_bf16(o[0], o[1]); w.y = cvt_pk_bf16(o[2], o[3]);
                            *(u32x2v*)(xn + off + bj * HALF + n * 16) = w; }
                    asm volatile("" ::: "memory"); }
        } else {
#pragma unroll
            for (int ai = 0; ai < 2; ++ai)
#pragma unroll
                for (int m = 0; m < 4; ++m) { const int r = ai * HALF + wr * 64 + m * 16 + fr; const size_t off = (size_t)(u.pm * BM + r) * ldc + col0;
#pragma unroll
                    for (int bj = 0; bj < 2; ++bj)
#pragma unroll
                        for (int n = 0; n < 2; ++n) *(f32x4*)(out + off + bj * HALF + n * 16) = acc[ai][bj][m][n]; }
        }
    }
};

__device__ __forceinline__ float bflo(unsigned w) { return __builtin_bit_cast(float, w << 16); }
__device__ __forceinline__ float bfhi(unsigned w) { return __builtin_bit_cast(float, w & 0xffff0000u); }
struct EpiRmsFused {
    static constexpr bool PERM = true, AFTER_DRAIN = true;
    const bf16_t* base_b;
    float* out_f; bf16_t* out_b;
    bf16_t* xn; const float* g1; const float* g2;
    unsigned long long* xbuf;
    unsigned* cnt;
    __device__ __forceinline__ void operator()(const f32x4 (&)[2][2][4][2], const Unit&, int, int, int, int) const {}
    __device__ __forceinline__ void fused(f32x4 (&acc)[2][2][4][2], const Unit& u, int wr, int wc, int fr, int fq, PG8_LAS unsigned char* lds, int wid, int lane) const {
        typedef unsigned u32x2v __attribute__((ext_vector_type(2)));
        constexpr int ldc = 2048; constexpr float inv_n = 1.0f / 2048.0f, eps = 1e-6f;
        PG8_LAS f32x4* P = (PG8_LAS f32x4*)(lds + 131072);
        PG8_LAS float* S = (PG8_LAS float*)(lds + 131072 + 16384);
        const int col0 = u.pn * BM + wc * 32 + 8 * fq;
        f32x4 gv[2][2];
#pragma unroll
        for (int bj = 0; bj < 2; ++bj)
#pragma unroll
            for (int n = 0; n < 2; ++n) gv[bj][n] = *(const f32x4*)(g1 + col0 + bj * HALF + n * 4);
        PG8_LAS u32x4* XL = (PG8_LAS u32x4*)lds + (wid * 64 + lane);
#pragma unroll
        for (int ai = 0; ai < 2; ++ai)
#pragma unroll
            for (int m = 0; m < 4; ++m) { const size_t off = (size_t)(u.pm * BM + ai * HALF + wr * 64 + m * 16 + fr) * ldc + col0;
#pragma unroll
                for (int bj = 0; bj < 2; ++bj) XL[((ai * 4 + m) * 2 + bj) * 512] = *(const u32x4*)(base_b + off + bj * HALF); }
#pragma unroll
        for (int ai = 0; ai < 2; ++ai)
#pragma unroll
            for (int m = 0; m < 4; ++m) {
                float saa = 0.f, sxx = 0.f, sxag = 0.f, sgg = 0.f;
#pragma unroll
                for (int bj = 0; bj < 2; ++bj) { const u32x4 w4 = XL[((ai * 4 + m) * 2 + bj) * 512];
#pragma unroll
                    for (int n = 0; n < 2; ++n) { const f32x4 a = acc[ai][bj][m][n]; const f32x4 ag = a * gv[bj][n]; const unsigned wx = n == 0 ? w4.x : w4.z, wy = n == 0 ? w4.y : w4.w;
                        const f32x4 x = (f32x4){bflo(wx), bfhi(wx), bflo(wy), bfhi(wy)};
                        saa += (a[0] * a[0] + a[1] * a[1]) + (a[2] * a[2] + a[3] * a[3]); sxx += (x[0] * x[0] + x[1] * x[1]) + (x[2] * x[2] + x[3] * x[3]);
                        sxag += (x[0] * ag[0] + x[1] * ag[1]) + (x[2] * ag[2] + x[3] * ag[3]); sgg += (ag[0] * ag[0] + ag[1] * ag[1]) + (ag[2] * ag[2] + ag[3] * ag[3]); } }
                asm volatile("" : "+v"(saa), "+v"(sxx), "+v"(sxag), "+v"(sgg));
                saa += __shfl_xor(saa, 16); sxx += __shfl_xor(sxx, 16); sxag += __shfl_xor(sxag, 16); sgg += __shfl_xor(sgg, 16);
                saa += __shfl_xor(saa, 32); sxx += __shfl_xor(sxx, 32); sxag += __shfl_xor(sxag, 32); sgg += __shfl_xor(sgg, 32);
                if (fq == 0) P[(ai * HALF + wr * 64 + m * 16 + fr) * 4 + wc] = (f32x4){saa, sxx, sxag, sgg};
                __builtin_amdgcn_sched_barrier(0);
            }
        asm volatile("s_waitcnt lgkmcnt(0)" ::: "memory"); __builtin_amdgcn_s_barrier(); asm volatile("" ::: "memory");
        const int row = wid * 32 + (lane & 31);
        unsigned long long* slot = xbuf + ((size_t)(u.pm * BM + row) * 8) * 2;
        if (lane < 32) { const f32x4 q = (P[row * 4 + 0] + P[row * 4 + 1]) + (P[row * 4 + 2] + P[row * 4 + 3]);
            __hip_atomic_store(slot + u.pn * 2, ((unsigned long long)__float_as_uint(q[1]) << 32) | __float_as_uint(q[0]), __ATOMIC_RELAXED, __HIP_MEMORY_SCOPE_AGENT);
            __hip_atomic_store(slot + u.pn * 2 + 1, ((unsigned long long)__float_as_uint(q[3]) << 32) | __float_as_uint(q[2]), __ATOMIC_RELAXED, __HIP_MEMORY_SCOPE_AGENT); }
        asm volatile("s_waitcnt vmcnt(0)" ::: "memory"); __builtin_amdgcn_s_barrier(); asm volatile("" ::: "memory");
        if (wid == 0) {
            if (lane == 0) __hip_atomic_fetch_add(cnt + 64 * u.pm, 1u, __ATOMIC_RELAXED, __HIP_MEMORY_SCOPE_AGENT);
            unsigned sp = 0;
            while ((unsigned)__builtin_amdgcn_readfirstlane(__hip_atomic_load(cnt + 64 * u.pm, __ATOMIC_RELAXED, __HIP_MEMORY_SCOPE_AGENT)) < 8u) { __builtin_amdgcn_s_sleep(1); if (++sp > (1u << 22)) break; }
            __builtin_amdgcn_fence(__ATOMIC_ACQUIRE, "agent");
        }
        asm volatile("s_waitcnt vmcnt(0) lgkmcnt(0)" ::: "memory"); __builtin_amdgcn_s_barrier(); asm volatile("" ::: "memory");
        if (lane < 32) { float saa = 0.f, sxx = 0.f, sxag = 0.f, sgg = 0.f;
#pragma unroll
            for (int t = 0; t < 8; ++t) { const unsigned long long w0 = __hip_atomic_load(slot + t * 2, __ATOMIC_RELAXED, __HIP_MEMORY_SCOPE_AGENT), w1 = __hip_atomic_load(slot + t * 2 + 1, __ATOMIC_RELAXED, __HIP_MEMORY_SCOPE_AGENT);
                saa += __uint_as_float((unsigned)w0); sxx += __uint_as_float((unsigned)(w0 >> 32)); sxag += __uint_as_float((unsigned)w1); sgg += __uint_as_float((unsigned)(w1 >> 32)); }
            const float r1 = 1.0f / sqrtf(saa * inv_n + eps);
            float s1 = sxx + 2.0f * r1 * sxag + r1 * r1 * sgg; s1 = s1 < 0.f ? 0.f : s1;
            S[row * 2] = r1; S[row * 2 + 1] = 1.0f / sqrtf(s1 * inv_n + eps); }
        asm volatile("s_waitcnt lgkmcnt(0)" ::: "memory"); __builtin_amdgcn_s_barrier(); asm volatile("" ::: "memory");
        int fr2 = fr, col2 = col0; asm volatile("" : "+v"(fr2), "+v"(col2));
        f32x4 g2v[2][2], g1v[2][2];
#pragma unroll
        for (int bj = 0; bj < 2; ++bj)
#pragma unroll
            for (int n = 0; n < 2; ++n) { g2v[bj][n] = g2 ? *(const f32x4*)(g2 + col2 + bj * HALF + n * 4) : (f32x4){0.f, 0.f, 0.f, 0.f}; g1v[bj][n] = *(const f32x4*)(g1 + col2 + bj * HALF + n * 4); }
#pragma unroll
        for (int ai = 0; ai < 2; ++ai)
#pragma unroll
            for (int m = 0; m < 4; ++m) { const int r = ai * HALF + wr * 64 + m * 16 + fr2; const float r1 = S[r * 2], r2 = S[r * 2 + 1]; const size_t off = (size_t)(u.pm * BM + r) * ldc + col2;
#pragma unroll
                for (int bj = 0; bj < 2; ++bj) { u32x4 w4 = XL[((ai * 4 + m) * 2 + bj) * 512]; asm volatile("" : "+v"(w4.x), "+v"(w4.y), "+v"(w4.z), "+v"(w4.w));
                    const f32x4 xa = (f32x4){bflo(w4.x), bfhi(w4.x), bflo(w4.y), bfhi(w4.y)}, xb = (f32x4){bflo(w4.z), bfhi(w4.z), bflo(w4.w), bfhi(w4.w)};
                    const f32x4 x1a = xa + acc[ai][bj][m][0] * r1 * g1v[bj][0], x1b = xb + acc[ai][bj][m][1] * r1 * g1v[bj][1];
                    if (out_f) { *(f32x4*)(out_f + off + bj * HALF) = x1a; *(f32x4*)(out_f + off + bj * HALF + 4) = x1b; }
                    else { u32x4 o; o.x = cvt_pk_bf16(x1a[0], x1a[1]); o.y = cvt_pk_bf16(x1a[2], x1a[3]); o.z = cvt_pk_bf16(x1b[0], x1b[1]); o.w = cvt_pk_bf16(x1b[2], x1b[3]); *(u32x4*)(out_b + off + bj * HALF) = o; }
                    if (g2) { const f32x4 ya = x1a * r2 * g2v[bj][0], yb = x1b * r2 * g2v[bj][1]; u32x4 o; o.x = cvt_pk_bf16(ya[0], ya[1]); o.y = cvt_pk_bf16(ya[2], ya[3]); o.z = cvt_pk_bf16(yb[0], yb[1]); o.w = cvt_pk_bf16(yb[2], yb[3]);
                        *(u32x4*)(xn + off + bj * HALF) = o; } }
                asm volatile("" ::: "memory"); __builtin_amdgcn_sched_barrier(0); }
    }
};

struct EpiProj {
    static constexpr bool PERM = true, AFTER_DRAIN = false;
    bf16_t* O; int ldc; const float* rope; const float* qn; const float* kn; PG8_LAS float* X;
    __device__ __forceinline__ void operator()(const f32x4 (&acc)[2][2][4][2], const Unit& u, int wr, int wc, int fr_, int fq_) const {
        int fr = fr_, fq = fq_; asm volatile("" : "+v"(fr), "+v"(fq));
        const int pn = u.pn, kind = pn < 4 ? 1 : ((pn >= 10 && pn <= 12) ? 2 : 0);
        if (kind == 0) {
            const int row0 = u.pm * BM + wr * 64 + fr, col0 = pn * BM + wc * 32 + 8 * fq;
#pragma unroll
            for (int ai = 0; ai < 2; ++ai)
#pragma unroll
                for (int m = 0; m < 4; ++m) { bf16_t* rowp = O + (size_t)(row0 + ai * HALF + m * 16) * ldc + col0;
#pragma unroll
                    for (int bj = 0; bj < 2; ++bj) { const f32x4 v0 = acc[ai][bj][m][0], v1 = acc[ai][bj][m][1];
                        u32x4 w; w.x = cvt_pk_bf16(v0[0], v0[1]); w.y = cvt_pk_bf16(v0[2], v0[3]); w.z = cvt_pk_bf16(v1[0], v1[1]); w.w = cvt_pk_bf16(v1[2], v1[3]);
                        *(u32x4*)(rowp + bj * HALF) = w; } }
            return;
        }
        const int i0 = 8 * fq, c1 = pn * BM + 64 * wc + i0;
        float frev[8];
#pragma unroll
        for (int k = 0; k < 8; ++k) { constexpr float FK[8] = {0.15915494309189535f, 0.11934937021124886f, 0.08949940160889104f, 0.06711508300522727f, 0.05032921210448705f, 0.037741584717419785f, 0.02830219583062341f, 0.02122365276477767f};
            frev[k] = FK[k] * (fq == 0 ? 1.0f : (fq == 1 ? 0.1f : (fq == 2 ? 0.01f : 0.001f))); }
        f32x4 ga[2], gb[2];
        if (kind == 2) { const float* gn = (pn == 12 ? kn : qn) + 64 * (wc & 1) + i0;
            ga[0] = *(const f32x4*)gn; ga[1] = *(const f32x4*)(gn + 4); gb[0] = *(const f32x4*)(gn + 32); gb[1] = *(const f32x4*)(gn + 36);
#pragma unroll
            for (int ai = 0; ai < 2; ++ai)
#pragma unroll
                for (int m = 0; m < 4; ++m) { float q = 0.f;
#pragma unroll
                    for (int bj = 0; bj < 2; ++bj)
#pragma unroll
                        for (int n = 0; n < 2; ++n) { const f32x4 x = acc[ai][bj][m][n]; q += (x[0] * x[0] + x[1] * x[1]) + (x[2] * x[2] + x[3] * x[3]); }
                    q += __shfl_xor(q, 16); q += __shfl_xor(q, 32);
                    if (fq == 0) X[(ai * HALF + wr * 64 + m * 16 + fr) * 4 + wc] = q; }
            asm volatile("s_waitcnt lgkmcnt(0)" ::: "memory"); __builtin_amdgcn_s_barrier(); asm volatile("" ::: "memory");
        } else { ga[0] = ga[1] = gb[0] = gb[1] = (f32x4){1.f, 1.f, 1.f, 1.f}; }
#pragma unroll
        for (int ai = 0; ai < 2; ++ai)
#pragma unroll
            for (int m = 0; m < 4; ++m) { const int r = ai * HALF + wr * 64 + m * 16 + fr, row = u.pm * BM + r, t = row & 4095;
                const int pos = kind == 1 ? t : ((wc & 1) ? (t & 63) : (t >> 6));
                const float fpos = (float)pos;
                float rs = 1.f;
                if (kind == 2) rs = 1.0f / sqrtf((X[r * 4 + wc] + X[r * 4 + (wc ^ 1)]) * (1.0f / 128.0f) + 1e-6f);
                u32x4 w1, w2;
#pragma unroll
                for (int n = 0; n < 2; ++n) {
                    f32x4 c, sn;
#pragma unroll
                    for (int j = 0; j < 4; ++j) { const float rev = __builtin_amdgcn_fractf(fpos * frev[4 * n + j]); c[j] = __builtin_amdgcn_cosf(rev); sn[j] = __builtin_amdgcn_sinf(rev); }
                    const f32x4 a = acc[ai][0][m][n] * rs * ga[n], b = acc[ai][1][m][n] * rs * gb[n];
                    const f32x4 o1 = a * c - b * sn, o2 = a * sn + b * c;
                    if (n == 0) { w1.x = cvt_pk_bf16(o1[0], o1[1]); w1.y = cvt_pk_bf16(o1[2], o1[3]); w2.x = cvt_pk_bf16(o2[0], o2[1]); w2.y = cvt_pk_bf16(o2[2], o2[3]); }
                    else { w1.z = cvt_pk_bf16(o1[0], o1[1]); w1.w = cvt_pk_bf16(o1[2], o1[3]); w2.z = cvt_pk_bf16(o2[0], o2[1]); w2.w = cvt_pk_bf16(o2[2], o2[3]); }
                }
                bf16_t* rowp = O + (size_t)row * ldc + c1;
                *(u32x4*)rowp = w1;
                *(u32x4*)(rowp + 32) = w2; __builtin_amdgcn_sched_barrier(0); }
    }
};
struct StrideOrder {
    int first, G, count, nN;
    __device__ bool next(int i, Unit& u) const { const int j = first + i * G; if (j >= count) return false; u.pm = j / nN; u.pn = j % nN; return true; }
    __device__ __forceinline__ void a_ready(const Unit&) const {}
    __device__ __forceinline__ void done(const Unit&) const {}
};
template <class Epi, class Sched, bool ALIGN_EPI = false, bool SP2 = false>
__device__ __forceinline__ void gemm_phase(PG8_LAS unsigned char* lds, const Gemm g, const Sched& S, const Epi& E) {
    const int tid = opaque_tid(), wid = __builtin_amdgcn_readfirstlane(tid >> 6), lane = tid & 63, wr = wid >> 2, wc = wid & 3, fr = lane & 15, fq = lane >> 4;
    const int K = g.K, nt = K / BK;
    unsigned voffA[2], voffB[2];
#pragma unroll
    for (int i = 0; i < 2; ++i) { int R, C; stage_rc(tid * 16 + i * 8192, R, C); const int Rb = Epi::PERM ? ((R & ~31) + perm32(R & 31)) : R;
        voffA[i] = (unsigned)(R * K + C) * 2u; voffB[i] = (unsigned)(Rb * K + C) * 2u; }
    const size_t kstep = (size_t)(BK * 2);
    const size_t hstep = (size_t)HALF * K * 2;
    const size_t tstep = 2 * hstep;
    const unsigned ldsw = (unsigned)wid * 1024u;
    const int aoff = lds_byte(wr * 64 + fr, fq * 8), boff = lds_byte(wc * 32 + fr, fq * 8);
#define PG8_SA(b, h) (((b) * 2 + (h)) * HTB)
#define PG8_SB(b, h) ((4 + (b) * 2 + (h)) * HTB)
#define PG8_STAGE(bufoff, gbase, voff) do { _Pragma("unroll") for (int _i = 0; _i < 2; ++_i) \
        __builtin_amdgcn_global_load_lds((const unsigned*)((const char*)(gbase) + (voff)[_i]), (PG8_LAS unsigned*)(lds + (bufoff) + ldsw + _i * 8192), 16, 0, 0); } while (0)
#define PG8_LDA(dst, b, h) do { _Pragma("unroll") for (int m = 0; m < 4; ++m) _Pragma("unroll") for (int k = 0; k < 2; ++k) dst[m][k] = *(const PG8_LAS bf16x8*)(lds + PG8_SA(b, h) + aoff + m * 2048 + k * 1024); } while (0)
#define PG8_LDB(dst, b, h) do { _Pragma("unroll") for (int n = 0; n < 2; ++n) _Pragma("unroll") for (int k = 0; k < 2; ++k) dst[n][k] = *(const PG8_LAS bf16x8*)(lds + PG8_SB(b, h) + boff + n * 2048 + k * 1024); } while (0)
#define PG8_MMA(ai, bj, At, Bt) do { __builtin_amdgcn_s_setprio(1); _Pragma("unroll") for (int m = 0; m < 4; ++m) _Pragma("unroll") for (int n = 0; n < 2; ++n) _Pragma("unroll") for (int k = 0; k < 2; ++k) \
        acc[ai][bj][m][n] = __builtin_amdgcn_mfma_f32_16x16x32_bf16(Bt[n][k], At[m][k], acc[ai][bj][m][n], 0, 0, 0); __builtin_amdgcn_s_setprio(0); } while (0)
#define PG8_WAIT_V(n) asm volatile("s_waitcnt vmcnt(" #n ")" ::: "memory")
#define PG8_WAIT_L(n) asm volatile("s_waitcnt lgkmcnt(" #n ")" ::: "memory")
#define PG8_BAR __builtin_amdgcn_s_barrier()
#define PG8_SCHED __builtin_amdgcn_sched_barrier(0)
    Unit cur, nxt; int ui = 0;
    if (!S.next(0, cur)) return;
    f32x4 acc[2][2][4][2];
#pragma unroll
    for (int a = 0; a < 2; ++a)
#pragma unroll
        for (int b = 0; b < 2; ++b)
#pragma unroll
            for (int m = 0; m < 4; ++m)
#pragma unroll
                for (int n = 0; n < 2; ++n) acc[a][b][m][n] = (f32x4){0.f, 0.f, 0.f, 0.f};
    bf16x8 At[4][2], B0[2][2], B1[2][2];
    const char* cA = (const char*)g.A + (size_t)cur.pm * tstep; const char* cB = (const char*)g.Bt + (size_t)cur.pn * tstep;
    S.a_ready(cur);
    if constexpr (SP2) {
        PG8_STAGE(PG8_SB(0, 0), cB, voffB); PG8_STAGE(PG8_SB(0, 1), cB + hstep, voffB); PG8_STAGE(PG8_SA(0, 0), cA, voffA); PG8_STAGE(PG8_SA(0, 1), cA + hstep, voffA);
        if (wr == 1) PG8_BAR;
        PG8_WAIT_V(2); PG8_BAR;
        PG8_STAGE(PG8_SB(1, 0), cB + kstep, voffB); PG8_STAGE(PG8_SA(1, 0), cA + kstep, voffA); PG8_STAGE(PG8_SB(1, 1), cB + hstep + kstep, voffB);
        PG8_WAIT_V(6); PG8_BAR;
    } else {
        PG8_STAGE(PG8_SB(0, 0), cB, voffB); PG8_STAGE(PG8_SA(0, 0), cA, voffA); PG8_STAGE(PG8_SB(0, 1), cB + hstep, voffB); PG8_STAGE(PG8_SA(0, 1), cA + hstep, voffA);
        if (wr == 1) PG8_BAR;
        PG8_WAIT_V(4); PG8_BAR;
        PG8_STAGE(PG8_SB(1, 0), cB + kstep, voffB); PG8_STAGE(PG8_SA(1, 0), cA + kstep, voffA); PG8_STAGE(PG8_SB(1, 1), cB + hstep + kstep, voffB);
        PG8_WAIT_V(6); PG8_BAR;
    }
    for (;;) {
        const bool has_next = S.next(ui + 1, nxt);
        const char* nA = has_next ? (const char*)g.A + (size_t)nxt.pm * tstep : cA; const char* nB = has_next ? (const char*)g.Bt + (size_t)nxt.pn * tstep : cB;
        for (int t = 0; t < nt; t += 2) {
            const bool last = (t == nt - 2);
            const char* a1 = cA + (size_t)(t + 1) * kstep;
            const char* a2 = last ? nA : cA + (size_t)(t + 2) * kstep; const char* b2 = last ? nB : cB + (size_t)(t + 2) * kstep;
            const char* a3 = a2 + kstep; const char* b3 = b2 + kstep;
            if (last && has_next) S.a_ready(nxt);
            if constexpr (SP2) {
            PG8_LDB(B0, 0, 0); PG8_LDB(B1, 0, 1); PG8_SCHED; PG8_LDA(At, 0, 0); PG8_STAGE(PG8_SA(1, 1), a1 + hstep, voffA);
            PG8_WAIT_V(8); PG8_WAIT_L(0); PG8_BAR; PG8_MMA(0, 0, At, B0); PG8_MMA(0, 1, At, B1); PG8_BAR; PG8_SCHED;
            PG8_LDA(At, 0, 1); PG8_STAGE(PG8_SB(0, 0), b2, voffB); PG8_STAGE(PG8_SB(0, 1), b2 + hstep, voffB); PG8_STAGE(PG8_SA(0, 0), a2, voffA);
            PG8_WAIT_V(8); PG8_WAIT_L(0); PG8_BAR; PG8_MMA(1, 0, At, B0); PG8_MMA(1, 1, At, B1); PG8_BAR; PG8_SCHED;
            PG8_LDB(B0, 1, 0); PG8_LDB(B1, 1, 1); PG8_SCHED; PG8_LDA(At, 1, 0); PG8_STAGE(PG8_SA(0, 1), a2 + hstep, voffA);
            PG8_WAIT_V(8); PG8_WAIT_L(0); PG8_BAR; PG8_MMA(0, 0, At, B0); PG8_MMA(0, 1, At, B1); PG8_BAR; PG8_SCHED;
            PG8_LDA(At, 1, 1); PG8_STAGE(PG8_SB(1, 0), b3, voffB); PG8_STAGE(PG8_SB(1, 1), b3 + hstep, voffB); PG8_STAGE(PG8_SA(1, 0), a3, voffA);
            PG8_WAIT_V(8); PG8_WAIT_L(0); PG8_BAR; PG8_MMA(1, 0, At, B0); PG8_MMA(1, 1, At, B1); PG8_BAR; PG8_SCHED;
            } else {
            PG8_LDB(B0, 0, 0); PG8_SCHED; PG8_LDA(At, 0, 0); PG8_STAGE(PG8_SA(1, 1), a1 + hstep, voffA);
            PG8_WAIT_L(8); PG8_BAR; PG8_WAIT_L(0); PG8_MMA(0, 0, At, B0); PG8_BAR; PG8_SCHED;
            PG8_LDB(B1, 0, 1); PG8_STAGE(PG8_SB(0, 0), b2, voffB);
            PG8_BAR; PG8_WAIT_L(0); PG8_MMA(0, 1, At, B1); PG8_BAR;
            PG8_LDA(At, 0, 1); PG8_STAGE(PG8_SA(0, 0), a2, voffA);
            PG8_BAR; PG8_WAIT_L(0); PG8_MMA(1, 0, At, B0); PG8_BAR; PG8_SCHED;
            PG8_STAGE(PG8_SB(0, 1), b2 + hstep, voffB);
            PG8_WAIT_V(6); PG8_BAR; PG8_MMA(1, 1, At, B1); PG8_BAR;
            PG8_LDB(B0, 1, 0); PG8_SCHED; PG8_LDA(At, 1, 0); PG8_STAGE(PG8_SA(0, 1), a2 + hstep, voffA);
            PG8_WAIT_L(8); PG8_BAR; PG8_WAIT_L(0); PG8_MMA(0, 0, At, B0); PG8_BAR; PG8_SCHED;
            PG8_LDB(B1, 1, 1); PG8_STAGE(PG8_SB(1, 0), b3, voffB);
            PG8_BAR; PG8_WAIT_L(0); PG8_MMA(0, 1, At, B1); PG8_BAR;
            PG8_LDA(At, 1, 1); PG8_STAGE(PG8_SA(1, 0), a3, voffA);
            PG8_BAR; PG8_WAIT_L(0); PG8_MMA(1, 0, At, B0); PG8_BAR; PG8_SCHED;
            PG8_STAGE(PG8_SB(1, 1), b3 + hstep, voffB);
            PG8_WAIT_V(6); PG8_BAR; PG8_MMA(1, 1, At, B1); PG8_BAR;
            }
        }
        if constexpr (ALIGN_EPI) { if (wr == 0) PG8_BAR; }
        if constexpr (!Epi::AFTER_DRAIN) { E(acc, cur, wr, wc, fr, fq); S.done(cur); }
        if (!has_next) break;
#pragma unroll
        for (int a = 0; a < 2; ++a)
#pragma unroll
            for (int b = 0; b < 2; ++b)
#pragma unroll
                for (int m = 0; m < 4; ++m)
#pragma unroll
                    for (int n = 0; n < 2; ++n) acc[a][b][m][n] = (f32x4){0.f, 0.f, 0.f, 0.f};
        cur = nxt; cA = nA; cB = nB; ++ui;
        if constexpr (ALIGN_EPI) { if (wr == 1) PG8_BAR; }
    }
    PG8_WAIT_V(0);
    if constexpr (!ALIGN_EPI) { if (wr == 0) PG8_BAR; }
    PG8_BAR;
    if constexpr (Epi::AFTER_DRAIN) { E.fused(acc, cur, wr, wc, fr, fq, lds, wid, lane); S.done(cur); }
#undef PG8_SA
#undef PG8_SB
#undef PG8_STAGE
#undef PG8_LDA
#undef PG8_LDB
#undef PG8_MMA
#undef PG8_WAIT_V
#undef PG8_WAIT_L
#undef PG8_BAR
#undef PG8_SCHED
}
}
namespace att {
using bf16 = unsigned short;
using bf16x8 = __attribute__((ext_vector_type(8))) short;
using s16x4  = __attribute__((ext_vector_type(4))) short;
using f32x16 = __attribute__((ext_vector_type(16))) float;
using u32x4  = __attribute__((ext_vector_type(4))) unsigned;
constexpr int KVBLK = 64, LDP = 5120;
constexpr float THR = 8.f;
constexpr int SHM_V = 16384, SHM_K = 16384, SHM_ATTN = 2 * SHM_V + 2 * SHM_K + 8 * 64 * 4;
constexpr int RPB_OFF = SHM_ATTN, Q_OFF = SHM_ATTN + 2048;
#define SBAR() __builtin_amdgcn_sched_barrier(0)
template <int DK> __device__ __forceinline__ int kswz(int row, int colB) { return DK == 128 ? row * 256 + (colB ^ ((row & 7) << 4)) : row * 128 + (colB ^ (((row >> 1) & 7) << 4)); }
__device__ __forceinline__ int crow(int r, int hi) { return (r & 3) + 8 * (r >> 2) + 4 * hi; }
__device__ __forceinline__ unsigned cvtpk(float lo, float hi) { unsigned r; asm volatile("v_cvt_pk_bf16_f32 %0, %1, %2" : "=v"(r) : "v"(lo), "v"(hi)); return r; }

__device__ __forceinline__ void partialSM(f32x16& p0, f32x16& p1, float& m_reg, float& mn, float& alpha, float C, float thrRaw) {
  float pmax = p0[0];
#pragma unroll
  for (int r = 1; r < 16; ++r) pmax = fmaxf(pmax, p0[r]);
#pragma unroll
  for (int r = 0; r < 16; ++r) pmax = fmaxf(pmax, p1[r]);
  { auto rr = __builtin_amdgcn_permlane32_swap(__float_as_uint(pmax), __float_as_uint(pmax), false, false);
    pmax = fmaxf(__uint_as_float(rr[0]), __uint_as_float(rr[1])); }
  if (__builtin_expect(__all(pmax - m_reg <= thrRaw), 1)) { mn = m_reg; alpha = 1.f; }
  else { mn = fmaxf(m_reg, pmax); alpha = __builtin_amdgcn_exp2f((m_reg - mn) * C); m_reg = mn; }
  float mnC = -mn * C;
#pragma unroll
  for (int r = 0; r < 16; ++r) p0[r] = fmaf(p0[r], C, mnC);
#pragma unroll
  for (int r = 0; r < 16; ++r) p1[r] = fmaf(p1[r], C, mnC);
#pragma unroll
  for (int r = 0; r < 16; ++r) p0[r] = __builtin_amdgcn_exp2f(p0[r]);
}
__device__ __forceinline__ void finishSM(f32x16& p0, f32x16& p1, float alpha, float& l_reg, bf16x8& pa0, bf16x8& pa1, bf16x8& pa2, bf16x8& pa3) {
#pragma unroll
  for (int r = 0; r < 16; ++r) p1[r] = __builtin_amdgcn_exp2f(p1[r]);
  float ps = 0;
#pragma unroll
  for (int r = 0; r < 16; ++r) ps += p0[r];
#pragma unroll
  for (int r = 0; r < 16; ++r) ps += p1[r];
  { auto rr = __builtin_amdgcn_permlane32_swap(__float_as_uint(ps), __float_as_uint(ps), false, false);
    ps = __uint_as_float(rr[0]) + __uint_as_float(rr[1]); }
  l_reg = l_reg * alpha + ps;
#define PK4(P, BASE, OUT) do { unsigned a0 = cvtpk(P[BASE + 0], P[BASE + 1]), a1 = cvtpk(P[BASE + 2], P[BASE + 3]);   \
    unsigned b0 = cvtpk(P[BASE + 4], P[BASE + 5]), b1 = cvtpk(P[BASE + 6], P[BASE + 7]);                              \
    auto r0 = __builtin_amdgcn_permlane32_swap(a0, b0, false, false); auto r1 = __builtin_amdgcn_permlane32_swap(a1, b1, false, false); \
    u32x4 w = {r0[0], r1[0], r0[1], r1[1]}; OUT = *reinterpret_cast<bf16x8*>(&w); } while (0)
  PK4(p0, 0, pa0); PK4(p0, 8, pa1); PK4(p1, 0, pa2); PK4(p1, 8, pa3);
#undef PK4
}
template <int DK, bool QL>
__device__ __forceinline__ void qkt(f32x16& p0, f32x16& p1, const bf16* Ks, const bf16x8* qr, const char* ql, int r32, int hi) {
  p0 = f32x16{}; p1 = f32x16{};
  __builtin_amdgcn_s_setprio(1);
#pragma unroll
  for (int d0 = 0; d0 < DK / 16; ++d0) { int cb = (d0 * 16 + hi * 8) * 2;
    const bf16x8 qv = QL ? *reinterpret_cast<const bf16x8*>(ql + d0 * 1024) : qr[d0];
    bf16x8 b0 = *reinterpret_cast<const bf16x8*>((const char*)Ks + kswz<DK>(r32, cb));
    bf16x8 b1 = *reinterpret_cast<const bf16x8*>((const char*)Ks + kswz<DK>(32 + r32, cb));
    p0 = __builtin_amdgcn_mfma_f32_32x32x16_bf16(b0, qv, p0, 0, 0, 0);
    p1 = __builtin_amdgcn_mfma_f32_32x32x16_bf16(b1, qv, p1, 0, 0, 0); }
  __builtin_amdgcn_s_setprio(0);
}
__device__ __forceinline__ void na_hook(f32x16& p0, f32x16& p1, int kr, int q_row, int q_col, int win_r, int win_c, const float* rpb, float inv_scale, int hi) {
  const bool rowok = (kr >= win_r) && (kr < win_r + 8);
  int ir = kr - q_row + 7; ir = ir < 0 ? 0 : (ir > 14 ? 14 : ir);
  const float* rp = rpb + ir * 31;
#pragma unroll
  for (int r = 0; r < 16; ++r) {
    const int kc = crow(r, hi);
    { const bool ok = rowok && kc >= win_c && kc < win_c + 16; int ic = kc - q_col + 15; ic = ic < 0 ? 0 : (ic > 30 ? 30 : ic);
      p0[r] = ok ? fmaf(rp[ic], inv_scale, p0[r]) : -1e30f; }
    { const int kc2 = kc + 32; const bool ok = rowok && kc2 >= win_c && kc2 < win_c + 16; int ic = kc2 - q_col + 15; ic = ic < 0 ? 0 : (ic > 30 ? 30 : ic);
      p1[r] = ok ? fmaf(rp[ic], inv_scale, p1[r]) : -1e30f; }
  }
}
__device__ __forceinline__ int v_st(int k, int c) { const int kk = (k & ~0xC) | ((k & 4) << 1) | ((k & 8) >> 1); return ((kk >> 3) * 4 + (c >> 5)) * 512 + ((kk & 7) * 32 + (c & 31)) * 2; }
__device__ __forceinline__ int v_rd_base(int lane) { return ((lane & 3) << 3) | (((lane >> 2) & 3) << 6) | (((lane >> 4) & 1) << 5) | (((lane >> 5) & 1) << 8); }
constexpr int v_rd_off(int d0, int ks, int half) { return d0 * 512 + ks * 4096 + half * 2048; }
template <int OFF> __device__ __forceinline__ s16x4 tr_read(int vb) {
  s16x4 r; asm volatile("ds_read_b64_tr_b16 %0, %1 offset:%2" : "=&v"(r) : "v"(vb), "i"(OFF) : "memory"); return r;
}
template <int D0> __device__ __forceinline__ void pv_one(f32x16& od, int vb, bf16x8 pa0, bf16x8 pa1, bf16x8 pa2, bf16x8 pa3) {
  const s16x4 l0 = tr_read<v_rd_off(D0, 0, 0)>(vb), h0 = tr_read<v_rd_off(D0, 0, 1)>(vb), l1 = tr_read<v_rd_off(D0, 1, 0)>(vb), h1 = tr_read<v_rd_off(D0, 1, 1)>(vb);
  const s16x4 l2 = tr_read<v_rd_off(D0, 2, 0)>(vb), h2 = tr_read<v_rd_off(D0, 2, 1)>(vb), l3 = tr_read<v_rd_off(D0, 3, 0)>(vb), h3 = tr_read<v_rd_off(D0, 3, 1)>(vb);
  asm volatile("s_waitcnt lgkmcnt(0)" ::: "memory"); SBAR();
#define PK(L, H) (bf16x8){L[0], L[1], L[2], L[3], H[0], H[1], H[2], H[3]}
  __builtin_amdgcn_s_setprio(1);
  od = __builtin_amdgcn_mfma_f32_32x32x16_bf16(pa0, PK(l0, h0), od, 0, 0, 0);
  od = __builtin_amdgcn_mfma_f32_32x32x16_bf16(pa1, PK(l1, h1), od, 0, 0, 0);
  od = __builtin_amdgcn_mfma_f32_32x32x16_bf16(pa2, PK(l2, h2), od, 0, 0, 0);
  od = __builtin_amdgcn_mfma_f32_32x32x16_bf16(pa3, PK(l3, h3), od, 0, 0, 0);
  __builtin_amdgcn_s_setprio(0);
#undef PK
}
__device__ __forceinline__ void pv_d0(f32x16* o, int vb, bf16x8 pa0, bf16x8 pa1, bf16x8 pa2, bf16x8 pa3) {
  pv_one<0>(o[0], vb, pa0, pa1, pa2, pa3); pv_one<1>(o[1], vb, pa0, pa1, pa2, pa3); pv_one<2>(o[2], vb, pa0, pa1, pa2, pa3); pv_one<3>(o[3], vb, pa0, pa1, pa2, pa3);
}
template <int DK, bool NA, bool QL, int SD>
__device__ __forceinline__ void attn_body(const bf16* __restrict__ Qb, const bf16* __restrict__ Kh, const bf16* __restrict__ Vh, int NT, char* lds,
                                          float C, float thrRaw, f32x16 (&o)[4], int krow0, int q_row, int q_col, float inv_scale) {
  const int tid = opaque_tid(), wid = tid >> 6, lane = tid & 63, r32 = lane & 31, hi = lane >> 5;
  bf16* V_lds = (bf16*)lds; bf16* K_lds = (bf16*)(lds + 2 * SHM_V);
  float* ws = (float*)(lds + 2 * SHM_V + 2 * SHM_K) + wid * 64; float* li_l = ws; float* al_l = ws + 32;
  const float* rpb = (const float*)(lds + RPB_OFF);
  int win_r = q_row - 4; win_r = win_r < 0 ? 0 : (win_r > 56 ? 56 : win_r);
  int win_c = q_col - 8; win_c = win_c < 0 ? 0 : (win_c > 48 ? 48 : win_c);
  float m_reg = -1e30f, l_reg = 0; bf16x8 qr[QL ? 1 : DK / 16];
  char* ql = lds + Q_OFF + (wid * (DK / 16) * 64 + lane) * 16;
#pragma unroll
  for (int d = 0; d < 4; ++d) o[d] = f32x16{};
  const bf16* Qw = Qb + (long)(wid * 32 + r32) * LDP + hi * 8;
#pragma unroll
  for (int d0 = 0; d0 < DK / 16; ++d0) { const bf16x8 qv = *reinterpret_cast<const bf16x8*>(Qw + d0 * 16); if (QL) *reinterpret_cast<bf16x8*>(ql + d0 * 1024) = qv; else qr[d0] = qv; }
  const int sr = tid >> 4, sc = (tid & 15) * 8, vst0 = v_st(sr, sc), vst1 = v_st(32 + sr, sc);
  const int ksr = DK == 128 ? sr : (tid >> 3), ksc = DK == 128 ? sc : (tid & 7) * 8;
  const int vb0 = (int)(uintptr_t)V_lds + v_rd_base(lane);
  struct { bf16x8 vs0, vs1, ks0, ks1; } sr_[SD];
#define SLOAD(i, k0) do { sr_[i].vs0 = *reinterpret_cast<const bf16x8*>(&Vh[(long)((k0) + sr) * LDP + sc]); sr_[i].vs1 = *reinterpret_cast<const bf16x8*>(&Vh[(long)((k0) + 32 + sr) * LDP + sc]); \
    sr_[i].ks0 = *reinterpret_cast<const bf16x8*>(&Kh[(long)((k0) + ksr) * LDP + ksc]); if (DK == 128) sr_[i].ks1 = *reinterpret_cast<const bf16x8*>(&Kh[(long)((k0) + 32 + ksr) * LDP + ksc]); } while (0)
#define SWRITE(b, i) do { *(bf16x8*)((char*)V_lds + (b) * SHM_V + vst0) = sr_[i].vs0;          \
    *(bf16x8*)((char*)V_lds + (b) * SHM_V + vst1) = sr_[i].vs1; int kc = ksc * 2;               \
    *(bf16x8*)((char*)K_lds + (b) * SHM_K + kswz<DK>(ksr, kc)) = sr_[i].ks0;                       \
    if (DK == 128) *(bf16x8*)((char*)K_lds + (b) * SHM_K + kswz<DK>(32 + ksr, kc)) = sr_[i].ks1; } while (0)
#define SWAIT() do { if (SD == 1) asm volatile("s_waitcnt vmcnt(0)" ::: "memory"); else if (DK == 128) asm volatile("s_waitcnt vmcnt(4)" ::: "memory"); else asm volatile("s_waitcnt vmcnt(3)" ::: "memory"); } while (0)
#define RESC(a) do { if (__any((a) < 1.f)) { if (hi == 0) al_l[r32] = (a); asm volatile("s_waitcnt lgkmcnt(0)" ::: "memory"); \
    _Pragma("unroll") for (int d = 0; d < 4; ++d) _Pragma("unroll") for (int r = 0; r < 16; ++r) o[d][r] *= al_l[crow(r, hi)]; } } while (0)
#define HOOK(P0, P1, j) do { if (NA) na_hook(P0, P1, krow0 + (j), q_row, q_col, win_r, win_c, rpb, inv_scale, hi); } while (0)
  f32x16 pA0, pA1, pB0, pB1; float mnA, mnB, alA, alB; bf16x8 pa0, pa1, pa2, pa3;
  constexpr int SE = 0, SO = SD - 1;
  SLOAD(SE, 0); asm volatile("s_waitcnt vmcnt(0)" ::: "memory"); SWRITE(0, SE); __syncthreads();
  qkt<DK, QL>(pA0, pA1, K_lds, qr, ql, r32, hi); HOOK(pA0, pA1, 0); partialSM(pA0, pA1, m_reg, mnA, alA, C, thrRaw);
  SLOAD(SO, KVBLK); if (SD == 2) { if (2 < NT) SLOAD(SE, 2 * KVBLK); }
  SWAIT(); SWRITE(1, SO); __syncthreads();
  for (int j = 1; j + 1 < NT; j += 2) {
    SBAR(); qkt<DK, QL>(pB0, pB1, (bf16*)((char*)K_lds + SHM_K), qr, ql, r32, hi); HOOK(pB0, pB1, j);
    finishSM(pA0, pA1, alA, l_reg, pa0, pa1, pa2, pa3); SBAR();
    SLOAD(SO, (j + SD) * KVBLK); SBAR();
    pv_d0(o, vb0, pa0, pa1, pa2, pa3); partialSM(pB0, pB1, m_reg, mnB, alB, C, thrRaw);
    __syncthreads(); SWAIT(); SWRITE(0, SE);
    RESC(alB); __syncthreads();
    SBAR(); qkt<DK, QL>(pA0, pA1, K_lds, qr, ql, r32, hi); HOOK(pA0, pA1, j + 1);
    finishSM(pB0, pB1, alB, l_reg, pa0, pa1, pa2, pa3); SBAR();
    if (SD == 1 || j + 3 < NT) SLOAD(SE, (j + 1 + SD) * KVBLK); SBAR();
    pv_d0(o, vb0 + (int)SHM_V, pa0, pa1, pa2, pa3); partialSM(pA0, pA1, m_reg, mnA, alA, C, thrRaw);
    __syncthreads(); SWAIT(); SWRITE(1, SO);
    RESC(alA); __syncthreads();
  }
  SBAR(); qkt<DK, QL>(pB0, pB1, (bf16*)((char*)K_lds + SHM_K), qr, ql, r32, hi); HOOK(pB0, pB1, NT - 1);
  finishSM(pA0, pA1, alA, l_reg, pa0, pa1, pa2, pa3); SBAR();
  pv_d0(o, vb0, pa0, pa1, pa2, pa3); partialSM(pB0, pB1, m_reg, mnB, alB, C, thrRaw);
  __syncthreads(); RESC(alB);
  finishSM(pB0, pB1, alB, l_reg, pa0, pa1, pa2, pa3); SBAR();
  pv_d0(o, vb0 + (int)SHM_V, pa0, pa1, pa2, pa3);
  if (hi == 0) li_l[r32] = l_reg; asm volatile("s_waitcnt vmcnt(0) lgkmcnt(0)" ::: "memory");
#pragma unroll
  for (int r = 0; r < 16; ++r) { const float rl = __builtin_amdgcn_rcpf(li_l[crow(r, hi)]);
#pragma unroll
    for (int d = 0; d < 4; ++d) o[d][r] *= rl; }
#undef SLOAD
#undef SWRITE
#undef SWAIT
#undef RESC
#undef HOOK
}
#undef SBAR
}
#define GAS __attribute__((address_space(1)))
#define LAS __attribute__((address_space(3)))
typedef unsigned short bf16;
typedef unsigned v4u __attribute__((ext_vector_type(4)));
typedef unsigned v2u __attribute__((ext_vector_type(2)));
typedef float f32x4 __attribute__((ext_vector_type(4)));
typedef float f32x2 __attribute__((ext_vector_type(2)));
constexpr int NWAVES = 8, NTHR = 512;
constexpr int SEQ = 4096, M = 8192, DM = 2048, NIN = 5120, FF = 5632, DEPTH = 2, CC = 512;
constexpr float EPS = 1e-6f;
constexpr int PA_Q = 0, PA_K = 512, PA_V = 1024, PB_A = 1536, PB_G = 2048, PC_Q = 2560, PC_K = 3072, PC_V = 3328, PD_Q = 3584, PD_K = 4096, PD_V = 4608;
constexpr size_t MiB = 1u << 20;
constexpr size_t WS_ROPE = 1 * MiB;
constexpr size_t WS_WIN = 2 * MiB;
constexpr size_t WS_WOUT = WS_WIN + 40 * MiB;
constexpr size_t WS_WGU = WS_WOUT + 16 * MiB;
constexpr size_t WS_WDN = WS_WGU + 88 * MiB;
constexpr size_t WS_WPW = WS_WDN + 44 * MiB;
constexpr size_t WS_XN = WS_WPW + 1 * MiB;
constexpr size_t WS_PROJ = WS_XN + 32 * MiB;
constexpr size_t WS_CAT = WS_PROJ + 80 * MiB;
constexpr size_t WS_H = WS_PROJ;
constexpr size_t WS_MIX = WS_CAT + 32 * MiB;
constexpr size_t WS_CV = WS_MIX + 64 * MiB;
constexpr size_t WS_END = WS_CV + 8 * MiB;
constexpr int LDS_BYTES = 163840;

__device__ __forceinline__ unsigned f2bf(float f) { unsigned u = __builtin_bit_cast(unsigned, f); return (u + 0x7fffu + ((u >> 16) & 1u)) >> 16; }
__device__ __forceinline__ unsigned pk2(float lo, float hi) { return f2bf(lo) | (f2bf(hi) << 16); }
__device__ __forceinline__ float bf2f(unsigned short b) { return __builtin_bit_cast(float, (unsigned)b << 16); }
__device__ __forceinline__ float wave_sum(float v) {
#pragma unroll
    for (int o = 1; o < 64; o <<= 1) v += __shfl_xor(v, o);
    return v;
}
#define LDS_WAIT() asm volatile("s_waitcnt lgkmcnt(0)" ::: "memory")

#define XB_TMO      128
#define XB_XCNT(j)  (256  + 64 * (j))
#define XB_XSUB(j)  (1280 + 64 * (j))
#define XB_XGEN(j)  (2304 + 64 * (j))
#define XB_TOP      3328
#define XB_TOPGEN   3392
#define XCD_BAR_WORDS 3456
#define XB_SPIN_CAP (1u << 18)

__device__ __forceinline__ unsigned xb_ld(unsigned* p)              { return __hip_atomic_load(p, __ATOMIC_RELAXED, __HIP_MEMORY_SCOPE_AGENT); }
__device__ __forceinline__ unsigned xb_add(unsigned* p, unsigned v) { return __hip_atomic_fetch_add(p, v, __ATOMIC_RELAXED, __HIP_MEMORY_SCOPE_AGENT); }
__device__ __forceinline__ unsigned xb_xcc_id() { return (unsigned)__builtin_amdgcn_s_getreg((3 << 11) | 20) & 0xFu; }
#define XB_SPIN(cond, bar) do { unsigned _sp = 0; while (cond) { __builtin_amdgcn_s_sleep(1); \
    if ((++_sp & 255u) == 0u) { if (xb_ld(&(bar)[XB_TMO])) break; if (_sp > XB_SPIN_CAP) { atomicAdd(&(bar)[XB_TMO], 1u); break; } } } } while (0)

struct XcdBarrier {
    unsigned* bar; unsigned x;
    volatile LAS unsigned* st;
};

__device__ __forceinline__ XcdBarrier xcd_barrier_post(unsigned* bar, volatile LAS unsigned* st) {
    XcdBarrier b; b.bar = bar; b.x = xb_xcc_id(); b.st = st;
    if (threadIdx.x == 0) (void)xb_add(&bar[XB_XCNT(b.x)], 1u);
    return b;
}
__device__ __forceinline__ void xcd_barrier_complete(unsigned* bar, unsigned x, unsigned& nloc, unsigned& nx) {
    const unsigned G = gridDim.x * gridDim.y * gridDim.z;
    unsigned sum, cnt, mine, sp = 0u;
    for (;;) {
        sum = 0u; cnt = 0u; mine = 0u;
#pragma unroll
        for (unsigned j = 0; j < 16; ++j) { const unsigned c = xb_ld(&bar[XB_XCNT(j)]); sum += c; cnt += (c > 0u) ? 1u : 0u; mine = (j == x) ? c : mine; }
        if (sum == G) break;
        __builtin_amdgcn_s_sleep(1);
        if ((++sp & 255u) == 0u) { if (xb_ld(&bar[XB_TMO])) break; if (sp > XB_SPIN_CAP) { atomicAdd(&bar[XB_TMO], 1u); break; } }
    }
    nloc = mine > 0u ? mine : 1u; nx = cnt > 0u ? cnt : 1u;
}

__device__ __forceinline__ void xcd_barrier(const XcdBarrier& b) {
    asm volatile("s_waitcnt vmcnt(0)" ::: "memory");
    __syncthreads();
    if (threadIdx.x == 0) {
        unsigned* bar = b.bar;
        __builtin_amdgcn_s_waitcnt(0);
        unsigned nloc = b.st[0], nx = b.st[1];
        if (nloc == 0u) { xcd_barrier_complete(bar, b.x, nloc, nx); b.st[0] = nloc; b.st[1] = nx; }
        const unsigned old = xb_add(&bar[XB_XSUB(b.x)], 1u);
        const unsigned gen = old / nloc;
        if (old + 1u == (gen + 1u) * nloc) {
            __builtin_amdgcn_fence(__ATOMIC_RELEASE, "agent");
            asm volatile("s_waitcnt vmcnt(0)" ::: "memory");
            const unsigned og = xb_add(&bar[XB_TOP], 1u);
            const unsigned tg = og / nx;
            if (og + 1u == (tg + 1u) * nx) xb_add(&bar[XB_TOPGEN], 1u);
            else XB_SPIN(xb_ld(&bar[XB_TOPGEN]) == tg, bar);
            __builtin_amdgcn_fence(__ATOMIC_ACQUIRE, "agent");
            xb_add(&bar[XB_XGEN(b.x)], 1u);
            asm volatile("s_waitcnt vmcnt(0)" ::: "memory");
        } else {
            XB_SPIN(xb_ld(&bar[XB_XGEN(b.x)]) == gen, bar);
            __builtin_amdgcn_fence(__ATOMIC_ACQUIRE, "agent");
            asm volatile("s_waitcnt vmcnt(0)" ::: "memory");
        }
    }
    __syncthreads();
}

struct Params {
    const float* x; const float* norm_mix_pre; const float* norm_mix_post; const float* norm_ffn_pre; const float* norm_ffn_post;
    const float* w_in; const float* w_out; const float* diff_lambda; const float* diff_subln; const float* conv_dw; const float* conv_dw_b;
    const float* conv_ln_g; const float* conv_ln_b; const float* conv_pw; const float* conv_pw_b; const float* gqa_q_norm; const float* gqa_k_norm;
    const float* na_rpb; const float* ffn_gate; const float* ffn_up; const float* ffn_down;
    float* out; unsigned char* ws;
};

__device__ __forceinline__ void transpose_item(const float* __restrict__ W, int K, int N, bf16* WT, int k0, int n0, int dst_row0, LAS float* scr, int lane) {
    const int r = lane >> 3, q = lane & 7;
    f32x4 v[8];
#pragma unroll
    for (int i = 0; i < 8; ++i) v[i] = __builtin_nontemporal_load((const f32x4*)(W + (size_t)(k0 + 8 * i + r) * N + n0 + 4 * q));
#pragma unroll
    for (int i = 0; i < 8; ++i) { LAS float* d = scr + (8 * i + r) * 33 + 4 * q; d[0] = v[i].x; d[1] = v[i].y; d[2] = v[i].z; d[3] = v[i].w; }
    LDS_WAIT(); asm volatile("" ::: "memory");
    const int c = lane & 7;
#pragma unroll
    for (int j = 0; j < 4; ++j) { const int n = (lane >> 3) + 8 * j; const LAS float* s = scr + (8 * c) * 33 + n;
        v4u o; o.x = pk2(s[0 * 33], s[1 * 33]); o.y = pk2(s[2 * 33], s[3 * 33]); o.z = pk2(s[4 * 33], s[5 * 33]); o.w = pk2(s[6 * 33], s[7 * 33]);
        __builtin_nontemporal_store(o, (v4u*)(WT + (size_t)(dst_row0 + n) * K + k0 + 8 * c)); }
    LDS_WAIT(); asm volatile("" ::: "memory");
}
__device__ __forceinline__ void norm_row_bf16(const f32x4* v, const float* __restrict__ g, bf16* orow, int lane) {
    float s = 0.f;
#pragma unroll
    for (int j = 0; j < 8; ++j) s += (v[j].x * v[j].x + v[j].y * v[j].y) + (v[j].z * v[j].z + v[j].w * v[j].w);
    const float rstd = 1.0f / sqrtf(wave_sum(s) * (1.0f / DM) + EPS);
#pragma unroll
    for (int j = 0; j < 8; ++j) { const f32x4 gv = *(const f32x4*)(g + 4 * (lane + 64 * j));
        v2u o; o.x = pk2(v[j].x * rstd * gv.x, v[j].y * rstd * gv.y); o.y = pk2(v[j].z * rstd * gv.z, v[j].w * rstd * gv.w);
        *(v2u*)(orow + 4 * (lane + 64 * j)) = o; }
}
__device__ __forceinline__ void rows_update(const float* xin, const float* mix, const float* __restrict__ g_post, float* xout, const float* __restrict__ g_next, bf16* XN, int gw, int ngw, int lane) {
    for (int m = gw; m < M; m += ngw) {
        f32x4 a[8], v[8]; float s = 0.f;
#pragma unroll
        for (int j = 0; j < 8; ++j) { a[j] = *(const f32x4*)(mix + (size_t)m * DM + 4 * (lane + 64 * j)); v[j] = *(const f32x4*)(xin + (size_t)m * DM + 4 * (lane + 64 * j));
            s += (a[j].x * a[j].x + a[j].y * a[j].y) + (a[j].z * a[j].z + a[j].w * a[j].w); }
        const float rstd = 1.0f / sqrtf(wave_sum(s) * (1.0f / DM) + EPS);
#pragma unroll
        for (int j = 0; j < 8; ++j) { const f32x4 gv = *(const f32x4*)(g_post + 4 * (lane + 64 * j)); v[j] = v[j] + a[j] * rstd * gv;
            *(f32x4*)(xout + (size_t)m * DM + 4 * (lane + 64 * j)) = v[j]; }
        if (g_next) norm_row_bf16(v, g_next, XN + (size_t)m * DM, lane);
    }
}

constexpr int I_IN = 32 * 160, I_OUT = 32 * 64, I_G = 32 * 176, I_D = 88 * 64, I_PW = 8 * 16;
constexpr int I_LAYER = I_IN + I_OUT + 2 * I_G + I_D + I_PW;
constexpr int TAIL_ITEMS = 7168;
__device__ __forceinline__ void convert_item(const Params& p, unsigned char* ws, int l, int r, LAS float* scr, int lane) {
    bf16* WIN = (bf16*)(ws + WS_WIN); bf16* WOUT = (bf16*)(ws + WS_WOUT); bf16* WGU = (bf16*)(ws + WS_WGU); bf16* WDN = (bf16*)(ws + WS_WDN); bf16* WPW = (bf16*)(ws + WS_WPW);
    if (r < I_IN) { const int kb = r / 160, nb = r % 160, n0 = 32 * nb, tile = n0 >> 8, lc = n0 & 255; const bool rt = tile < 4 || (tile >= 10 && tile <= 12);
        transpose_item(p.w_in + (size_t)l * DM * NIN, DM, NIN, WIN + (size_t)l * NIN * DM, 64 * kb, n0, rt ? tile * 256 + 128 * ((lc >> 5) & 1) + 32 * (lc >> 6) : n0, scr, lane); return; } r -= I_IN;
    if (r < I_OUT) { const int kb = r / 64, nb = r % 64; transpose_item(p.w_out + (size_t)l * DM * DM, DM, DM, WOUT + (size_t)l * DM * DM, 64 * kb, 32 * nb, 32 * nb, scr, lane); return; } r -= I_OUT;
    if (r < I_G) { const int kb = r / 176, nb = r % 176, n0 = 32 * nb; transpose_item(p.ffn_gate + (size_t)l * DM * FF, DM, FF, WGU + (size_t)l * 2 * FF * DM, 64 * kb, n0, (n0 >> 7) * 256 + (n0 & 127), scr, lane); return; } r -= I_G;
    if (r < I_G) { const int kb = r / 176, nb = r % 176, n0 = 32 * nb; transpose_item(p.ffn_up + (size_t)l * DM * FF, DM, FF, WGU + (size_t)l * 2 * FF * DM, 64 * kb, n0, (n0 >> 7) * 256 + 128 + (n0 & 127), scr, lane); return; } r -= I_G;
    if (r < I_D) { const int kb = r / 64, nb = r % 64; transpose_item(p.ffn_down + (size_t)l * FF * DM, FF, DM, WDN + (size_t)l * DM * FF, 64 * kb, 32 * nb, 32 * nb, scr, lane); return; } r -= I_D;
    { const int kb = r / 16, nb = r % 16; transpose_item(p.conv_pw + (size_t)l * CC * CC, CC, CC, WPW + (size_t)l * CC * CC, 64 * kb, 32 * nb, 32 * nb, scr, lane); }
}
__device__ __forceinline__ void slot_item(int slot, int idx, int& l, int& r) {
    if (slot == 0) { l = 0; r = 5120 + idx; }
    else if (slot == 1) { if (idx < 5632) { l = 0; r = 18432 + idx; } else { l = 1; r = idx - 5632; } }
    else if (slot == 2) { l = 1; r = 7168 + idx; }
    else { l = 1; r = 18432 + idx; }
}
__device__ __forceinline__ void p0_item(int it, int& l, int& r) {
    if (it < 5120) { l = 0; r = it; return; } it -= 5120;
    if (it < 128) { l = 0; r = 24064 + it; return; } it -= 128;
    l = 1; r = 24064 + it;
}
constexpr int P0_ITEMS = 5376;
__device__ __forceinline__ void tail_convert(const Params& p, unsigned char* ws, int slot, PG8_LAS unsigned char* ldsl, int bx) {
    if (bx < 128) return;
    const int tid = opaque_tid(), lane = tid & 63, wave = __builtin_amdgcn_readfirstlane(tid >> 6);
    LAS float* scr = (LAS float*)(ldsl + wave * 16384);
    const int gwt = (bx - 128) * NWAVES + wave, count = slot == 0 ? 13312 : (slot == 1 ? 12800 : (slot == 2 ? 11264 : 5632));
    for (int it = gwt; it < count; it += 1024) { int l, r; slot_item(slot, it, l, r); convert_item(p, ws, l, r, scr, lane); }
}

__device__ __forceinline__ float wave_reduce32(const float (&v)[32], int lane) {
    float a[16], b[8], c[4], d[2], e;
    { const bool h = lane & 32;
#pragma unroll
      for (int t = 0; t < 16; ++t) { const float keep = h ? v[t + 16] : v[t], send = h ? v[t] : v[t + 16]; a[t] = keep + __shfl_xor(send, 32); } }
    { const bool h = lane & 16;
#pragma unroll
      for (int t = 0; t < 8; ++t) { const float keep = h ? a[t + 8] : a[t], send = h ? a[t] : a[t + 8]; b[t] = keep + __shfl_xor(send, 16); } }
    { const bool h = lane & 8;
#pragma unroll
      for (int t = 0; t < 4; ++t) { const float keep = h ? b[t + 4] : b[t], send = h ? b[t] : b[t + 4]; c[t] = keep + __shfl_xor(send, 8); } }
    { const bool h = lane & 4;
#pragma unroll
      for (int t = 0; t < 2; ++t) { const float keep = h ? c[t + 2] : c[t], send = h ? c[t] : c[t + 2]; d[t] = keep + __shfl_xor(send, 4); } }
    { const bool h = lane & 2; const float keep = h ? d[1] : d[0], send = h ? d[0] : d[1]; e = keep + __shfl_xor(send, 2); }
    e += __shfl_xor(e, 1);
    return e;
}
__device__ __forceinline__ void conv_tile(const Params& p, int l, int item, const bf16* PROJ, bf16* CV, LAS float* sl) {
    const int tid = opaque_tid(), lane = tid & 63, wave = __builtin_amdgcn_readfirstlane(tid >> 6), c = tid;
    const int m0 = item * 32, b = m0 / SEQ, s0 = m0 % SEQ;
    LAS float* part = sl; LAS float* stat = sl + 512;
    float u[62];
#pragma unroll
    for (int rr = 0; rr < 62; ++rr) { const int sq = s0 - 15 + rr; const bool ok = sq >= 0 && sq < SEQ; const bf16* pr = PROJ + (size_t)(b * SEQ + (ok ? sq : s0)) * NIN;
        const float a = bf2f(pr[PB_A + c]), g = bf2f(pr[PB_G + c]); u[rr] = ok ? a / (1.0f + __expf(-g)) : 0.f; }
    float w[31];
#pragma unroll
    for (int j = 0; j < 31; ++j) w[j] = p.conv_dw[(size_t)(l * 31 + j) * CC + c];
    const float bias = p.conv_dw_b[l * CC + c];
    float y[32], y2[32];
#pragma unroll
    for (int t = 0; t < 32; ++t) { float acc = bias;
#pragma unroll
        for (int j = 0; j < 31; ++j) acc = fmaf(u[t + j], w[j], acc);
        y[t] = acc; y2[t] = acc * acc; }
    const float r1 = wave_reduce32(y, lane), r2 = wave_reduce32(y2, lane);
    const int tl = 16 * ((lane >> 5) & 1) + 8 * ((lane >> 4) & 1) + 4 * ((lane >> 3) & 1) + 2 * ((lane >> 2) & 1) + ((lane >> 1) & 1);
    __syncthreads();
    if ((lane & 1) == 0) { part[(tl * 8 + wave) * 2] = r1; part[(tl * 8 + wave) * 2 + 1] = r2; }
    __syncthreads();
    if (tid < 32) { float S1 = 0.f, S2 = 0.f;
#pragma unroll
        for (int w8 = 0; w8 < 8; ++w8) { S1 += part[(tid * 8 + w8) * 2]; S2 += part[(tid * 8 + w8) * 2 + 1]; }
        const float mean = S1 * (1.0f / CC); float var = S2 * (1.0f / CC) - mean * mean; var = var < 0.f ? 0.f : var;
        stat[tid * 2] = mean; stat[tid * 2 + 1] = 1.0f / sqrtf(var + EPS); }
    __syncthreads();
    const float lg = p.conv_ln_g[l * CC + c], lb = p.conv_ln_b[l * CC + c];
#pragma unroll
    for (int t = 0; t < 32; ++t) { float v = (y[t] - stat[t * 2]) * stat[t * 2 + 1] * lg + lb; v = v / (1.0f + __expf(-v)); CV[(size_t)(m0 + t) * CC + c] = (bf16)f2bf(v); }
}
#ifndef QL64
#define QL64 false
#endif
#ifndef QL128
#define QL128 true
#endif
#ifndef SD64
#define SD64 2
#endif
#ifndef SD128
#define SD128 2
#endif
#ifndef SDNA
#define SDNA 1
#endif
#ifndef USE_CG_SYNC
#define USE_CG_SYNC 0
#endif
#define GSYNC() do { if (USE_CG_SYNC) grid.sync(); else xcd_barrier(xbar); } while (0)
#ifndef ROPE_PROBE
#define ROPE_PROBE 0
#endif
#ifndef REP_CONV
#define REP_CONV 1
#endif
#ifndef EXTRA_SYNC
#define EXTRA_SYNC 0
#endif
#ifndef REP_S3
#define REP_S3 1
#endif
#ifndef REP_GEMM
#define REP_GEMM 1
#endif
#ifndef REP_P0
#define REP_P0 1
#endif
#ifndef ON_DIFF
#define ON_DIFF 1
#endif
#ifndef ON_GQA
#define ON_GQA 1
#endif
#ifndef ON_NA
#define ON_NA 1
#endif
#ifndef ON_CONV
#define ON_CONV 1
#endif
#ifndef ON_ROPE
#define ON_ROPE 1
#endif
#ifndef ON_P0
#define ON_P0 1
#endif
#ifndef ON_GEMM
#define ON_GEMM 1
#endif
__device__ __forceinline__ void store_o_bf16(const att::f32x16 (&o)[4], bf16* base  , unsigned char* lds) {
    const int tid = opaque_tid(), lane = tid & 63, wave = __builtin_amdgcn_readfirstlane(tid >> 6), r32 = lane & 31, hi = lane >> 5;
    __syncthreads();
    float* T = (float*)(lds + wave * 16896);
#pragma unroll
    for (int r = 0; r < 16; ++r) { float* tp = T + att::crow(r, hi) * 132 + r32;
#pragma unroll
        for (int d = 0; d < 4; ++d) tp[32 * d] = o[d][r]; }
#pragma unroll
    for (int k = 0; k < 8; ++k) { const int chunk = k * 64 + lane, row = chunk >> 4, c8 = chunk & 15;
        const f32x4 a = *(const f32x4*)(T + row * 132 + c8 * 8), b = *(const f32x4*)(T + row * 132 + c8 * 8 + 4);
        v4u w; w.x = att::cvtpk(a.x, a.y); w.y = att::cvtpk(a.z, a.w); w.z = att::cvtpk(b.x, b.y); w.w = att::cvtpk(b.z, b.w);
        *(v4u*)(base + (size_t)(wave * 32 + row) * DM + c8 * 8) = w; }
}

__global__ void __launch_bounds__(NTHR) mega_fwd(Params p) {
    extern __shared__ __attribute__((aligned(16))) unsigned char lds[];
    cg::grid_group grid = cg::this_grid();
    const int G = gridDim.x, bx = blockIdx.x, ngw = G * NWAVES;
    unsigned char* ws = p.ws;
    bf16* WIN = (bf16*)(ws + WS_WIN); bf16* WOUT = (bf16*)(ws + WS_WOUT); bf16* WGU = (bf16*)(ws + WS_WGU); bf16* WDN = (bf16*)(ws + WS_WDN); bf16* WPW = (bf16*)(ws + WS_WPW);
    bf16* XN = (bf16*)(ws + WS_XN); bf16* PROJ = (bf16*)(ws + WS_PROJ); bf16* CAT = (bf16*)(ws + WS_CAT); bf16* HB = (bf16*)(ws + WS_H); bf16* CV = (bf16*)(ws + WS_CV);
    float* MIX = (float*)(ws + WS_MIX); unsigned long long* XSLOT = (unsigned long long*)(ws + WS_MIX + 48 * MiB); bf16* XB = (bf16*)(ws + WS_MIX + 16 * MiB);
    unsigned* CTL = (unsigned*)ws; f32x2* ROPE = (f32x2*)(ws + WS_ROPE);
    PG8_LAS unsigned char* ldsl = (PG8_LAS unsigned char*)lds;
    volatile LAS unsigned* bst = (volatile LAS unsigned*)(ldsl + LDS_BYTES - 16);
    if (threadIdx.x < 4) bst[threadIdx.x] = 0u;
    __syncthreads();
    const XcdBarrier xbar = xcd_barrier_post((unsigned*)ws, bst);

    for (int rp0 = 0; rp0 < REP_P0; ++rp0) {
        const int tid = opaque_tid(), lane = tid & 63, wave = __builtin_amdgcn_readfirstlane(tid >> 6), gw = bx * NWAVES + wave; (void)tid; (void)lane; (void)gw;
        LAS float* scr = (LAS float*)(ldsl + wave * 16384);
        for (int it = gw; it < ON_P0 * P0_ITEMS; it += ngw) { int cl, cr; p0_item(it, cl, cr); convert_item(p, ws, cl, cr, scr, lane); }
        for (int m = gw; m < M; m += ngw) { f32x4 v[8];
#pragma unroll
            for (int j = 0; j < 8; ++j) v[j] = *(const f32x4*)(p.x + (size_t)m * DM + 4 * (lane + 64 * j));
#pragma unroll
            for (int j = 0; j < 8; ++j) { v2u o; o.x = pk2(v[j].x, v[j].y); o.y = pk2(v[j].z, v[j].w); *(v2u*)(XB + (size_t)m * DM + 4 * (lane + 64 * j)) = o; }
            norm_row_bf16(v, p.norm_mix_pre, XN + (size_t)m * DM, lane); }
    }
    if (G != 256) grid.sync(); else GSYNC();
    for (int es = 0; es < EXTRA_SYNC; ++es) GSYNC();

    for (int l = 0; l < DEPTH; ++l) {
        _Pragma("unroll") for (int rg = 0; rg < REP_GEMM; ++rg) { pg8::Gemm g{XN, WIN + (size_t)l * NIN * DM, M, NIN, DM}; pg8::StaticOrder S; S.init(M, NIN, G, bx);
          pg8::EpiProj E{PROJ, NIN, (const float*)ROPE, p.gqa_q_norm + l * 128, p.gqa_k_norm + l * 128, (PG8_LAS float*)(ldsl + 131072)};
          pg8::gemm_phase<pg8::EpiProj, pg8::StaticOrder, true, true>(ldsl, g, S, E); }
        tail_convert(p, ws, l == 0 ? 0 : 2, ldsl, bx);
        GSYNC();

        for (int rep3 = 0; rep3 < REP_S3; ++rep3) {
            const int tid = opaque_tid(), lane = tid & 63, wave = __builtin_amdgcn_readfirstlane(tid >> 6), gw = bx * NWAVES + wave; (void)tid; (void)lane; (void)gw;
            const float lam_init = l == 0 ? 0.2f : 0.35550906759096934f;
            float lam; { const float* lp = p.diff_lambda + l * 256; const float sa = wave_sum(lp[lane] * lp[64 + lane]), sb = wave_sum(lp[128 + lane] * lp[192 + lane]); lam = expf(sa) - expf(sb) + lam_init; }
            constexpr float C64 = 0.125f * 1.4426950408889634f, THR64 = att::THR / 0.125f;
            constexpr float SC128 = 0.08838834764831845f, C128 = SC128 * 1.4426950408889634f, THR128 = att::THR / SC128;
            const int r32 = lane & 31, hi = lane >> 5;
            unsigned* ccnt = CTL + 32768 + l * 2048;
            if (ON_CONV && bx >= 128) {
                for (int ci = 0; ci < 2; ++ci) { const int item = 2 * (bx - 128) + ci;
                    conv_tile(p, l, item, PROJ, CV, (LAS float*)(ldsl + 131072));
                    asm volatile("s_waitcnt vmcnt(0)" ::: "memory"); __syncthreads();
                    if (tid == 0) { __builtin_amdgcn_fence(__ATOMIC_RELEASE, "agent"); asm volatile("s_waitcnt vmcnt(0)" ::: "memory"); __hip_atomic_fetch_add(ccnt + 64 * (item >> 3), 1u, __ATOMIC_RELAXED, __HIP_MEMORY_SCOPE_AGENT); } }
            }
            for (int round = 0;; ++round) {
                const int pc = (round & 1) ? (round + 1) * G - 1 - bx : round * G + bx;
                if (pc >= 384) break;
                const int kind = pc >> 7, xq = bx & 7, b = xq >> 2, h = xq & 3, qb = (bx & 127) >> 3;
                const size_t rowq = (size_t)b * SEQ + qb * 256, rowk = (size_t)b * SEQ;
                att::f32x16 o[4];
                __syncthreads();
                if (ON_DIFF && kind == 0) {
                    att::attn_body<64, false, QL64, SD64>(PROJ + rowq * NIN + PA_Q + h * 128, PROJ + rowk * NIN + PA_K + h * 128, PROJ + rowk * NIN + PA_V + h * 128, SEQ / 64, (char*)lds, C64, THR64, o, 0, 0, 0, 0.f);
                    { const int t2 = opaque_tid(); v4u* STv = (v4u*)((char*)lds + 69632) + t2;
#pragma unroll
                      for (int k = 0; k < 8; ++k) { const int d = k >> 1, r0 = 8 * (k & 1); v4u w;
                          w.x = att::cvtpk(o[d][r0], o[d][r0 + 1]); w.y = att::cvtpk(o[d][r0 + 2], o[d][r0 + 3]); w.z = att::cvtpk(o[d][r0 + 4], o[d][r0 + 5]); w.w = att::cvtpk(o[d][r0 + 6], o[d][r0 + 7]);
                          STv[k * 512] = w; } }
                    att::attn_body<64, false, QL64, SD64>(PROJ + rowq * NIN + PA_Q + h * 128 + 64, PROJ + rowk * NIN + PA_K + h * 128 + 64, PROJ + rowk * NIN + PA_V + h * 128, SEQ / 64, (char*)lds, C64, THR64, o, 0, 0, 0, 0.f);
                    { const int t3 = opaque_tid(), l3 = t3 & 63, r32 = l3 & 31; const v4u* STv = (const v4u*)((char*)lds + 69632) + t3;
                      const float* sg = p.diff_subln + l * 128;
                      float gsub[4], ss[16];
#pragma unroll
                      for (int d = 0; d < 4; ++d) gsub[d] = sg[32 * d + r32] * (1.0f - lam_init);
#pragma unroll
                      for (int r = 0; r < 16; ++r) ss[r] = 0.f;
#pragma unroll
                      for (int k = 0; k < 8; ++k) { const int d = k >> 1, r0 = 8 * (k & 1); const v4u w = STv[k * 512];
#pragma unroll
                          for (int i = 0; i < 4; ++i) { const unsigned wi = i == 0 ? w.x : (i == 1 ? w.y : (i == 2 ? w.z : w.w));
                              const float va = bf2f((unsigned short)(wi & 0xffffu)) - lam * o[d][r0 + 2 * i], vb = bf2f((unsigned short)(wi >> 16)) - lam * o[d][r0 + 2 * i + 1];
                              o[d][r0 + 2 * i] = va; o[d][r0 + 2 * i + 1] = vb; ss[r0 + 2 * i] += va * va; ss[r0 + 2 * i + 1] += vb * vb; } }
#pragma unroll
                      for (int r = 0; r < 16; ++r) { float q = ss[r]; q += __shfl_xor(q, 1); q += __shfl_xor(q, 2); q += __shfl_xor(q, 4); q += __shfl_xor(q, 8); q += __shfl_xor(q, 16);
                          const float rstd = 1.0f / sqrtf(q * (1.0f / 128.0f) + EPS);
#pragma unroll
                          for (int d = 0; d < 4; ++d) o[d][r] *= rstd * gsub[d]; } }
                    store_o_bf16(o, CAT + rowq * DM + h * 128, lds);
                } else if (ON_GQA && kind == 1) {
                    att::attn_body<128, false, QL128, SD128>(PROJ + rowq * NIN + PC_Q + h * 128, PROJ + rowk * NIN + PC_K + (h >> 1) * 128, PROJ + rowk * NIN + PC_V + (h >> 1) * 128, SEQ / 64, (char*)lds, C128, THR128, o, 0, 0, 0, 0.f);
                    store_o_bf16(o, CAT + rowq * DM + 1024 + h * 128, lds);
                } else if (ON_NA) {
                    { const float* rsrc = p.na_rpb + (size_t)(l * 4 + h) * 465; float* rdst = (float*)((char*)lds + att::RPB_OFF); for (int e = tid; e < 465; e += NTHR) rdst[e] = rsrc[e]; }
                    int krow0 = 4 * qb - 4; krow0 = krow0 < 0 ? 0 : (krow0 > 52 ? 52 : krow0);
                    const size_t rowkn = rowk + (size_t)krow0 * 64;
                    att::attn_body<128, true, QL128, SDNA>(PROJ + rowq * NIN + PD_Q + h * 128, PROJ + rowkn * NIN + PD_K + h * 128, PROJ + rowkn * NIN + PD_V + h * 128, 12, (char*)lds, C128, THR128, o,
                                              krow0, 4 * qb + (wave >> 1), (wave & 1) * 32 + r32, 11.313708498984761f);
                    store_o_bf16(o, CAT + rowq * DM + 1536 + h * 128, lds);
                }
            }
            __syncthreads();
            if (G - 1 - bx < 64) {
                if (tid == 0) { unsigned sp = 0; while (__hip_atomic_load(ccnt + 64 * ((G - 1 - bx) >> 1), __ATOMIC_RELAXED, __HIP_MEMORY_SCOPE_AGENT) < 8u) { __builtin_amdgcn_s_sleep(2); if (++sp > (1u << 24)) break; }
                    __builtin_amdgcn_fence(__ATOMIC_ACQUIRE, "agent"); asm volatile("s_waitcnt vmcnt(0)" ::: "memory"); }
                __syncthreads();
            }
            { pg8::Gemm g{CV, WPW + (size_t)l * CC * CC, M, CC, CC}; pg8::StrideOrder S{G - 1 - bx, G, 64, 2};
              pg8::EpiBf16<0> E{CAT + 512, DM, p.conv_pw_b + l * CC, 0, 0, 1.f};
              pg8::gemm_phase<pg8::EpiBf16<0>, pg8::StrideOrder, true, true>(ldsl, g, S, E); }
        }
        GSYNC();

        { pg8::Gemm g{CAT, WOUT + (size_t)l * DM * DM, M, DM, DM}; pg8::StaticOrder S; S.init(M, DM, G, bx);
          pg8::EpiRmsFused E{XB, nullptr, XB, XN, p.norm_mix_post + l * DM, p.norm_ffn_pre + l * DM, XSLOT + (size_t)(l * 2 + 0) * 131072, CTL + 16384 + (l * 2 + 0) * 2048};
          pg8::gemm_phase<pg8::EpiRmsFused, pg8::StaticOrder, false, true>(ldsl, g, S, E); }
        GSYNC();
        _Pragma("unroll") for (int rg = 0; rg < REP_GEMM; ++rg) { pg8::Gemm g{XN, WGU + (size_t)l * 2 * FF * DM, M, 2 * FF, DM}; pg8::StaticOrder S; S.init(M, 2 * FF, G, bx);
          pg8::EpiSwiGLU E{HB, FF};
          pg8::gemm_phase<pg8::EpiSwiGLU, pg8::StaticOrder, true, true>(ldsl, g, S, E); }
        tail_convert(p, ws, l == 0 ? 1 : 3, ldsl, bx);
        GSYNC();
        { pg8::Gemm g{HB, WDN + (size_t)l * DM * FF, M, DM, FF}; pg8::StaticOrder S; S.init(M, DM, G, bx);
          pg8::EpiRmsFused E{XB, l + 1 < DEPTH ? nullptr : p.out, XB, XN, p.norm_ffn_post + l * DM, l + 1 < DEPTH ? p.norm_mix_pre + (l + 1) * DM : nullptr, XSLOT + (size_t)(l * 2 + 1) * 131072, CTL + 16384 + (l * 2 + 1) * 2048};
          pg8::gemm_phase<pg8::EpiRmsFused, pg8::StaticOrder, false, true>(ldsl, g, S, E); }
        if (l + 1 < DEPTH) GSYNC();
    }
}

extern "C" void kernel_launch(void* const* d_in, const int* in_sizes, int n_in, void* d_out, int out_size, void* d_ws, size_t ws_size, hipStream_t stream) {
    static int grid = 0;
    if (grid == 0) {
        if (n_in != 21 || out_size != M * DM || ws_size < WS_END) { fprintf(stderr, "kernel_launch: unexpected shapes: n_in %d out %d ws %zu (need %zu)\n", n_in, out_size, ws_size, (size_t)WS_END); grid = -1; return; }
        int dev = 0, cus = 0, per_cu = 0;
        if (hipGetDevice(&dev) != hipSuccess || hipDeviceGetAttribute(&cus, hipDeviceAttributeMultiprocessorCount, dev) != hipSuccess) { fprintf(stderr, "kernel_launch: device query failed\n"); grid = -1; return; }
        if (hipFuncSetAttribute((const void*)mega_fwd, hipFuncAttributeMaxDynamicSharedMemorySize, LDS_BYTES) != hipSuccess) { fprintf(stderr, "kernel_launch: hipFuncSetAttribute failed\n"); grid = -1; return; }
        if (hipOccupancyMaxActiveBlocksPerMultiprocessor(&per_cu, (const void*)mega_fwd, NTHR, LDS_BYTES) != hipSuccess || per_cu < 1) { fprintf(stderr, "kernel_launch: occupancy query says %d\n", per_cu); (void)hipGetLastError(); per_cu = 1; }
        grid = cus * per_cu;
        if (grid < 256) { fprintf(stderr, "kernel_launch: needs 256 co-resident workgroups, device offers %d\n", grid); grid = -1; return; }
        grid = 256;
    }
    if (grid < 0) return;
    if (hipMemsetAsync(d_ws, 0, 196608, stream) != hipSuccess) { fprintf(stderr, "kernel_launch: memset failed\n"); return; }
    Params p{};
    const float** pp = (const float**)&p;
    for (int i = 0; i < 21; ++i) pp[i] = (const float*)d_in[i];
    p.out = (float*)d_out; p.ws = (unsigned char*)d_ws;
    void* args[] = {&p};
    hipError_t e = hipLaunchCooperativeKernel((const void*)mega_fwd, dim3(grid), dim3(NTHR), args, LDS_BYTES, stream);
    if (e != hipSuccess) fprintf(stderr, "cooperative launch failed: %s (grid %d)\n", hipGetErrorString(e), grid);
}
```

```cpp
#include <hip/hip_runtime.h>
#include <hip/hip_cooperative_groups.h>
#include <cstdio>
#include <cstdint>
namespace cg = cooperative_groups;
__device__ __forceinline__ int opaque_tid() { int t = threadIdx.x; asm volatile("" : "+v"(t)); return t; }
namespace pg8 {
#define PG8_LAS __attribute__((address_space(3)))
typedef unsigned short bf16_t;
typedef short bf16x8 __attribute__((ext_vector_type(8)));
typedef float f32x4 __attribute__((ext_vector_type(4)));
typedef unsigned u32x4 __attribute__((ext_vector_type(4)));
constexpr int BM = 256, BK = 64, HALF = 128, HTB = HALF * BK * 2  , STAGE_BYTES = 8 * HTB, NXCD = 8, WGM = 8;

__host__ __device__ __forceinline__ int lds_byte(int r, int c) { const int st = (r >> 4) * 2 + (c >> 5), rr = r & 15, cc = c & 31, ob = rr * 64 + cc * 2; return st * 1024 + (ob ^ (((ob >> 9) & 1) << 5)); }
__host__ __device__ __forceinline__ void stage_rc(int b, int& R, int& C) { const int st = b / 1024, sb = b % 1024, swz = sb ^ (((sb >> 9) & 1) << 5); R = (st >> 1) * 16 + swz / 64; C = (st & 1) * 32 + (swz % 64) / 2; }
__host__ __device__ __forceinline__ int perm32(int rho) { const int n = rho >> 4, i = rho & 15; return 8 * (i >> 2) + 4 * n + (i & 3); }

struct Unit { int pm, pn; };
struct Gemm { const bf16_t* A; const bf16_t* Bt; int M, N, K; };

struct StaticOrder {
    int nM, nN, nwg, G, c;
    __host__ __device__ void init(int M, int N, int G_, int c_) { nM = M / BM; nN = N / BM; nwg = nM * nN; G = G_; c = c_; }
    __host__ __device__ bool next(int i, Unit& u) const {
        const long L = (long)i * G + c; if (L >= nwg) return false;
        int wgid = (int)L; { const int q = nwg / NXCD, r = nwg % NXCD, xcd = wgid % NXCD, off = wgid / NXCD; wgid = (xcd < r ? xcd * (q + 1) : r * (q + 1) + (xcd - r) * q) + off; }
        const int nig = WGM * nN, gid = wgid / nig, fm = gid * WGM, gsz = (nM - fm) < WGM ? (nM - fm) : WGM;
        u.pm = fm + ((wgid % nig) % gsz); u.pn = (wgid % nig) / gsz; return true;
    }
    __device__ __forceinline__ void a_ready(const Unit&) const {}
    __device__ __forceinline__ void done(const Unit&) const {}
};

__device__ __forceinline__ unsigned cvt_pk_bf16(float lo, float hi) { unsigned r; asm volatile("v_cvt_pk_bf16_f32 %0, %1, %2" : "=v"(r) : "v"(lo), "v"(hi)); return r; }
typedef float f32x2 __attribute__((ext_vector_type(2)));
__device__ __forceinline__ f32x2 gelu_pk(f32x2 v) {
    const f32x2 av = __builtin_elementwise_abs(v), d = av * 0.2316418882f + 1.0f;
    f32x2 t; t.x = __builtin_amdgcn_rcpf(d.x); t.y = __builtin_amdgcn_rcpf(d.y);
    f32x2 q = t * 0.5307027145f + (-0.7265760135f); q = q * t + 0.7107068705f; q = q * t + (-0.142248368f); q = q * t + 0.127414796f; q = q * t;
    const f32x2 s = (v * v) * (-0.72134752044f);
    f32x2 e; e.x = __builtin_amdgcn_exp2f(s.x); e.y = __builtin_amdgcn_exp2f(s.y);
    const f32x2 m = v * (q * e), r = v - m;
    f32x2 o; o.x = v.x < 0.f ? m.x : r.x; o.y = v.y < 0.f ? m.y : r.y; return o;
}

template <int ACT  > struct EpiBf16 {
    static constexpr bool PERM = true, AFTER_DRAIN = false; static_assert(ACT == 0 || ACT == 1, "EpiBf16: ACT is 0 (none) or 1 (gelu_pk)");
    bf16_t* O; int ldc; const float* bias; int split_cols; size_t split_stride; float scale0;
    __device__ __forceinline__ void operator()(const f32x4 (&acc)[2][2][4][2], const Unit& u, int wr, int wc, int fr, int fq) const {
        const int row0 = u.pm * BM + wr * 64 + fr; int colt = u.pn * BM; bf16_t* base = O;
        float sc = 1.f; if (split_cols) { const int t = colt / split_cols; base += (size_t)t * split_stride; colt -= t * split_cols; if (t == 0) sc = scale0; }
        const int col0 = colt + wc * 32 + 8 * fq, bcol0 = u.pn * BM + wc * 32 + 8 * fq;
        f32x4 bv[2][2];
#pragma unroll
        for (int bj = 0; bj < 2; ++bj)
#pragma unroll
            for (int n = 0; n < 2; ++n) bv[bj][n] = bias ? *(const f32x4*)(bias + bcol0 + bj * HALF + 4 * n) : (f32x4){0.f, 0.f, 0.f, 0.f};
#pragma unroll
        for (int ai = 0; ai < 2; ++ai)
#pragma unroll
            for (int m = 0; m < 4; ++m) { bf16_t* rowp = base + (size_t)(row0 + ai * HALF + m * 16) * ldc + col0;
#pragma unroll
                for (int bj = 0; bj < 2; ++bj) { f32x4 v0 = acc[ai][bj][m][0] + bv[bj][0], v1 = acc[ai][bj][m][1] + bv[bj][1];
                    if (ACT == 1) { f32x2 a = gelu_pk((f32x2){v0[0], v0[1]}), b = gelu_pk((f32x2){v0[2], v0[3]}), c = gelu_pk((f32x2){v1[0], v1[1]}), d = gelu_pk((f32x2){v1[2], v1[3]});
                        v0 = (f32x4){a.x, a.y, b.x, b.y}; v1 = (f32x4){c.x, c.y, d.x, d.y}; }
                    v0 = v0 * sc; v1 = v1 * sc; u32x4 w; w.x = cvt_pk_bf16(v0[0], v0[1]); w.y = cvt_pk_bf16(v0[2], v0[3]); w.z = cvt_pk_bf16(v1[0], v1[1]); w.w = cvt_pk_bf16(v1[2], v1[3]);
                    *(u32x4*)(rowp + bj * HALF) = w; } }
    }
};
struct EpiF32 {
    static constexpr bool PERM = false, AFTER_DRAIN = false;
    float* O; int ldc;
    __device__ __forceinline__ void operator()(const f32x4 (&acc)[2][2][4][2], const Unit& u, int wr, int wc, int fr, int fq) const {
        const int row0 = u.pm * BM + wr * 64 + fr, col0 = u.pn * BM + wc * 32 + 4 * fq;
#pragma unroll
        for (int ai = 0; ai < 2; ++ai)
#pragma unroll
            for (int m = 0; m < 4; ++m) { float* rowp = O + (size_t)(row0 + ai * HALF + m * 16) * ldc + col0;
#pragma unroll
                for (int bj = 0; bj < 2; ++bj)
#pragma unroll
                    for (int n = 0; n < 2; ++n) *(f32x4*)(rowp + bj * HALF + n * 16) = acc[ai][bj][m][n]; }
    }
};
__device__ __forceinline__ float swiglu1(float g, float u) { return g * u * __builtin_amdgcn_rcpf(1.0f + __expf(-g)); }
struct EpiSwiGLU {
    static constexpr bool PERM = true, AFTER_DRAIN = false;
    bf16_t* O; int ldc;
    __device__ __forceinline__ void operator()(const f32x4 (&acc)[2][2][4][2], const Unit& u, int wr, int wc, int fr, int fq) const {
        const int row0 = u.pm * BM + wr * 64 + fr, col0 = u.pn * HALF + wc * 32 + 8 * fq;
#pragma unroll
        for (int ai = 0; ai < 2; ++ai)
#pragma unroll
            for (int m = 0; m < 4; ++m) { bf16_t* rowp = O + (size_t)(row0 + ai * HALF + m * 16) * ldc + col0;
                const f32x4 g0 = acc[ai][0][m][0], g1 = acc[ai][0][m][1], u0 = acc[ai][1][m][0], u1 = acc[ai][1][m][1];
                u32x4 w; w.x = cvt_pk_bf16(swiglu1(g0[0], u0[0]), swiglu1(g0[1], u0[1])); w.y = cvt_pk_bf16(swiglu1(g0[2], u0[2]), swiglu1(g0[3], u0[3]));
                w.z = cvt_pk_bf16(swiglu1(g1[0], u1[0]), swiglu1(g1[1], u1[1])); w.w = cvt_pk_bf16(swiglu1(g1[2], u1[2]), swiglu1(g1[3], u1[3]));
                *(u32x4*)rowp = w; }
    }
};

struct PanelSS {
    unsigned* xbuf;
    unsigned* cnt;
    float inv_n, eps;
    __device__ __forceinline__ void run(const f32x4 (&v)[2][2][4][2], const Unit& u, int wr, int wc, int fr, int fq, PG8_LAS unsigned char* lds, int wid, int lane) const {
        PG8_LAS float* P = (PG8_LAS float*)lds;
        PG8_LAS float* S = (PG8_LAS float*)(lds + 4096);
#pragma unroll
        for (int ai = 0; ai < 2; ++ai)
#pragma unroll
            for (int m = 0; m < 4; ++m) {
                float q = 0.f;
#pragma unroll
                for (int bj = 0; bj < 2; ++bj)
#pragma unroll
                    for (int n = 0; n < 2; ++n) { const f32x4 x = v[ai][bj][m][n]; q += (x[0] * x[0] + x[1] * x[1]) + (x[2] * x[2] + x[3] * x[3]); }
                q += __shfl_xor(q, 16); q += __shfl_xor(q, 32);
                if (fq == 0) P[(ai * HALF + wr * 64 + m * 16 + fr) * 4 + wc] = q;
            }
        asm volatile("s_waitcnt lgkmcnt(0)" ::: "memory"); __builtin_amdgcn_s_barrier(); asm volatile("" ::: "memory");
        const int row = wid * 32 + (lane & 31);
        unsigned* slot = xbuf + ((size_t)(u.pm * BM + row) * 8);
        if (lane < 32) { const float q = (P[row * 4 + 0] + P[row * 4 + 1]) + (P[row * 4 + 2] + P[row * 4 + 3]);
            __hip_atomic_store(slot + u.pn, __float_as_uint(q), __ATOMIC_RELAXED, __HIP_MEMORY_SCOPE_AGENT); }
        asm volatile("s_waitcnt vmcnt(0)" ::: "memory");
        if (lane == 0) __hip_atomic_fetch_add(cnt + 64 * u.pm, 1u, __ATOMIC_RELAXED, __HIP_MEMORY_SCOPE_AGENT);
        if (wid == 0) {
            unsigned sp = 0;
            while ((unsigned)__builtin_amdgcn_readfirstlane(__hip_atomic_load(cnt + 64 * u.pm, __ATOMIC_RELAXED, __HIP_MEMORY_SCOPE_AGENT)) < 64u) { __builtin_amdgcn_s_sleep(2); if (++sp > (1u << 22)) break; }
            __builtin_amdgcn_fence(__ATOMIC_ACQUIRE, "agent");
        }
        asm volatile("s_waitcnt vmcnt(0) lgkmcnt(0)" ::: "memory"); __builtin_amdgcn_s_barrier(); asm volatile("" ::: "memory");
        if (lane < 32) { float q = 0.f;
#pragma unroll
            for (int t = 0; t < 8; ++t) q += __uint_as_float(__hip_atomic_load(slot + t, __ATOMIC_RELAXED, __HIP_MEMORY_SCOPE_AGENT));
            S[row] = 1.0f / sqrtf(q * inv_n + eps); }
        asm volatile("s_waitcnt lgkmcnt(0)" ::: "memory"); __builtin_amdgcn_s_barrier(); asm volatile("" ::: "memory");
    }
};
struct EpiRmsResRms {
    static constexpr bool PERM = false, AFTER_DRAIN = true;
    const float* base; float* out; bf16_t* xn; int ldc; const float* g1; const float* g2; PanelSS st1, st2;
    __device__ __forceinline__ void operator()(const f32x4 (&)[2][2][4][2], const Unit&, int, int, int, int) const {}
    __device__ __forceinline__ void fused(f32x4 (&acc)[2][2][4][2], const Unit& u, int wr, int wc, int fr, int fq, PG8_LAS unsigned char* lds, int wid, int lane) const {
        typedef unsigned u32x2v __attribute__((ext_vector_type(2)));
        const PG8_LAS float* S = (const PG8_LAS float*)(lds + 4096);
        const int col0 = u.pn * BM + wc * 32 + 4 * fq;
        st1.run(acc, u, wr, wc, fr, fq, lds, wid, lane);
        {
            f32x4 gv[2][2];
#pragma unroll
            for (int bj = 0; bj < 2; ++bj)
#pragma unroll
                for (int n = 0; n < 2; ++n) gv[bj][n] = *(const f32x4*)(g1 + col0 + bj * HALF + n * 16);
#pragma unroll
            for (int ai = 0; ai < 2; ++ai)
#pragma unroll
                for (int m = 0; m < 4; ++m) { const int r = ai * HALF + wr * 64 + m * 16 + fr; const float sr = S[r]; const size_t off = (size_t)(u.pm * BM + r) * ldc + col0;
#pragma unroll
                    for (int bj = 0; bj < 2; ++bj)
#pragma unroll
                        for (int n = 0; n < 2; ++n) { const f32x4 bs = *(const f32x4*)(base + off + bj * HALF + n * 16); acc[ai][bj][m][n] = bs + acc[ai][bj][m][n] * sr * gv[bj][n]; }
                    asm volatile("" : "+v"(acc[ai][0][m][0]), "+v"(acc[ai][0][m][1]), "+v"(acc[ai][1][m][0]), "+v"(acc[ai][1][m][1]));
                    if (m & 1) asm volatile("" ::: "memory"); }
        }
        if (g2) {
            st2.run(acc, u, wr, wc, fr, fq, lds, wid, lane);
            f32x4 gv[2][2];
#pragma unroll
            for (int bj = 0; bj < 2; ++bj)
#pragma unroll
                for (int n = 0; n < 2; ++n) gv[bj][n] = *(const f32x4*)(g2 + col0 + bj * HALF + n * 16);
#pragma unroll
            for (int ai = 0; ai < 2; ++ai)
#pragma unroll
                for (int m = 0; m < 4; ++m) { const int r = ai * HALF + wr * 64 + m * 16 + fr; const float sr = S[r]; const size_t off = (size_t)(u.pm * BM + r) * ldc + col0;
#pragma unroll
                    for (int bj = 0; bj < 2; ++bj)
#pragma unroll
                        for (int n = 0; n < 2; ++n) { const f32x4 x1 = acc[ai][bj][m][n]; *(f32x4*)(out + off + bj * HALF + n * 16) = x1;
                            const f32x4 o = x1 * sr * gv[bj][n]; u32x2v w; w.x = cvt_pk_bf16(o[0], o[1]); w.y = cvt_pk_bf16(o[2], o[3]);
                            *(u32x2v*)(xn + off + bj * HALF + n * 16) = w; }
                    asm volatile("" ::: "memory"); }
        } else {
#pragma unroll
            for (int ai = 0; ai < 2; ++ai)
#pragma unroll
                for (int m = 0; m < 4; ++m) { const int r = ai * HALF + wr * 64 + m * 16 + fr; const size_t off = (size_t)(u.pm * BM + r) * ldc + col0;
#pragma unroll
                    for (int bj = 0; bj < 2; ++bj)
#pragma unroll
                        for (int n = 0; n < 2; ++n) *(f32x4*)(out + off + bj * HALF + n * 16) = acc[ai][bj][m][n]; }
        }
    }
};

__device__ __forceinline__ float bflo(unsigned w) { return __builtin_bit_cast(float, w << 16); }
__device__ __forceinline__ float bfhi(unsigned w) { return __builtin_bit_cast(float, w & 0xffff0000u); }
struct EpiRmsFused {
    static constexpr bool PERM = true, AFTER_DRAIN = true;
    const bf16_t* base_b;
    float* out_f; bf16_t* out_b;
    bf16_t* xn; const float* g1; const float* g2;
    unsigned long long* xbuf;
    unsigned* cnt;
    __device__ __forceinline__ void operator()(const f32x4 (&)[2][2][4][2], const Unit&, int, int, int, int) const {}
    __device__ __forceinline__ void fused(f32x4 (&acc)[2][2][4][2], const Unit& u, int wr, int wc, int fr, int fq, PG8_LAS unsigned char* lds, int wid, int lane) const {
        typedef unsigned u32x2v __attribute__((ext_vector_type(2)));
        constexpr int ldc = 2048; constexpr float inv_n = 1.0f / 2048.0f, eps = 1e-6f;
        PG8_LAS f32x4* P = (PG8_LAS f32x4*)(lds + 131072);
        PG8_LAS float* S = (PG8_LAS float*)(lds + 131072 + 16384);
        const int col0 = u.pn * BM + wc * 32 + 8 * fq;
        f32x4 gv[2][2];
#pragma unroll
        for (int bj = 0; bj < 2; ++bj)
#pragma unroll
            for (int n = 0; n < 2; ++n) gv[bj][n] = *(const f32x4*)(g1 + col0 + bj * HALF + n * 4);
        PG8_LAS u32x4* XL = (PG8_LAS u32x4*)lds + (wid * 64 + lane);
#pragma unroll
        for (int ai = 0; ai < 2; ++ai)
#pragma unroll
            for (int m = 0; m < 4; ++m) { const size_t off = (size_t)(u.pm * BM + ai * HALF + wr * 64 + m * 16 + fr) * ldc + col0;
#pragma unroll
                for (int bj = 0; bj < 2; ++bj) XL[((ai * 4 + m) * 2 + bj) * 512] = *(const u32x4*)(base_b + off + bj * HALF); }
#pragma unroll
        for (int ai = 0; ai < 2; ++ai)
#pragma unroll
            for (int m = 0; m < 4; ++m) {
                float saa = 0.f, sxx = 0.f, sxag = 0.f, sgg = 0.f;
#pragma unroll
                for (int bj = 0; bj < 2; ++bj) { const u32x4 w4 = XL[((ai * 4 + m) * 2 + bj) * 512];
#pragma unroll
                    for (int n = 0; n < 2; ++n) { const f32x4 a = acc[ai][bj][m][n]; const f32x4 ag = a * gv[bj][n]; const unsigned wx = n == 0 ? w4.x : w4.z, wy = n == 0 ? w4.y : w4.w;
                        const f32x4 x = (f32x4){bflo(wx), bfhi(wx), bflo(wy), bfhi(wy)};
                        saa += (a[0] * a[0] + a[1] * a[1]) + (a[2] * a[2] + a[3] * a[3]); sxx += (x[0] * x[0] + x[1] * x[1]) + (x[2] * x[2] + x[3] * x[3]);
                        sxag += (x[0] * ag[0] + x[1] * ag[1]) + (x[2] * ag[2] + x[3] * ag[3]); sgg += (ag[0] * ag[0] + ag[1] * ag[1]) + (ag[2] * ag[2] + ag[3] * ag[3]); } }
                asm volatile("" : "+v"(saa), "+v"(sxx), "+v"(sxag), "+v"(sgg));
                saa += __shfl_xor(saa, 16); sxx += __shfl_xor(sxx, 16); sxag += __shfl_xor(sxag, 16); sgg += __shfl_xor(sgg, 16);
                saa += __shfl_xor(saa, 32); sxx += __shfl_xor(sxx, 32); sxag += __shfl_xor(sxag, 32); sgg += __shfl_xor(sgg, 32);
                if (fq == 0) P[(ai * HALF + wr * 64 + m * 16 + fr) * 4 + wc] = (f32x4){saa, sxx, sxag, sgg};
                __builtin_amdgcn_sched_barrier(0);
            }
        asm volatile("s_waitcnt lgkmcnt(0)" ::: "memory"); __builtin_amdgcn_s_barrier(); asm volatile("" ::: "memory");
        const int row = wid * 32 + (lane & 31);
        unsigned long long* slot = xbuf + ((size_t)(u.pm * BM + row) * 8) * 2;
        if (lane < 32) { const f32x4 q = (P[row * 4 + 0] + P[row * 4 + 1]) + (P[row * 4 + 2] + P[row * 4 + 3]);
            __hip_atomic_store(slot + u.pn * 2, ((unsigned long long)__float_as_uint(q[1]) << 32) | __float_as_uint(q[0]), __ATOMIC_RELAXED, __HIP_MEMORY_SCOPE_AGENT);
            __hip_atomic_store(slot + u.pn * 2 + 1, ((unsigned long long)__float_as_uint(q[3]) << 32) | __float_as_uint(q[2]), __ATOMIC_RELAXED, __HIP_MEMORY_SCOPE_AGENT); }
        asm volatile("s_waitcnt vmcnt(0)" ::: "memory"); __builtin_amdgcn_s_barrier(); asm volatile("" ::: "memory");
        if (wid == 0) {
            if (lane == 0) __hip_atomic_fetch_add(cnt + 64 * u.pm, 1u, __ATOMIC_RELAXED, __HIP_MEMORY_SCOPE_AGENT);
            unsigned sp = 0;
            while ((unsigned)__builtin_amdgcn_readfirstlane(__hip_atomic_load(cnt + 64 * u.pm, __ATOMIC_RELAXED, __HIP_MEMORY_SCOPE_AGENT)) < 8u) { __builtin_amdgcn_s_sleep(1); if (++sp > (1u << 22)) break; }
            __builtin_amdgcn_fence(__ATOMIC_ACQUIRE, "agent");
        }
        asm volatile("s_waitcnt vmcnt(0) lgkmcnt(0)" ::: "memory"); __builtin_amdgcn_s_barrier(); asm volatile("" ::: "memory");
        if (lane < 32) { float saa = 0.f, sxx = 0.f, sxag = 0.f, sgg = 0.f;
#pragma unroll
            for (int t = 0; t < 8; ++t) { const unsigned long long w0 = __hip_atomic_load(slot + t * 2, __ATOMIC_RELAXED, __HIP_MEMORY_SCOPE_AGENT), w1 = __hip_atomic_load(slot + t * 2 + 1, __ATOMIC_RELAXED, __HIP_MEMORY_SCOPE_AGENT);
                saa += __uint_as_float((unsigned)w0); sxx += __uint_as_float((unsigned)(w0 >> 32)); sxag += __uint_as_float((unsigned)w1); sgg += __uint_as_float((unsigned)(w1 >> 32)); }
            const float r1 = 1.0f / sqrtf(saa * inv_n + eps);
            float s1 = sxx + 2.0f * r1 * sxag + r1 * r1 * sgg; s1 = s1 < 0.f ? 0.f : s1;
            S[row * 2] = r1; S[row * 2 + 1] = 1.0f / sqrtf(s1 * inv_n + eps); }
        asm volatile("s_waitcnt lgkmcnt(0)" ::: "memory"); __builtin_amdgcn_s_barrier(); asm volatile("" ::: "memory");
        int fr2 = fr, col2 = col0; asm volatile("" : "+v"(fr2), "+v"(col2));
        f32x4 g2v[2][2], g1v[2][2];
#pragma unroll
        for (int bj = 0; bj < 2; ++bj)
#pragma unroll
            for (int n = 0; n < 2; ++n) { g2v[bj][n] = g2 ? *(const f32x4*)(g2 + col2 + bj * HALF + n * 4) : (f32x4){0.f, 0.f, 0.f, 0.f}; g1v[bj][n] = *(const f32x4*)(g1 + col2 + bj * HALF + n * 4); }
#pragma unroll
        for (int ai = 0; ai < 2; ++ai)
#pragma unroll
            for (int m = 0; m < 4; ++m) { const int r = ai * HALF + wr * 64 + m * 16 + fr2; const float r1 = S[r * 2], r2 = S[r * 2 + 1]; const size_t off = (size_t)(u.pm * BM + r) * ldc + col2;
#pragma unroll
                for (int bj = 0; bj < 2; ++bj) { u32x4 w4 = XL[((ai * 4 + m) * 2 + bj) * 512]; asm volatile("" : "+v"(w4.x), "+v"(w4.y), "+v"(w4.z), "+v"(w4.w));
                    const f32x4 xa = (f32x4){bflo(w4.x), bfhi(w4.x), bflo(w4.y), bfhi(w4.y)}, xb = (f32x4){bflo(w4.z), bfhi(w4.z), bflo(w4.w), bfhi(w4.w)};
                    const f32x4 x1a = xa + acc[ai][bj][m][0] * r1 * g1v[bj][0], x1b = xb + acc[ai][bj][m][1] * r1 * g1v[bj][1];
                    if (out_f) { *(f32x4*)(out_f + off + bj * HALF) = x1a; *(f32x4*)(out_f + off + bj * HALF + 4) = x1b; }
                    else { u32x4 o; o.x = cvt_pk_bf16(x1a[0], x1a[1]); o.y = cvt_pk_bf16(x1a[2], x1a[3]); o.z = cvt_pk_bf16(x1b[0], x1b[1]); o.w = cvt_pk_bf16(x1b[2], x1b[3]); *(u32x4*)(out_b + off + bj * HALF) = o; }
                    if (g2) { const f32x4 ya = x1a * r2 * g2v[bj][0], yb = x1b * r2 * g2v[bj][1]; u32x4 o; o.x = cvt_pk_bf16(ya[0], ya[1]); o.y = cvt_pk_bf16(ya[2], ya[3]); o.z = cvt_pk_bf16(yb[0], yb[1]); o.w = cvt_pk_bf16(yb[2], yb[3]);
                        *(u32x4*)(xn + off + bj * HALF) = o; } }
                asm volatile("" ::: "memory"); __builtin_amdgcn_sched_barrier(0); }
    }
};

struct EpiProj {
    static constexpr bool PERM = true, AFTER_DRAIN = false;
    bf16_t* O; int ldc; const float* rope; const float* qn; const float* kn; PG8_LAS float* X;
    __device__ __forceinline__ void operator()(const f32x4 (&acc)[2][2][4][2], const Unit& u, int wr, int wc, int fr_, int fq_) const {
        int fr = fr_, fq = fq_; asm volatile("" : "+v"(fr), "+v"(fq));
        const int pn = u.pn, kind = pn < 4 ? 1 : ((pn >= 10 && pn <= 12) ? 2 : 0);
        if (kind == 0) {
            const int row0 = u.pm * BM + wr * 64 + fr, col0 = pn * BM + wc * 32 + 8 * fq;
#pragma unroll
            for (int ai = 0; ai < 2; ++ai)
#pragma unroll
                for (int m = 0; m < 4; ++m) { bf16_t* rowp = O + (size_t)(row0 + ai * HALF + m * 16) * ldc + col0;
#pragma unroll
                    for (int bj = 0; bj < 2; ++bj) { const f32x4 v0 = acc[ai][bj][m][0], v1 = acc[ai][bj][m][1];
                        u32x4 w; w.x = cvt_pk_bf16(v0[0], v0[1]); w.y = cvt_pk_bf16(v0[2], v0[3]); w.z = cvt_pk_bf16(v1[0], v1[1]); w.w = cvt_pk_bf16(v1[2], v1[3]);
                        *(u32x4*)(rowp + bj * HALF) = w; } }
            return;
        }
        const int i0 = 8 * fq, c1 = pn * BM + 64 * wc + i0;
        float frev[8];
#pragma unroll
        for (int k = 0; k < 8; ++k) { constexpr float FK[8] = {0.15915494309189535f, 0.11934937021124886f, 0.08949940160889104f, 0.06711508300522727f, 0.05032921210448705f, 0.037741584717419785f, 0.02830219583062341f, 0.02122365276477767f};
            frev[k] = FK[k] * (fq == 0 ? 1.0f : (fq == 1 ? 0.1f : (fq == 2 ? 0.01f : 0.001f))); }
        f32x4 ga[2], gb[2];
        if (kind == 2) { const float* gn = (pn == 12 ? kn : qn) + 64 * (wc & 1) + i0;
            ga[0] = *(const f32x4*)gn; ga[1] = *(const f32x4*)(gn + 4); gb[0] = *(const f32x4*)(gn + 32); gb[1] = *(const f32x4*)(gn + 36);
#pragma unroll
            for (int ai = 0; ai < 2; ++ai)
#pragma unroll
                for (int m = 0; m < 4; ++m) { float q = 0.f;
#pragma unroll
                    for (int bj = 0; bj < 2; ++bj)
#pragma unroll
                        for (int n = 0; n < 2; ++n) { const f32x4 x = acc[ai][bj][m][n]; q += (x[0] * x[0] + x[1] * x[1]) + (x[2] * x[2] + x[3] * x[3]); }
                    q += __shfl_xor(q, 16); q += __shfl_xor(q, 32);
                    if (fq == 0) X[(ai * HALF + wr * 64 + m * 16 + fr) * 4 + wc] = q; }
            asm volatile("s_waitcnt lgkmcnt(0)" ::: "memory"); __builtin_amdgcn_s_barrier(); asm volatile("" ::: "memory");
        } else { ga[0] = ga[1] = gb[0] = gb[1] = (f32x4){1.f, 1.f, 1.f, 1.f}; }
#pragma unroll
        for (int ai = 0; ai < 2; ++ai)
#pragma unroll
            for (int m = 0; m < 4; ++m) { const int r = ai * HALF + wr * 64 + m * 16 + fr, row = u.pm * BM + r, t = row & 4095;
                const int pos = kind == 1 ? t : ((wc & 1) ? (t & 63) : (t >> 6));
                const float fpos = (float)pos;
                float rs = 1.f;
                if (kind == 2) rs = 1.0f / sqrtf((X[r * 4 + wc] + X[r * 4 + (wc ^ 1)]) * (1.0f / 128.0f) + 1e-6f);
                u32x4 w1, w2;
#pragma unroll
                for (int n = 0; n < 2; ++n) {
                    f32x4 c, sn;
#pragma unroll
                    for (int j = 0; j < 4; ++j) { const float rev = __builtin_amdgcn_fractf(fpos * frev[4 * n + j]); c[j] = __builtin_amdgcn_cosf(rev); sn[j] = __builtin_amdgcn_sinf(rev); }
                    const f32x4 a = acc[ai][0][m][n] * rs * ga[n], b = acc[ai][1][m][n] * rs * gb[n];
                    const f32x4 o1 = a * c - b * sn, o2 = a * sn + b * c;
                    if (n == 0) { w1.x = cvt_pk_bf16(o1[0], o1[1]); w1.y = cvt_pk_bf16(o1[2], o1[3]); w2.x = cvt_pk_bf16(o2[0], o2[1]); w2.y = cvt_pk_bf16(o2[2], o2[3]); }
                    else { w1.z = cvt_pk_bf16(o1[0], o1[1]); w1.w = cvt_pk_bf16(o1[2], o1[3]); w2.z = cvt_pk_bf16(o2[0], o2[1]); w2.w = cvt_pk_bf16(o2[2], o2[3]); }
                }
                bf16_t* rowp = O + (size_t)row * ldc + c1;
                *(u32x4*)rowp = w1;
                *(u32x4*)(rowp + 32) = w2; __builtin_amdgcn_sched_barrier(0); }
    }
};
struct StrideOrder {
    int first, G, count, nN;
    __device__ bool next(int i, Unit& u) const { const int j = first + i * G; if (j >= count) return false; u.pm = j / nN; u.pn = j % nN; return true; }
    __device__ __forceinline__ void a_ready(const Unit&) const {}
    __device__ __forceinline__ void done(const Unit&) const {}
};
template <class Epi, class Sched, bool ALIGN_EPI = false, bool SP2 = false>
__device__ __forceinline__ void gemm_phase(PG8_LAS unsigned char* lds, const Gemm g, const Sched& S, const Epi& E) {
    const int tid = opaque_tid(), wid = __builtin_amdgcn_readfirstlane(tid >> 6), lane = tid & 63, wr = wid >> 2, wc = wid & 3, fr = lane & 15, fq = lane >> 4;
    const int K = g.K, nt = K / BK;
    unsigned voffA[2], voffB[2];
#pragma unroll
    for (int i = 0; i < 2; ++i) { int R, C; stage_rc(tid * 16 + i * 8192, R, C); const int Rb = Epi::PERM ? ((R & ~31) + perm32(R & 31)) : R;
        voffA[i] = (unsigned)(R * K + C) * 2u; voffB[i] = (unsigned)(Rb * K + C) * 2u; }
    const size_t kstep = (size_t)(BK * 2);
    const size_t hstep = (size_t)HALF * K * 2;
    const size_t tstep = 2 * hstep;
    const unsigned ldsw = (unsigned)wid * 1024u;
    const int aoff = lds_byte(wr * 64 + fr, fq * 8), boff = lds_byte(wc * 32 + fr, fq * 8);
#define PG8_SA(b, h) (((b) * 2 + (h)) * HTB)
#define PG8_SB(b, h) ((4 + (b) * 2 + (h)) * HTB)
#define PG8_STAGE(bufoff, gbase, voff) do { _Pragma("unroll") for (int _i = 0; _i < 2; ++_i) \
        __builtin_amdgcn_global_load_lds((const unsigned*)((const char*)(gbase) + (voff)[_i]), (PG8_LAS unsigned*)(lds + (bufoff) + ldsw + _i * 8192), 16, 0, 0); } while (0)
#define PG8_LDA(dst, b, h) do { _Pragma("unroll") for (int m = 0; m < 4; ++m) _Pragma("unroll") for (int k = 0; k < 2; ++k) dst[m][k] = *(const PG8_LAS bf16x8*)(lds + PG8_SA(b, h) + aoff + m * 2048 + k * 1024); } while (0)
#define PG8_LDB(dst, b, h) do { _Pragma("unroll") for (int n = 0; n < 2; ++n) _Pragma("unroll") for (int k = 0; k < 2; ++k) dst[n][k] = *(const PG8_LAS bf16x8*)(lds + PG8_SB(b, h) + boff + n * 2048 + k * 1024); } while (0)
#define PG8_MMA(ai, bj, At, Bt) do { __builtin_amdgcn_s_setprio(1); _Pragma("unroll") for (int m = 0; m < 4; ++m) _Pragma("unroll") for (int n = 0; n < 2; ++n) _Pragma("unroll") for (int k = 0; k < 2; ++k) \
        acc[ai][bj][m][n] = __builtin_amdgcn_mfma_f32_16x16x32_bf16(Bt[n][k], At[m][k], acc[ai][bj][m][n], 0, 0, 0); __builtin_amdgcn_s_setprio(0); } while (0)
#define PG8_WAIT_V(n) asm volatile("s_waitcnt vmcnt(" #n ")" ::: "memory")
#define PG8_WAIT_L(n) asm volatile("s_waitcnt lgkmcnt(" #n ")" ::: "memory")
#define PG8_BAR __builtin_amdgcn_s_barrier()
#define PG8_SCHED __builtin_amdgcn_sched_barrier(0)
    Unit cur, nxt; int ui = 0;
    if (!S.next(0, cur)) return;
    f32x4 acc[2][2][4][2];
#pragma unroll
    for (int a = 0; a < 2; ++a)
#pragma unroll
        for (int b = 0; b < 2; ++b)
#pragma unroll
            for (int m = 0; m < 4; ++m)
#pragma unroll
                for (int n = 0; n < 2; ++n) acc[a][b][m][n] = (f32x4){0.f, 0.f, 0.f, 0.f};
    bf16x8 At[4][2], B0[2][2], B1[2][2];
    const char* cA = (const char*)g.A + (size_t)cur.pm * tstep; const char* cB = (const char*)g.Bt + (size_t)cur.pn * tstep;
    S.a_ready(cur);
    if constexpr (SP2) {
        PG8_STAGE(PG8_SB(0, 0), cB, voffB); PG8_STAGE(PG8_SB(0, 1), cB + hstep, voffB); PG8_STAGE(PG8_SA(0, 0), cA, voffA); PG8_STAGE(PG8_SA(0, 1), cA + hstep, voffA);
        if (wr == 1) PG8_BAR;
        PG8_WAIT_V(2); PG8_BAR;
        PG8_STAGE(PG8_SB(1, 0), cB + kstep, voffB); PG8_STAGE(PG8_SA(1, 0), cA + kstep, voffA); PG8_STAGE(PG8_SB(1, 1), cB + hstep + kstep, voffB);
        PG8_WAIT_V(6); PG8_BAR;
    } else {
        PG8_STAGE(PG8_SB(0, 0), cB, voffB); PG8_STAGE(PG8_SA(0, 0), cA, voffA); PG8_STAGE(PG8_SB(0, 1), cB + hstep, voffB); PG8_STAGE(PG8_SA(0, 1), cA + hstep, voffA);
        if (wr == 1) PG8_BAR;
        PG8_WAIT_V(4); PG8_BAR;
        PG8_STAGE(PG8_SB(1, 0), cB + kstep, voffB); PG8_STAGE(PG8_SA(1, 0), cA + kstep, voffA); PG8_STAGE(PG8_SB(1, 1), cB + hstep + kstep, voffB);
        PG8_WAIT_V(6); PG8_BAR;
    }
    for (;;) {
        const bool has_next = S.next(ui + 1, nxt);
        const char* nA = has_next ? (const char*)g.A + (size_t)nxt.pm * tstep : cA; const char* nB = has_next ? (const char*)g.Bt + (size_t)nxt.pn * tstep : cB;
        for (int t = 0; t < nt; t += 2) {
            const bool last = (t == nt - 2);
            const char* a1 = cA + (size_t)(t + 1) * kstep;
            const char* a2 = last ? nA : cA + (size_t)(t + 2) * kstep; const char* b2 = last ? nB : cB + (size_t)(t + 2) * kstep;
            const char* a3 = a2 + kstep; const char* b3 = b2 + kstep;
            if (last && has_next) S.a_ready(nxt);
            if constexpr (SP2) {
            PG8_LDB(B0, 0, 0); PG8_LDB(B1, 0, 1); PG8_SCHED; PG8_LDA(At, 0, 0); PG8_STAGE(PG8_SA(1, 1), a1 + hstep, voffA);
            PG8_WAIT_V(8); PG8_WAIT_L(0); PG8_BAR; PG8_MMA(0, 0, At, B0); PG8_MMA(0, 1, At, B1); PG8_BAR; PG8_SCHED;
            PG8_LDA(At, 0, 1); PG8_STAGE(PG8_SB(0, 0), b2, voffB); PG8_STAGE(PG8_SB(0, 1), b2 + hstep, voffB); PG8_STAGE(PG8_SA(0, 0), a2, voffA);
            PG8_WAIT_V(8); PG8_WAIT_L(0); PG8_BAR; PG8_MMA(1, 0, At, B0); PG8_MMA(1, 1, At, B1); PG8_BAR; PG8_SCHED;
            PG8_LDB(B0, 1, 0); PG8_LDB(B1, 1, 1); PG8_SCHED; PG8_LDA(At, 1, 0); PG8_STAGE(PG8_SA(0, 1), a2 + hstep, voffA);
            PG8_WAIT_V(8); PG8_WAIT_L(0); PG8_BAR; PG8_MMA(0, 0, At, B0); PG8_MMA(0, 1, At, B1); PG8_BAR; PG8_SCHED;
            PG8_LDA(At, 1, 1); PG8_STAGE(PG8_SB(1, 0), b3, voffB); PG8_STAGE(PG8_SB(1, 1), b3 + hstep, voffB); PG8_STAGE(PG8_SA(1, 0), a3, voffA);
            PG8_WAIT_V(8); PG8_WAIT_L(0); PG8_BAR; PG8_MMA(1, 0, At, B0); PG8_MMA(1, 1, At, B1); PG8_BAR; PG8_SCHED;
            } else {
            PG8_LDB(B0, 0, 0); PG8_SCHED; PG8_LDA(At, 0, 0); PG8_STAGE(PG8_SA(1, 1), a1 + hstep, voffA);
            PG8_WAIT_L(8); PG8_BAR; PG8_WAIT_L(0); PG8_MMA(0, 0, At, B0); PG8_BAR; PG8_SCHED;
            PG8_LDB(B1, 0, 1); PG8_STAGE(PG8_SB(0, 0), b2, voffB);
            PG8_BAR; PG8_WAIT_L(0); PG8_MMA(0, 1, At, B1); PG8_BAR;
            PG8_LDA(At, 0, 1); PG8_STAGE(PG8_SA(0, 0), a2, voffA);
            PG8_BAR; PG8_WAIT_L(0); PG8_MMA(1, 0, At, B0); PG8_BAR; PG8_SCHED;
            PG8_STAGE(PG8_SB(0, 1), b2 + hstep, voffB);
            PG8_WAIT_V(6); PG8_BAR; PG8_MMA(1, 1, At, B1); PG8_BAR;
            PG8_LDB(B0, 1, 0); PG8_SCHED; PG8_LDA(At, 1, 0); PG8_STAGE(PG8_SA(0, 1), a2 + hstep, voffA);
            PG8_WAIT_L(8); PG8_BAR; PG8_WAIT_L(0); PG8_MMA(0, 0, At, B0); PG8_BAR; PG8_SCHED;
            PG8_LDB(B1, 1, 1); PG8_STAGE(PG8_SB(1, 0), b3, voffB);
            PG8_BAR; PG8_WAIT_L(0); PG8_MMA(0, 1, At, B1); PG8_BAR;
            PG8_LDA(At, 1, 1); PG8_STAGE(PG8_SA(1, 0), a3, voffA);
            PG8_BAR; PG8_WAIT_L(0); PG8_MMA(1, 0, At, B0); PG8_BAR; PG8_SCHED;
            PG8_STAGE(PG8_SB(1, 1), b3 + hstep, voffB);
            PG8_WAIT_V(6); PG8_BAR; PG8_MMA(1, 1, At, B1); PG8_BAR;
            }
        }
        if constexpr (ALIGN_EPI) { if (wr == 0) PG8_BAR; }
        if constexpr (!Epi::AFTER_DRAIN) { E(acc, cur, wr, wc, fr, fq); S.done(cur); }
        if (!has_next) break;
#pragma unroll
        for (int a = 0; a < 2; ++a)
#pragma unroll
            for (int b = 0; b < 2; ++b)
#pragma unroll
                for (int m = 0; m < 4; ++m)
#pragma unroll
                    for (int n = 0; n < 2; ++n) acc[a][b][m][n] = (f32x4){0.f, 0.f, 0.f, 0.f};
        cur = nxt; cA = nA; cB = nB; ++ui;
        if constexpr (ALIGN_EPI) { if (wr == 1) PG8_BAR; }
    }
    PG8_WAIT_V(0);
    if constexpr (!ALIGN_EPI) { if (wr == 0) PG8_BAR; }
    PG8_BAR;
    if constexpr (Epi::AFTER_DRAIN) { E.fused(acc, cur, wr, wc, fr, fq, lds, wid, lane); S.done(cur); }
#undef PG8_SA
#undef PG8_SB
#undef PG8_STAGE
#undef PG8_LDA
#undef PG8_LDB
#undef PG8_MMA
#undef PG8_WAIT_V
#undef PG8_WAIT_L
#undef PG8_BAR
#undef PG8_SCHED
}
}
namespace att {
using bf16 = unsigned short;
using bf16x8 = __attribute__((ext_vector_type(8))) short;
using s16x4  = __attribute__((ext_vector_type(4))) short;
using f32x16 = __attribute__((ext_vector_type(16))) float;
using u32x4  = __attribute__((ext_vector_type(4))) unsigned;
constexpr int KVBLK = 64, LDP = 5120;
constexpr float THR = 8.f;
constexpr int SHM_V = 16384, SHM_K = 16384, SHM_ATTN = 2 * SHM_V + 2 * SHM_K + 8 * 64 * 4;
constexpr int RPB_OFF = SHM_ATTN, Q_OFF = SHM_ATTN + 2048;
#define SBAR() __builtin_amdgcn_sched_barrier(0)
template <int DK> __device__ __forceinline__ int kswz(int row, int colB) { return DK == 128 ? row * 256 + (colB ^ ((row & 7) << 4)) : row * 128 + (colB ^ (((row >> 1) & 7) << 4)); }
__device__ __forceinline__ int crow(int r, int hi) { return (r & 3) + 8 * (r >> 2) + 4 * hi; }
__device__ __forceinline__ unsigned cvtpk(float lo, float hi) { unsigned r; asm volatile("v_cvt_pk_bf16_f32 %0, %1, %2" : "=v"(r) : "v"(lo), "v"(hi)); return r; }

__device__ __forceinline__ void partialSM(f32x16& p0, f32x16& p1, float& m_reg, float& mn, float& alpha, float C, float thrRaw) {
  __builtin_amdgcn_s_setprio(1);
  float pmax = p0[0];
#pragma unroll
  for (int r = 1; r < 16; ++r) pmax = fmaxf(pmax, p0[r]);
#pragma unroll
  for (int r = 0; r < 16; ++r) pmax = fmaxf(pmax, p1[r]);
  { auto rr = __builtin_amdgcn_permlane32_swap(__float_as_uint(pmax), __float_as_uint(pmax), false, false);
    pmax = fmaxf(__uint_as_float(rr[0]), __uint_as_float(rr[1])); }
  if (__builtin_expect(__all(pmax - m_reg <= thrRaw), 1)) { mn = m_reg; alpha = 1.f; }
  else { mn = fmaxf(m_reg, pmax); alpha = __builtin_amdgcn_exp2f((m_reg - mn) * C); m_reg = mn; }
  float mnC = -mn * C;
#pragma unroll
  for (int r = 0; r < 16; ++r) p0[r] = fmaf(p0[r], C, mnC);
#pragma unroll
  for (int r = 0; r < 16; ++r) p1[r] = fmaf(p1[r], C, mnC);
#pragma unroll
  for (int r = 0; r < 16; ++r) p0[r] = __builtin_amdgcn_exp2f(p0[r]);
  __builtin_amdgcn_s_setprio(0);
}
__device__ __forceinline__ void finishSM(f32x16& p0, f32x16& p1, float alpha, float& l_reg, bf16x8& pa0, bf16x8& pa1, bf16x8& pa2, bf16x8& pa3) {
  __builtin_amdgcn_s_setprio(1);
#pragma unroll
  for (int r = 0; r < 16; ++r) p1[r] = __builtin_amdgcn_exp2f(p1[r]);
  float ps = 0;
#pragma unroll
  for (int r = 0; r < 16; ++r) ps += p0[r];
#pragma unroll
  for (int r = 0; r < 16; ++r) ps += p1[r];
  { auto rr = __builtin_amdgcn_permlane32_swap(__float_as_uint(ps), __float_as_uint(ps), false, false);
    ps = __uint_as_float(rr[0]) + __uint_as_float(rr[1]); }
  l_reg = l_reg * alpha + ps;
#define PK4(P, BASE, OUT) do { unsigned a0 = cvtpk(P[BASE + 0], P[BASE + 1]), a1 = cvtpk(P[BASE + 2], P[BASE + 3]);   \
    unsigned b0 = cvtpk(P[BASE + 4], P[BASE + 5]), b1 = cvtpk(P[BASE + 6], P[BASE + 7]);                              \
    auto r0 = __builtin_amdgcn_permlane32_swap(a0, b0, false, false); auto r1 = __builtin_amdgcn_permlane32_swap(a1, b1, false, false); \
    u32x4 w = {r0[0], r1[0], r0[1], r1[1]}; OUT = *reinterpret_cast<bf16x8*>(&w); } while (0)
  PK4(p0, 0, pa0); PK4(p0, 8, pa1); PK4(p1, 0, pa2); PK4(p1, 8, pa3);
#undef PK4
  __builtin_amdgcn_s_setprio(0);
}
template <int DK, bool QL>
__device__ __forceinline__ void qkt(f32x16& p0, f32x16& p1, const bf16* Ks, const bf16x8* qr, const char* ql, int r32, int hi) {
  p0 = f32x16{}; p1 = f32x16{};
#pragma unroll
  for (int d0 = 0; d0 < DK / 16; ++d0) { int cb = (d0 * 16 + hi * 8) * 2;
    const bf16x8 qv = QL ? *reinterpret_cast<const bf16x8*>(ql + d0 * 1024) : qr[d0];
    bf16x8 b0 = *reinterpret_cast<const bf16x8*>((const char*)Ks + kswz<DK>(r32, cb));
    bf16x8 b1 = *reinterpret_cast<const bf16x8*>((const char*)Ks + kswz<DK>(32 + r32, cb));
    p0 = __builtin_amdgcn_mfma_f32_32x32x16_bf16(b0, qv, p0, 0, 0, 0);
    p1 = __builtin_amdgcn_mfma_f32_32x32x16_bf16(b1, qv, p1, 0, 0, 0); }
}
__device__ __forceinline__ void na_hook(f32x16& p0, f32x16& p1, int kr, int q_row, int q_col, int win_r, int win_c, const float* rpb, float inv_scale, int hi) {
  const bool rowok = (kr >= win_r) && (kr < win_r + 8);
  int ir = kr - q_row + 7; ir = ir < 0 ? 0 : (ir > 14 ? 14 : ir);
  const float* rp = rpb + ir * 31;
#pragma unroll
  for (int r = 0; r < 16; ++r) {
    const int kc = crow(r, hi);
    { const bool ok = rowok && kc >= win_c && kc < win_c + 16; int ic = kc - q_col + 15; ic = ic < 0 ? 0 : (ic > 30 ? 30 : ic);
      p0[r] = ok ? fmaf(rp[ic], inv_scale, p0[r]) : -1e30f; }
    { const int kc2 = kc + 32; const bool ok = rowok && kc2 >= win_c && kc2 < win_c + 16; int ic = kc2 - q_col + 15; ic = ic < 0 ? 0 : (ic > 30 ? 30 : ic);
      p1[r] = ok ? fmaf(rp[ic], inv_scale, p1[r]) : -1e30f; }
  }
}
__device__ __forceinline__ int v_st(int k, int c) { const int kk = (k & ~0xC) | ((k & 4) << 1) | ((k & 8) >> 1); return ((kk >> 3) * 4 + (c >> 5)) * 512 + ((kk & 7) * 32 + (c & 31)) * 2; }
__device__ __forceinline__ int v_rd_base(int lane) { return ((lane & 3) << 3) | (((lane >> 2) & 3) << 6) | (((lane >> 4) & 1) << 5) | (((lane >> 5) & 1) << 8); }
constexpr int v_rd_off(int d0, int ks, int half) { return d0 * 512 + ks * 4096 + half * 2048; }
template <int OFF> __device__ __forceinline__ s16x4 tr_read(int vb) {
  s16x4 r; asm volatile("ds_read_b64_tr_b16 %0, %1 offset:%2" : "=&v"(r) : "v"(vb), "i"(OFF) : "memory"); return r;
}
template <int D0> __device__ __forceinline__ void pv_one(f32x16& od, int vb, bf16x8 pa0, bf16x8 pa1, bf16x8 pa2, bf16x8 pa3) {
  const s16x4 l0 = tr_read<v_rd_off(D0, 0, 0)>(vb), h0 = tr_read<v_rd_off(D0, 0, 1)>(vb), l1 = tr_read<v_rd_off(D0, 1, 0)>(vb), h1 = tr_read<v_rd_off(D0, 1, 1)>(vb);
  const s16x4 l2 = tr_read<v_rd_off(D0, 2, 0)>(vb), h2 = tr_read<v_rd_off(D0, 2, 1)>(vb), l3 = tr_read<v_rd_off(D0, 3, 0)>(vb), h3 = tr_read<v_rd_off(D0, 3, 1)>(vb);
  asm volatile("s_waitcnt lgkmcnt(0)" ::: "memory"); SBAR();
#define PK(L, H) (bf16x8){L[0], L[1], L[2], L[3], H[0], H[1], H[2], H[3]}
  od = __builtin_amdgcn_mfma_f32_32x32x16_bf16(pa0, PK(l0, h0), od, 0, 0, 0);
  od = __builtin_amdgcn_mfma_f32_32x32x16_bf16(pa1, PK(l1, h1), od, 0, 0, 0);
  od = __builtin_amdgcn_mfma_f32_32x32x16_bf16(pa2, PK(l2, h2), od, 0, 0, 0);
  od = __builtin_amdgcn_mfma_f32_32x32x16_bf16(pa3, PK(l3, h3), od, 0, 0, 0);
#undef PK
}
__device__ __forceinline__ void pv_d0(f32x16* o, int vb, bf16x8 pa0, bf16x8 pa1, bf16x8 pa2, bf16x8 pa3) {
  pv_one<0>(o[0], vb, pa0, pa1, pa2, pa3); pv_one<1>(o[1], vb, pa0, pa1, pa2, pa3); pv_one<2>(o[2], vb, pa0, pa1, pa2, pa3); pv_one<3>(o[3], vb, pa0, pa1, pa2, pa3);
}
template <int DK, bool NA, bool QL, int SD>
__device__ __forceinline__ void attn_body(const bf16* __restrict__ Qb, const bf16* __restrict__ Kh, const bf16* __restrict__ Vh, int NT, char* lds,
                                          float C, float thrRaw, f32x16 (&o)[4], int krow0, int q_row, int q_col, float inv_scale) {
  const int tid = opaque_tid(), wid = tid >> 6, lane = tid & 63, r32 = lane & 31, hi = lane >> 5;
  bf16* V_lds = (bf16*)lds; bf16* K_lds = (bf16*)(lds + 2 * SHM_V);
  float* ws = (float*)(lds + 2 * SHM_V + 2 * SHM_K) + wid * 64; float* li_l = ws; float* al_l = ws + 32;
  const float* rpb = (const float*)(lds + RPB_OFF);
  int win_r = q_row - 4; win_r = win_r < 0 ? 0 : (win_r > 56 ? 56 : win_r);
  int win_c = q_col - 8; win_c = win_c < 0 ? 0 : (win_c > 48 ? 48 : win_c);
  float m_reg = -1e30f, l_reg = 0; bf16x8 qr[QL ? 1 : DK / 16];
  char* ql = lds + Q_OFF + (wid * (DK / 16) * 64 + lane) * 16;
#pragma unroll
  for (int d = 0; d < 4; ++d) o[d] = f32x16{};
  const bf16* Qw = Qb + (long)(wid * 32 + r32) * LDP + hi * 8;
#pragma unroll
  for (int d0 = 0; d0 < DK / 16; ++d0) { const bf16x8 qv = *reinterpret_cast<const bf16x8*>(Qw + d0 * 16); if (QL) *reinterpret_cast<bf16x8*>(ql + d0 * 1024) = qv; else qr[d0] = qv; }
  const int sr = tid >> 4, sc = (tid & 15) * 8, vst0 = v_st(sr, sc), vst1 = v_st(32 + sr, sc);
  const int ksr = DK == 128 ? sr : (tid >> 3), ksc = DK == 128 ? sc : (tid & 7) * 8;
  const int vb0 = (int)(uintptr_t)V_lds + v_rd_base(lane);
  struct { bf16x8 vs0, vs1, ks0, ks1; } sr_[SD];
#define SLOAD(i, k0) do { sr_[i].vs0 = *reinterpret_cast<const bf16x8*>(&Vh[(long)((k0) + sr) * LDP + sc]); sr_[i].vs1 = *reinterpret_cast<const bf16x8*>(&Vh[(long)((k0) + 32 + sr) * LDP + sc]); \
    sr_[i].ks0 = *reinterpret_cast<const bf16x8*>(&Kh[(long)((k0) + ksr) * LDP + ksc]); if (DK == 128) sr_[i].ks1 = *reinterpret_cast<const bf16x8*>(&Kh[(long)((k0) + 32 + ksr) * LDP + ksc]); } while (0)
#define SWRITE(b, i) do { *(bf16x8*)((char*)V_lds + (b) * SHM_V + vst0) = sr_[i].vs0;          \
    *(bf16x8*)((char*)V_lds + (b) * SHM_V + vst1) = sr_[i].vs1; int kc = ksc * 2;               \
    *(bf16x8*)((char*)K_lds + (b) * SHM_K + kswz<DK>(ksr, kc)) = sr_[i].ks0;                       \
    if (DK == 128) *(bf16x8*)((char*)K_lds + (b) * SHM_K + kswz<DK>(32 + ksr, kc)) = sr_[i].ks1; } while (0)
#define SWAIT() do { if (SD == 1) asm volatile("s_waitcnt vmcnt(0)" ::: "memory"); else if (DK == 128) asm volatile("s_waitcnt vmcnt(4)" ::: "memory"); else asm volatile("s_waitcnt vmcnt(3)" ::: "memory"); } while (0)
#define RESC(a) do { if (__any((a) < 1.f)) { if (hi == 0) al_l[r32] = (a); asm volatile("s_waitcnt lgkmcnt(0)" ::: "memory"); \
    _Pragma("unroll") for (int d = 0; d < 4; ++d) _Pragma("unroll") for (int r = 0; r < 16; ++r) o[d][r] *= al_l[crow(r, hi)]; } } while (0)
#define HOOK(P0, P1, j) do { if (NA) na_hook(P0, P1, krow0 + (j), q_row, q_col, win_r, win_c, rpb, inv_scale, hi); } while (0)
  f32x16 pA0, pA1, pB0, pB1; float mnA, mnB, alA, alB; bf16x8 pa0, pa1, pa2, pa3;
  constexpr int SE = 0, SO = SD - 1;
  SLOAD(SE, 0); asm volatile("s_waitcnt vmcnt(0)" ::: "memory"); SWRITE(0, SE); __syncthreads();
  qkt<DK, QL>(pA0, pA1, K_lds, qr, ql, r32, hi); HOOK(pA0, pA1, 0); partialSM(pA0, pA1, m_reg, mnA, alA, C, thrRaw);
  SLOAD(SO, KVBLK); if (SD == 2) { if (2 < NT) SLOAD(SE, 2 * KVBLK); }
  SWAIT(); SWRITE(1, SO); __syncthreads();
  for (int j = 1; j + 1 < NT; j += 2) {
    SBAR(); qkt<DK, QL>(pB0, pB1, (bf16*)((char*)K_lds + SHM_K), qr, ql, r32, hi); HOOK(pB0, pB1, j);
    finishSM(pA0, pA1, alA, l_reg, pa0, pa1, pa2, pa3); SBAR();
    SLOAD(SO, (j + SD) * KVBLK); SBAR();
    pv_d0(o, vb0, pa0, pa1, pa2, pa3); partialSM(pB0, pB1, m_reg, mnB, alB, C, thrRaw);
    __syncthreads(); SWAIT(); SWRITE(0, SE);
    RESC(alB); __syncthreads();
    SBAR(); qkt<DK, QL>(pA0, pA1, K_lds, qr, ql, r32, hi); HOOK(pA0, pA1, j + 1);
    finishSM(pB0, pB1, alB, l_reg, pa0, pa1, pa2, pa3); SBAR();
    if (SD == 1 || j + 3 < NT) SLOAD(SE, (j + 1 + SD) * KVBLK); SBAR();
    pv_d0(o, vb0 + (int)SHM_V, pa0, pa1, pa2, pa3); partialSM(pA0, pA1, m_reg, mnA, alA, C, thrRaw);
    __syncthreads(); SWAIT(); SWRITE(1, SO);
    RESC(alA); __syncthreads();
  }
  SBAR(); qkt<DK, QL>(pB0, pB1, (bf16*)((char*)K_lds + SHM_K), qr, ql, r32, hi); HOOK(pB0, pB1, NT - 1);
  finishSM(pA0, pA1, alA, l_reg, pa0, pa1, pa2, pa3); SBAR();
  pv_d0(o, vb0, pa0, pa1, pa2, pa3); partialSM(pB0, pB1, m_reg, mnB, alB, C, thrRaw);
  __syncthreads(); RESC(alB);
  finishSM(pB0, pB1, alB, l_reg, pa0, pa1, pa2, pa3); SBAR();
  pv_d0(o, vb0 + (int)SHM_V, pa0, pa1, pa2, pa3);
  if (hi == 0) li_l[r32] = l_reg; asm volatile("s_waitcnt vmcnt(0) lgkmcnt(0)" ::: "memory");
#pragma unroll
  for (int r = 0; r < 16; ++r) { const float rl = __builtin_amdgcn_rcpf(li_l[crow(r, hi)]);
#pragma unroll
    for (int d = 0; d < 4; ++d) o[d][r] *= rl; }
#undef SLOAD
#undef SWRITE
#undef SWAIT
#undef RESC
#undef HOOK
}
#undef SBAR
}
#define GAS __attribute__((address_space(1)))
#define LAS __attribute__((address_space(3)))
typedef unsigned short bf16;
typedef unsigned v4u __attribute__((ext_vector_type(4)));
typedef unsigned v2u __attribute__((ext_vector_type(2)));
typedef float f32x4 __attribute__((ext_vector_type(4)));
typedef float f32x2 __attribute__((ext_vector_type(2)));
constexpr int NWAVES = 8, NTHR = 512;
constexpr int SEQ = 4096, M = 8192, DM = 2048, NIN = 5120, FF = 5632, DEPTH = 2, CC = 512;
constexpr float EPS = 1e-6f;
constexpr int PA_Q = 0, PA_K = 512, PA_V = 1024, PB_A = 1536, PB_G = 2048, PC_Q = 2560, PC_K = 3072, PC_V = 3328, PD_Q = 3584, PD_K = 4096, PD_V = 4608;
constexpr size_t MiB = 1u << 20;
constexpr size_t WS_ROPE = 1 * MiB;
constexpr size_t WS_WIN = 2 * MiB;
constexpr size_t WS_WOUT = WS_WIN + 40 * MiB;
constexpr size_t WS_WGU = WS_WOUT + 16 * MiB;
constexpr size_t WS_WDN = WS_WGU + 88 * MiB;
constexpr size_t WS_WPW = WS_WDN + 44 * MiB;
constexpr size_t WS_XN = WS_WPW + 1 * MiB;
constexpr size_t WS_PROJ = WS_XN + 32 * MiB;
constexpr size_t WS_CAT = WS_PROJ + 80 * MiB;
constexpr size_t WS_H = WS_PROJ;
constexpr size_t WS_MIX = WS_CAT + 32 * MiB;
constexpr size_t WS_CV = WS_MIX + 64 * MiB;
constexpr size_t WS_END = WS_CV + 8 * MiB;
constexpr int LDS_BYTES = 163840;

__device__ __forceinline__ unsigned f2bf(float f) { unsigned u = __builtin_bit_cast(unsigned, f); return (u + 0x7fffu + ((u >> 16) & 1u)) >> 16; }
__device__ __forceinline__ unsigned pk2(float lo, float hi) { return f2bf(lo) | (f2bf(hi) << 16); }
__device__ __forceinline__ float bf2f(unsigned short b) { return __builtin_bit_cast(float, (unsigned)b << 16); }
__device__ __forceinline__ float wave_sum(float v) {
#pragma unroll
    for (int o = 1; o < 64; o <<= 1) v += __shfl_xor(v, o);
    return v;
}
#define LDS_WAIT() asm volatile("s_waitcnt lgkmcnt(0)" ::: "memory")

#define XB_TMO      128
#define XB_XCNT(j)  (256  + 64 * (j))
#define XB_XSUB(j)  (1280 + 64 * (j))
#define XB_XGEN(j)  (2304 + 64 * (j))
#define XB_TOP      3328
#define XB_TOPGEN   3392
#define XCD_BAR_WORDS 3456
#define XB_SPIN_CAP (1u << 18)

__device__ __forceinline__ unsigned xb_ld(unsigned* p)              { return __hip_atomic_load(p, __ATOMIC_RELAXED, __HIP_MEMORY_SCOPE_AGENT); }
__device__ __forceinline__ unsigned xb_add(unsigned* p, unsigned v) { return __hip_atomic_fetch_add(p, v, __ATOMIC_RELAXED, __HIP_MEMORY_SCOPE_AGENT); }
__device__ __forceinline__ unsigned xb_xcc_id() { return (unsigned)__builtin_amdgcn_s_getreg((3 << 11) | 20) & 0xFu; }
#define XB_SPIN(cond, bar) do { unsigned _sp = 0; while (cond) { __builtin_amdgcn_s_sleep(1); \
    if ((++_sp & 255u) == 0u) { if (xb_ld(&(bar)[XB_TMO])) break; if (_sp > XB_SPIN_CAP) { atomicAdd(&(bar)[XB_TMO], 1u); break; } } } } while (0)

struct XcdBarrier {
    unsigned* bar; unsigned x;
    volatile LAS unsigned* st;
};

__device__ __forceinline__ XcdBarrier xcd_barrier_post(unsigned* bar, volatile LAS unsigned* st) {
    XcdBarrier b; b.bar = bar; b.x = xb_xcc_id(); b.st = st;
    if (threadIdx.x == 0) (void)xb_add(&bar[XB_XCNT(b.x)], 1u);
    return b;
}
__device__ __forceinline__ void xcd_barrier_complete(unsigned* bar, unsigned x, unsigned& nloc, unsigned& nx) {
    const unsigned G = gridDim.x * gridDim.y * gridDim.z;
    unsigned sum, cnt, mine, sp = 0u;
    for (;;) {
        sum = 0u; cnt = 0u; mine = 0u;
#pragma unroll
        for (unsigned j = 0; j < 16; ++j) { const unsigned c = xb_ld(&bar[XB_XCNT(j)]); sum += c; cnt += (c > 0u) ? 1u : 0u; mine = (j == x) ? c : mine; }
        if (sum == G) break;
        __builtin_amdgcn_s_sleep(1);
        if ((++sp & 255u) == 0u) { if (xb_ld(&bar[XB_TMO])) break; if (sp > XB_SPIN_CAP) { atomicAdd(&bar[XB_TMO], 1u); break; } }
    }
    nloc = mine > 0u ? mine : 1u; nx = cnt > 0u ? cnt : 1u;
}

__device__ __forceinline__ void xcd_barrier(const XcdBarrier& b) {
    asm volatile("s_waitcnt vmcnt(0)" ::: "memory");
    __syncthreads();
    if (threadIdx.x == 0) {
        unsigned* bar = b.bar;
        __builtin_amdgcn_s_waitcnt(0);
        unsigned nloc = b.st[0], nx = b.st[1];
        if (nloc == 0u) { xcd_barrier_complete(bar, b.x, nloc, nx); b.st[0] = nloc; b.st[1] = nx; }
        const unsigned old = xb_add(&bar[XB_XSUB(b.x)], 1u);
        const unsigned gen = old / nloc;
        if (old + 1u == (gen + 1u) * nloc) {
            __builtin_amdgcn_fence(__ATOMIC_RELEASE, "agent");
            asm volatile("s_waitcnt vmcnt(0)" ::: "memory");
            const unsigned og = xb_add(&bar[XB_TOP], 1u);
            const unsigned tg = og / nx;
            if (og + 1u == (tg + 1u) * nx) xb_add(&bar[XB_TOPGEN], 1u);
            else XB_SPIN(xb_ld(&bar[XB_TOPGEN]) == tg, bar);
            __builtin_amdgcn_fence(__ATOMIC_ACQUIRE, "agent");
            xb_add(&bar[XB_XGEN(b.x)], 1u);
            asm volatile("s_waitcnt vmcnt(0)" ::: "memory");
        } else {
            XB_SPIN(xb_ld(&bar[XB_XGEN(b.x)]) == gen, bar);
            __builtin_amdgcn_fence(__ATOMIC_ACQUIRE, "agent");
            asm volatile("s_waitcnt vmcnt(0)" ::: "memory");
        }
    }
    __syncthreads();
}

struct Params {
    const float* x; const float* norm_mix_pre; const float* norm_mix_post; const float* norm_ffn_pre; const float* norm_ffn_post;
    const float* w_in; const float* w_out; const float* diff_lambda; const float* diff_subln; const float* conv_dw; const float* conv_dw_b;
    const float* conv_ln_g; const float* conv_ln_b; const float* conv_pw; const float* conv_pw_b; const float* gqa_q_norm; const float* gqa_k_norm;
    const float* na_rpb; const float* ffn_gate; const float* ffn_up; const float* ffn_down;
    float* out; unsigned char* ws;
};

__device__ __forceinline__ void transpose_item(const float* __restrict__ W, int K, int N, bf16* WT, int k0, int n0, int dst_row0, LAS float* scr, int lane) {
    const int r = lane >> 3, q = lane & 7;
    f32x4 v[8];
#pragma unroll
    for (int i = 0; i < 8; ++i) v[i] = __builtin_nontemporal_load((const f32x4*)(W + (size_t)(k0 + 8 * i + r) * N + n0 + 4 * q));
#pragma unroll
    for (int i = 0; i < 8; ++i) { LAS float* d = scr + (8 * i + r) * 33 + 4 * q; d[0] = v[i].x; d[1] = v[i].y; d[2] = v[i].z; d[3] = v[i].w; }
    LDS_WAIT(); asm volatile("" ::: "memory");
    const int c = lane & 7;
#pragma unroll
    for (int j = 0; j < 4; ++j) { const int n = (lane >> 3) + 8 * j; const LAS float* s = scr + (8 * c) * 33 + n;
        v4u o; o.x = pk2(s[0 * 33], s[1 * 33]); o.y = pk2(s[2 * 33], s[3 * 33]); o.z = pk2(s[4 * 33], s[5 * 33]); o.w = pk2(s[6 * 33], s[7 * 33]);
        __builtin_nontemporal_store(o, (v4u*)(WT + (size_t)(dst_row0 + n) * K + k0 + 8 * c)); }
    LDS_WAIT(); asm volatile("" ::: "memory");
}
__device__ __forceinline__ void norm_row_bf16(const f32x4* v, const float* __restrict__ g, bf16* orow, int lane) {
    float s = 0.f;
#pragma unroll
    for (int j = 0; j < 8; ++j) s += (v[j].x * v[j].x + v[j].y * v[j].y) + (v[j].z * v[j].z + v[j].w * v[j].w);
    const float rstd = 1.0f / sqrtf(wave_sum(s) * (1.0f / DM) + EPS);
#pragma unroll
    for (int j = 0; j < 8; ++j) { const f32x4 gv = *(const f32x4*)(g + 4 * (lane + 64 * j));
        v2u o; o.x = pk2(v[j].x * rstd * gv.x, v[j].y * rstd * gv.y); o.y = pk2(v[j].z * rstd * gv.z, v[j].w * rstd * gv.w);
        *(v2u*)(orow + 4 * (lane + 64 * j)) = o; }
}
__device__ __forceinline__ void rows_update(const float* xin, const float* mix, const float* __restrict__ g_post, float* xout, const float* __restrict__ g_next, bf16* XN, int gw, int ngw, int lane) {
    for (int m = gw; m < M; m += ngw) {
        f32x4 a[8], v[8]; float s = 0.f;
#pragma unroll
        for (int j = 0; j < 8; ++j) { a[j] = *(const f32x4*)(mix + (size_t)m * DM + 4 * (lane + 64 * j)); v[j] = *(const f32x4*)(xin + (size_t)m * DM + 4 * (lane + 64 * j));
            s += (a[j].x * a[j].x + a[j].y * a[j].y) + (a[j].z * a[j].z + a[j].w * a[j].w); }
        const float rstd = 1.0f / sqrtf(wave_sum(s) * (1.0f / DM) + EPS);
#pragma unroll
        for (int j = 0; j < 8; ++j) { const f32x4 gv = *(const f32x4*)(g_post + 4 * (lane + 64 * j)); v[j] = v[j] + a[j] * rstd * gv;
            *(f32x4*)(xout + (size_t)m * DM + 4 * (lane + 64 * j)) = v[j]; }
        if (g_next) norm_row_bf16(v, g_next, XN + (size_t)m * DM, lane);
    }
}

constexpr int I_IN = 32 * 160, I_OUT = 32 * 64, I_G = 32 * 176, I_D = 88 * 64, I_PW = 8 * 16;
constexpr int I_LAYER = I_IN + I_OUT + 2 * I_G + I_D + I_PW;
constexpr int TAIL_ITEMS = 7168;
__device__ __forceinline__ void convert_item(const Params& p, unsigned char* ws, int l, int r, LAS float* scr, int lane) {
    bf16* WIN = (bf16*)(ws + WS_WIN); bf16* WOUT = (bf16*)(ws + WS_WOUT); bf16* WGU = (bf16*)(ws + WS_WGU); bf16* WDN = (bf16*)(ws + WS_WDN); bf16* WPW = (bf16*)(ws + WS_WPW);
    if (r < I_IN) { const int kb = r / 160, nb = r % 160, n0 = 32 * nb, tile = n0 >> 8, lc = n0 & 255; const bool rt = tile < 4 || (tile >= 10 && tile <= 12);
        transpose_item(p.w_in + (size_t)l * DM * NIN, DM, NIN, WIN + (size_t)l * NIN * DM, 64 * kb, n0, rt ? tile * 256 + 128 * ((lc >> 5) & 1) + 32 * (lc >> 6) : n0, scr, lane); return; } r -= I_IN;
    if (r < I_OUT) { const int kb = r / 64, nb = r % 64; transpose_item(p.w_out + (size_t)l * DM * DM, DM, DM, WOUT + (size_t)l * DM * DM, 64 * kb, 32 * nb, 32 * nb, scr, lane); return; } r -= I_OUT;
    if (r < I_G) { const int kb = r / 176, nb = r % 176, n0 = 32 * nb; transpose_item(p.ffn_gate + (size_t)l * DM * FF, DM, FF, WGU + (size_t)l * 2 * FF * DM, 64 * kb, n0, (n0 >> 7) * 256 + (n0 & 127), scr, lane); return; } r -= I_G;
    if (r < I_G) { const int kb = r / 176, nb = r % 176, n0 = 32 * nb; transpose_item(p.ffn_up + (size_t)l * DM * FF, DM, FF, WGU + (size_t)l * 2 * FF * DM, 64 * kb, n0, (n0 >> 7) * 256 + 128 + (n0 & 127), scr, lane); return; } r -= I_G;
    if (r < I_D) { const int kb = r / 64, nb = r % 64; transpose_item(p.ffn_down + (size_t)l * FF * DM, FF, DM, WDN + (size_t)l * DM * FF, 64 * kb, 32 * nb, 32 * nb, scr, lane); return; } r -= I_D;
    { const int kb = r / 16, nb = r % 16; transpose_item(p.conv_pw + (size_t)l * CC * CC, CC, CC, WPW + (size_t)l * CC * CC, 64 * kb, 32 * nb, 32 * nb, scr, lane); }
}
__device__ __forceinline__ void slot_item(int slot, int idx, int& l, int& r) {
    if (slot == 0) { l = 0; r = 5120 + idx; }
    else if (slot == 1) { if (idx < 5632) { l = 0; r = 18432 + idx; } else { l = 1; r = idx - 5632; } }
    else if (slot == 2) { l = 1; r = 7168 + idx; }
    else { l = 1; r = 18432 + idx; }
}
__device__ __forceinline__ void p0_item(int it, int& l, int& r) {
    if (it < 5120) { l = 0; r = it; return; } it -= 5120;
    if (it < 128) { l = 0; r = 24064 + it; return; } it -= 128;
    l = 1; r = 24064 + it;
}
constexpr int P0_ITEMS = 5376;
__device__ __forceinline__ void tail_convert(const Params& p, unsigned char* ws, int slot, PG8_LAS unsigned char* ldsl, int bx) {
    if (bx < 128) return;
    const int tid = opaque_tid(), lane = tid & 63, wave = __builtin_amdgcn_readfirstlane(tid >> 6);
    LAS float* scr = (LAS float*)(ldsl + wave * 16384);
    const int gwt = (bx - 128) * NWAVES + wave, count = slot == 0 ? 13312 : (slot == 1 ? 12800 : (slot == 2 ? 11264 : 5632));
    for (int it = gwt; it < count; it += 1024) { int l, r; slot_item(slot, it, l, r); convert_item(p, ws, l, r, scr, lane); }
}

__device__ __forceinline__ float wave_reduce32(const float (&v)[32], int lane) {
    float a[16], b[8], c[4], d[2], e;
    { const bool h = lane & 32;
#pragma unroll
      for (int t = 0; t < 16; ++t) { const float keep = h ? v[t + 16] : v[t], send = h ? v[t] : v[t + 16]; a[t] = keep + __shfl_xor(send, 32); } }
    { const bool h = lane & 16;
#pragma unroll
      for (int t = 0; t < 8; ++t) { const float keep = h ? a[t + 8] : a[t], send = h ? a[t] : a[t + 8]; b[t] = keep + __shfl_xor(send, 16); } }
    { const bool h = lane & 8;
#pragma unroll
      for (int t = 0; t < 4; ++t) { const float keep = h ? b[t + 4] : b[t], send = h ? b[t] : b[t + 4]; c[t] = keep + __shfl_xor(send, 8); } }
    { const bool h = lane & 4;
#pragma unroll
      for (int t = 0; t < 2; ++t) { const float keep = h ? c[t + 2] : c[t], send = h ? c[t] : c[t + 2]; d[t] = keep + __shfl_xor(send, 4); } }
    { const bool h = lane & 2; const float keep = h ? d[1] : d[0], send = h ? d[0] : d[1]; e = keep + __shfl_xor(send, 2); }
    e += __shfl_xor(e, 1);
    return e;
}
__device__ __forceinline__ void conv_tile(const Params& p, int l, int item, const bf16* PROJ, bf16* CV, LAS float* sl) {
    const int tid = opaque_tid(), lane = tid & 63, wave = __builtin_amdgcn_readfirstlane(tid >> 6), c = tid;
    const int m0 = item * 32, b = m0 / SEQ, s0 = m0 % SEQ;
    LAS float* part = sl; LAS float* stat = sl + 512;
    float u[62];
#pragma unroll
    for (int rr = 0; rr < 62; ++rr) { const int sq = s0 - 15 + rr; const bool ok = sq >= 0 && sq < SEQ; const bf16* pr = PROJ + (size_t)(b * SEQ + (ok ? sq : s0)) * NIN;
        const float a = bf2f(pr[PB_A + c]), g = bf2f(pr[PB_G + c]); u[rr] = ok ? a / (1.0f + __expf(-g)) : 0.f; }
    float w[31];
#pragma unroll
    for (int j = 0; j < 31; ++j) w[j] = p.conv_dw[(size_t)(l * 31 + j) * CC + c];
    const float bias = p.conv_dw_b[l * CC + c];
    float y[32], y2[32];
#pragma unroll
    for (int t = 0; t < 32; ++t) { float acc = bias;
#pragma unroll
        for (int j = 0; j < 31; ++j) acc = fmaf(u[t + j], w[j], acc);
        y[t] = acc; y2[t] = acc * acc; }
    const float r1 = wave_reduce32(y, lane), r2 = wave_reduce32(y2, lane);
    const int tl = 16 * ((lane >> 5) & 1) + 8 * ((lane >> 4) & 1) + 4 * ((lane >> 3) & 1) + 2 * ((lane >> 2) & 1) + ((lane >> 1) & 1);
    __syncthreads();
    if ((lane & 1) == 0) { part[(tl * 8 + wave) * 2] = r1; part[(tl * 8 + wave) * 2 + 1] = r2; }
    __syncthreads();
    if (tid < 32) { float S1 = 0.f, S2 = 0.f;
#pragma unroll
        for (int w8 = 0; w8 < 8; ++w8) { S1 += part[(tid * 8 + w8) * 2]; S2 += part[(tid * 8 + w8) * 2 + 1]; }
        const float mean = S1 * (1.0f / CC); float var = S2 * (1.0f / CC) - mean * mean; var = var < 0.f ? 0.f : var;
        stat[tid * 2] = mean; stat[tid * 2 + 1] = 1.0f / sqrtf(var + EPS); }
    __syncthreads();
    const float lg = p.conv_ln_g[l * CC + c], lb = p.conv_ln_b[l * CC + c];
#pragma unroll
    for (int t = 0; t < 32; ++t) { float v = (y[t] - stat[t * 2]) * stat[t * 2 + 1] * lg + lb; v = v / (1.0f + __expf(-v)); CV[(size_t)(m0 + t) * CC + c] = (bf16)f2bf(v); }
}
#ifndef QL64
#define QL64 false
#endif
#ifndef QL128
#define QL128 true
#endif
#ifndef SD64
#define SD64 2
#endif
#ifndef SD128
#define SD128 2
#endif
#ifndef SDNA
#define SDNA 1
#endif
#ifndef USE_CG_SYNC
#define USE_CG_SYNC 0
#endif
#define GSYNC() do { if (USE_CG_SYNC) grid.sync(); else xcd_barrier(xbar); } while (0)
#ifndef ROPE_PROBE
#define ROPE_PROBE 0
#endif
#ifndef REP_CONV
#define REP_CONV 1
#endif
#ifndef EXTRA_SYNC
#define EXTRA_SYNC 0
#endif
#ifndef REP_S3
#define REP_S3 1
#endif
#ifndef REP_GEMM
#define REP_GEMM 1
#endif
#ifndef REP_P0
#define REP_P0 1
#endif
#ifndef ON_DIFF
#define ON_DIFF 1
#endif
#ifndef ON_GQA
#define ON_GQA 1
#endif
#ifndef ON_NA
#define ON_NA 1
#endif
#ifndef ON_CONV
#define ON_CONV 1
#endif
#ifndef ON_ROPE
#define ON_ROPE 1
#endif
#ifndef ON_P0
#define ON_P0 1
#endif
#ifndef ON_GEMM
#define ON_GEMM 1
#endif
__device__ __forceinline__ void store_o_bf16(const att::f32x16 (&o)[4], bf16* base  , unsigned char* lds) {
    const int tid = opaque_tid(), lane = tid & 63, wave = __builtin_amdgcn_readfirstlane(tid >> 6), r32 = lane & 31, hi = lane >> 5;
    __syncthreads();
    float* T = (float*)(lds + wave * 16896);
#pragma unroll
    for (int r = 0; r < 16; ++r) { float* tp = T + att::crow(r, hi) * 132 + r32;
#pragma unroll
        for (int d = 0; d < 4; ++d) tp[32 * d] = o[d][r]; }
#pragma unroll
    for (int k = 0; k < 8; ++k) { const int chunk = k * 64 + lane, row = chunk >> 4, c8 = chunk & 15;
        const f32x4 a = *(const f32x4*)(T + row * 132 + c8 * 8), b = *(const f32x4*)(T + row * 132 + c8 * 8 + 4);
        v4u w; w.x = att::cvtpk(a.x, a.y); w.y = att::cvtpk(a.z, a.w); w.z = att::cvtpk(b.x, b.y); w.w = att::cvtpk(b.z, b.w);
        *(v4u*)(base + (size_t)(wave * 32 + row) * DM + c8 * 8) = w; }
}

__global__ void __launch_bounds__(NTHR) mega_fwd(Params p) {
    extern __shared__ __attribute__((aligned(16))) unsigned char lds[];
    cg::grid_group grid = cg::this_grid();
    const int G = gridDim.x, bx = blockIdx.x, ngw = G * NWAVES;
    unsigned char* ws = p.ws;
    bf16* WIN = (bf16*)(ws + WS_WIN); bf16* WOUT = (bf16*)(ws + WS_WOUT); bf16* WGU = (bf16*)(ws + WS_WGU); bf16* WDN = (bf16*)(ws + WS_WDN); bf16* WPW = (bf16*)(ws + WS_WPW);
    bf16* XN = (bf16*)(ws + WS_XN); bf16* PROJ = (bf16*)(ws + WS_PROJ); bf16* CAT = (bf16*)(ws + WS_CAT); bf16* HB = (bf16*)(ws + WS_H); bf16* CV = (bf16*)(ws + WS_CV);
    float* MIX = (float*)(ws + WS_MIX); unsigned long long* XSLOT = (unsigned long long*)(ws + WS_MIX + 48 * MiB); bf16* XB = (bf16*)(ws + WS_MIX + 16 * MiB);
    unsigned* CTL = (unsigned*)ws; f32x2* ROPE = (f32x2*)(ws + WS_ROPE);
    PG8_LAS unsigned char* ldsl = (PG8_LAS unsigned char*)lds;
    volatile LAS unsigned* bst = (volatile LAS unsigned*)(ldsl + LDS_BYTES - 16);
    if (threadIdx.x < 4) bst[threadIdx.x] = 0u;
    __syncthreads();
    const XcdBarrier xbar = xcd_barrier_post((unsigned*)ws, bst);

    for (int rp0 = 0; rp0 < REP_P0; ++rp0) {
        const int tid = opaque_tid(), lane = tid & 63, wave = __builtin_amdgcn_readfirstlane(tid >> 6), gw = bx * NWAVES + wave; (void)tid; (void)lane; (void)gw;
        LAS float* scr = (LAS float*)(ldsl + wave * 16384);
        for (int it = gw; it < ON_P0 * P0_ITEMS; it += ngw) { int cl, cr; p0_item(it, cl, cr); convert_item(p, ws, cl, cr, scr, lane); }
        for (int m = gw; m < M; m += ngw) { f32x4 v[8];
#pragma unroll
            for (int j = 0; j < 8; ++j) v[j] = *(const f32x4*)(p.x + (size_t)m * DM + 4 * (lane + 64 * j));
#pragma unroll
            for (int j = 0; j < 8; ++j) { v2u o; o.x = pk2(v[j].x, v[j].y); o.y = pk2(v[j].z, v[j].w); *(v2u*)(XB + (size_t)m * DM + 4 * (lane + 64 * j)) = o; }
            norm_row_bf16(v, p.norm_mix_pre, XN + (size_t)m * DM, lane); }
    }
    if (G != 256) grid.sync(); else GSYNC();
    for (int es = 0; es < EXTRA_SYNC; ++es) GSYNC();

    for (int l = 0; l < DEPTH; ++l) {
        _Pragma("unroll") for (int rg = 0; rg < REP_GEMM; ++rg) { pg8::Gemm g{XN, WIN + (size_t)l * NIN * DM, M, NIN, DM}; pg8::StaticOrder S; S.init(M, NIN, G, bx);
          pg8::EpiProj E{PROJ, NIN, (const float*)ROPE, p.gqa_q_norm + l * 128, p.gqa_k_norm + l * 128, (PG8_LAS float*)(ldsl + 131072)};
          pg8::gemm_phase<pg8::EpiProj, pg8::StaticOrder, true, true>(ldsl, g, S, E); }
        tail_convert(p, ws, l == 0 ? 0 : 2, ldsl, bx);
        GSYNC();

        for (int rep3 = 0; rep3 < REP_S3; ++rep3) {
            const int tid = opaque_tid(), lane = tid & 63, wave = __builtin_amdgcn_readfirstlane(tid >> 6), gw = bx * NWAVES + wave; (void)tid; (void)lane; (void)gw;
            const float lam_init = l == 0 ? 0.2f : 0.35550906759096934f;
            float lam; { const float* lp = p.diff_lambda + l * 256; const float sa = wave_sum(lp[lane] * lp[64 + lane]), sb = wave_sum(lp[128 + lane] * lp[192 + lane]); lam = expf(sa) - expf(sb) + lam_init; }
            constexpr float C64 = 0.125f * 1.4426950408889634f, THR64 = att::THR / 0.125f;
            constexpr float SC128 = 0.08838834764831845f, C128 = SC128 * 1.4426950408889634f, THR128 = att::THR / SC128;
            const int r32 = lane & 31, hi = lane >> 5;
            unsigned* ccnt = CTL + 32768 + l * 2048;
            if (ON_CONV && bx >= 128) {
                for (int ci = 0; ci < 2; ++ci) { const int item = 2 * (bx - 128) + ci;
                    conv_tile(p, l, item, PROJ, CV, (LAS float*)(ldsl + 131072));
                    asm volatile("s_waitcnt vmcnt(0)" ::: "memory"); __syncthreads();
                    if (tid == 0) { __builtin_amdgcn_fence(__ATOMIC_RELEASE, "agent"); asm volatile("s_waitcnt vmcnt(0)" ::: "memory"); __hip_atomic_fetch_add(ccnt + 64 * (item >> 3), 1u, __ATOMIC_RELAXED, __HIP_MEMORY_SCOPE_AGENT); } }
            }
            for (int round = 0;; ++round) {
                const int pc = (round & 1) ? (round + 1) * G - 1 - bx : round * G + bx;
                if (pc >= 384) break;
                const int kind = pc >> 7, xq = bx & 7, b = xq >> 2, h = xq & 3, qb = (bx & 127) >> 3;
                const size_t rowq = (size_t)b * SEQ + qb * 256, rowk = (size_t)b * SEQ;
                att::f32x16 o[4];
                __syncthreads();
                if (ON_DIFF && kind == 0) {
                    att::attn_body<64, false, QL64, SD64>(PROJ + rowq * NIN + PA_Q + h * 128, PROJ + rowk * NIN + PA_K + h * 128, PROJ + rowk * NIN + PA_V + h * 128, SEQ / 64, (char*)lds, C64, THR64, o, 0, 0, 0, 0.f);
                    { const int t2 = opaque_tid(); v4u* STv = (v4u*)((char*)lds + 69632) + t2;
#pragma unroll
                      for (int k = 0; k < 8; ++k) { const int d = k >> 1, r0 = 8 * (k & 1); v4u w;
                          w.x = att::cvtpk(o[d][r0], o[d][r0 + 1]); w.y = att::cvtpk(o[d][r0 + 2], o[d][r0 + 3]); w.z = att::cvtpk(o[d][r0 + 4], o[d][r0 + 5]); w.w = att::cvtpk(o[d][r0 + 6], o[d][r0 + 7]);
                          STv[k * 512] = w; } }
                    att::attn_body<64, false, QL64, SD64>(PROJ + rowq * NIN + PA_Q + h * 128 + 64, PROJ + rowk * NIN + PA_K + h * 128 + 64, PROJ + rowk * NIN + PA_V + h * 128, SEQ / 64, (char*)lds, C64, THR64, o, 0, 0, 0, 0.f);
                    { const int t3 = opaque_tid(), l3 = t3 & 63, r32 = l3 & 31; const v4u* STv = (const v4u*)((char*)lds + 69632) + t3;
                      const float* sg = p.diff_subln + l * 128;
                      float gsub[4], ss[16];
#pragma unroll
                      for (int d = 0; d < 4; ++d) gsub[d] = sg[32 * d + r32] * (1.0f - lam_init);
#pragma unroll
                      for (int r = 0; r < 16; ++r) ss[r] = 0.f;
#pragma unroll
                      for (int k = 0; k < 8; ++k) { const int d = k >> 1, r0 = 8 * (k & 1); const v4u w = STv[k * 512];
#pragma unroll
                          for (int i = 0; i < 4; ++i) { const unsigned wi = i == 0 ? w.x : (i == 1 ? w.y : (i == 2 ? w.z : w.w));
                              const float va = bf2f((unsigned short)(wi & 0xffffu)) - lam * o[d][r0 + 2 * i], vb = bf2f((unsigned short)(wi >> 16)) - lam * o[d][r0 + 2 * i + 1];
                              o[d][r0 + 2 * i] = va; o[d][r0 + 2 * i + 1] = vb; ss[r0 + 2 * i] += va * va; ss[r0 + 2 * i + 1] += vb * vb; } }
#pragma unroll
                      for (int r = 0; r < 16; ++r) { float q = ss[r]; q += __shfl_xor(q, 1); q += __shfl_xor(q, 2); q += __shfl_xor(q, 4); q += __shfl_xor(q, 8); q += __shfl_xor(q, 16);
                          const float rstd = 1.0f / sqrtf(q * (1.0f / 128.0f) + EPS);
#pragma unroll
                          for (int d = 0; d < 4; ++d) o[d][r] *= rstd * gsub[d]; } }
                    store_o_bf16(o, CAT + rowq * DM + h * 128, lds);
                } else if (ON_GQA && kind == 1) {
                    att::attn_body<128, false, QL128, SD128>(PROJ + rowq * NIN + PC_Q + h * 128, PROJ + rowk * NIN + PC_K + (h >> 1) * 128, PROJ + rowk * NIN + PC_V + (h >> 1) * 128, SEQ / 64, (char*)lds, C128, THR128, o, 0, 0, 0, 0.f);
                    store_o_bf16(o, CAT + rowq * DM + 1024 + h * 128, lds);
                } else if (ON_NA) {
                    { const float* rsrc = p.na_rpb + (size_t)(l * 4 + h) * 465; float* rdst = (float*)((char*)lds + att::RPB_OFF); for (int e = tid; e < 465; e += NTHR) rdst[e] = rsrc[e]; }
                    int krow0 = 4 * qb - 4; krow0 = krow0 < 0 ? 0 : (krow0 > 52 ? 52 : krow0);
                    const size_t rowkn = rowk + (size_t)krow0 * 64;
                    att::attn_body<128, true, QL128, SDNA>(PROJ + rowq * NIN + PD_Q + h * 128, PROJ + rowkn * NIN + PD_K + h * 128, PROJ + rowkn * NIN + PD_V + h * 128, 12, (char*)lds, C128, THR128, o,
                                              krow0, 4 * qb + (wave >> 1), (wave & 1) * 32 + r32, 11.313708498984761f);
                    store_o_bf16(o, CAT + rowq * DM + 1536 + h * 128, lds);
                }
            }
            __syncthreads();
            if (G - 1 - bx < 64) {
                if (tid == 0) { unsigned sp = 0; while (__hip_atomic_load(ccnt + 64 * ((G - 1 - bx) >> 1), __ATOMIC_RELAXED, __HIP_MEMORY_SCOPE_AGENT) < 8u) { __builtin_amdgcn_s_sleep(2); if (++sp > (1u << 24)) break; }
                    __builtin_amdgcn_fence(__ATOMIC_ACQUIRE, "agent"); asm volatile("s_waitcnt vmcnt(0)" ::: "memory"); }
                __syncthreads();
            }
            { pg8::Gemm g{CV, WPW + (size_t)l * CC * CC, M, CC, CC}; pg8::StrideOrder S{G - 1 - bx, G, 64, 2};
              pg8::EpiBf16<0> E{CAT + 512, DM, p.conv_pw_b + l * CC, 0, 0, 1.f};
              pg8::gemm_phase<pg8::EpiBf16<0>, pg8::StrideOrder, true, true>(ldsl, g, S, E); }
        }
        GSYNC();

        { pg8::Gemm g{CAT, WOUT + (size_t)l * DM * DM, M, DM, DM}; pg8::StaticOrder S; S.init(M, DM, G, bx);
          pg8::EpiRmsFused E{XB, nullptr, XB, XN, p.norm_mix_post + l * DM, p.norm_ffn_pre + l * DM, XSLOT + (size_t)(l * 2 + 0) * 131072, CTL + 16384 + (l * 2 + 0) * 2048};
          pg8::gemm_phase<pg8::EpiRmsFused, pg8::StaticOrder, false, true>(ldsl, g, S, E); }
        GSYNC();
        _Pragma("unroll") for (int rg = 0; rg < REP_GEMM; ++rg) { pg8::Gemm g{XN, WGU + (size_t)l * 2 * FF * DM, M, 2 * FF, DM}; pg8::StaticOrder S; S.init(M, 2 * FF, G, bx);
          pg8::EpiSwiGLU E{HB, FF};
          pg8::gemm_phase<pg8::EpiSwiGLU, pg8::StaticOrder, true, true>(ldsl, g, S, E); }
        tail_convert(p, ws, l == 0 ? 1 : 3, ldsl, bx);
        GSYNC();
        { pg8::Gemm g{HB, WDN + (size_t)l * DM * FF, M, DM, FF}; pg8::StaticOrder S; S.init(M, DM, G, bx);
          pg8::EpiRmsFused E{XB, l + 1 < DEPTH ? nullptr : p.out, XB, XN, p.norm_ffn_post + l * DM, l + 1 < DEPTH ? p.norm_mix_pre + (l + 1) * DM : nullptr, XSLOT + (size_t)(l * 2 + 1) * 131072, CTL + 16384 + (l * 2 + 1) * 2048};
          pg8::gemm_phase<pg8::EpiRmsFused, pg8::StaticOrder, false, true>(ldsl, g, S, E); }
        if (l + 1 < DEPTH) GSYNC();
    }
}

extern "C" void kernel_launch(void* const* d_in, const int* in_sizes, int n_in, void* d_out, int out_size, void* d_ws, size_t ws_size, hipStream_t stream) {
    static int grid = 0;
    if (grid == 0) {
        if (n_in != 21 || out_size != M * DM || ws_size < WS_END) { fprintf(stderr, "kernel_launch: unexpected shapes: n_in %d out %d ws %zu (need %zu)\n", n_in, out_size, ws_size, (size_t)WS_END); grid = -1; return; }
        int dev = 0, cus = 0, per_cu = 0;
        if (hipGetDevice(&dev) != hipSuccess || hipDeviceGetAttribute(&cus, hipDeviceAttributeMultiprocessorCount, dev) != hipSuccess) { fprintf(stderr, "kernel_launch: device query failed\n"); grid = -1; return; }
        if (hipFuncSetAttribute((const void*)mega_fwd, hipFuncAttributeMaxDynamicSharedMemorySize, LDS_BYTES) != hipSuccess) { fprintf(stderr, "kernel_launch: hipFuncSetAttribute failed\n"); grid = -1; return; }
        if (hipOccupancyMaxActiveBlocksPerMultiprocessor(&per_cu, (const void*)mega_fwd, NTHR, LDS_BYTES) != hipSuccess || per_cu < 1) { fprintf(stderr, "kernel_launch: occupancy query says %d\n", per_cu); (void)hipGetLastError(); per_cu = 1; }
        grid = cus * per_cu;
        if (grid < 256) { fprintf(stderr, "kernel_launch: needs 256 co-resident workgroups, device offers %d\n", grid); grid = -1; return; }
        grid = 256;
    }
    if (grid < 0) return;
    if (hipMemsetAsync(d_ws, 0, 196608, stream) != hipSuccess) { fprintf(stderr, "kernel_launch: memset failed\n"); return; }
    Params p{};
    const float** pp = (const float**)&p;
    for (int i = 0; i < 21; ++i) pp[i] = (const float*)d_in[i];
    p.out = (float*)d_out; p.ws = (unsigned char*)d_ws;
    void* args[] = {&p};
    hipError_t e = hipLaunchCooperativeKernel((const void*)mega_fwd, dim3(grid), dim3(NTHR), args, LDS_BYTES, stream);
    if (e != hipSuccess) fprintf(stderr, "cooperative launch failed: %s (grid %d)\n", hipGetErrorString(e), grid);
}
```

```cpp
#include <hip/hip_runtime.h>
#include <hip/hip_cooperative_groups.h>
#include <cstdio>
#include <cstdint>
namespace cg = cooperative_groups;
__device__ __forceinline__ int opaque_tid() { int t = threadIdx.x; asm volatile("" : "+v"(t)); return t; }
namespace pg8 {
#define PG8_LAS __attribute__((address_space(3)))
typedef unsigned short bf16_t;
typedef short bf16x8 __attribute__((ext_vector_type(8)));
typedef float f32x4 __attribute__((ext_vector_type(4)));
typedef unsigned u32x4 __attribute__((ext_vector_type(4)));
constexpr int BM = 256, BK = 64, HALF = 128, HTB = HALF * BK * 2  , STAGE_BYTES = 8 * HTB, NXCD = 8, WGM = 8;

__host__ __device__ __forceinline__ int lds_byte(int r, int c) { const int st = (r >> 4) * 2 + (c >> 5), rr = r & 15, cc = c & 31, ob = rr * 64 + cc * 2; return st * 1024 + (ob ^ (((ob >> 9) & 1) << 5)); }
__host__ __device__ __forceinline__ void stage_rc(int b, int& R, int& C) { const int st = b / 1024, sb = b % 1024, swz = sb ^ (((sb >> 9) & 1) << 5); R = (st >> 1) * 16 + swz / 64; C = (st & 1) * 32 + (swz % 64) / 2; }
__host__ __device__ __forceinline__ int perm32(int rho) { const int n = rho >> 4, i = rho & 15; return 8 * (i >> 2) + 4 * n + (i & 3); }

struct Unit { int pm, pn; };
struct Gemm { const bf16_t* A; const bf16_t* Bt; int M, N, K; };

struct StaticOrder {
    int nM, nN, nwg, G, c;
    __host__ __device__ void init(int M, int N, int G_, int c_) { nM = M / BM; nN = N / BM; nwg = nM * nN; G = G_; c = c_; }
    __host__ __device__ bool next(int i, Unit& u) const {
        const long L = (long)i * G + c; if (L >= nwg) return false;
        int wgid = (int)L; { const int q = nwg / NXCD, r = nwg % NXCD, xcd = wgid % NXCD, off = wgid / NXCD; wgid = (xcd < r ? xcd * (q + 1) : r * (q + 1) + (xcd - r) * q) + off; }
        const int nig = WGM * nN, gid = wgid / nig, fm = gid * WGM, gsz = (nM - fm) < WGM ? (nM - fm) : WGM;
        u.pm = fm + ((wgid % nig) % gsz); u.pn = (wgid % nig) / gsz; return true;
    }
    __device__ __forceinline__ void a_ready(const Unit&) const {}
    __device__ __forceinline__ void done(const Unit&) const {}
};

__device__ __forceinline__ unsigned cvt_pk_bf16(float lo, float hi) { unsigned r; asm volatile("v_cvt_pk_bf16_f32 %0, %1, %2" : "=v"(r) : "v"(lo), "v"(hi)); return r; }
typedef float f32x2 __attribute__((ext_vector_type(2)));
__device__ __forceinline__ f32x2 gelu_pk(f32x2 v) {
    const f32x2 av = __builtin_elementwise_abs(v), d = av * 0.2316418882f + 1.0f;
    f32x2 t; t.x = __builtin_amdgcn_rcpf(d.x); t.y = __builtin_amdgcn_rcpf(d.y);
    f32x2 q = t * 0.5307027145f + (-0.7265760135f); q = q * t + 0.7107068705f; q = q * t + (-0.142248368f); q = q * t + 0.127414796f; q = q * t;
    const f32x2 s = (v * v) * (-0.72134752044f);
    f32x2 e; e.x = __builtin_amdgcn_exp2f(s.x); e.y = __builtin_amdgcn_exp2f(s.y);
    const f32x2 m = v * (q * e), r = v - m;
    f32x2 o; o.x = v.x < 0.f ? m.x : r.x; o.y = v.y < 0.f ? m.y : r.y; return o;
}

template <int ACT  > struct EpiBf16 {
    static constexpr bool PERM = true, AFTER_DRAIN = false; static_assert(ACT == 0 || ACT == 1, "EpiBf16: ACT is 0 (none) or 1 (gelu_pk)");
    bf16_t* O; int ldc; const float* bias; int split_cols; size_t split_stride; float scale0;
    __device__ __forceinline__ void operator()(const f32x4 (&acc)[2][2][4][2], const Unit& u, int wr, int wc, int fr, int fq) const {
        const int row0 = u.pm * BM + wr * 64 + fr; int colt = u.pn * BM; bf16_t* base = O;
        float sc = 1.f; if (split_cols) { const int t = colt / split_cols; base += (size_t)t * split_stride; colt -= t * split_cols; if (t == 0) sc = scale0; }
        const int col0 = colt + wc * 32 + 8 * fq, bcol0 = u.pn * BM + wc * 32 + 8 * fq;
        f32x4 bv[2][2];
#pragma unroll
        for (int bj = 0; bj < 2; ++bj)
#pragma unroll
            for (int n = 0; n < 2; ++n) bv[bj][n] = bias ? *(const f32x4*)(bias + bcol0 + bj * HALF + 4 * n) : (f32x4){0.f, 0.f, 0.f, 0.f};
#pragma unroll
        for (int ai = 0; ai < 2; ++ai)
#pragma unroll
            for (int m = 0; m < 4; ++m) { bf16_t* rowp = base + (size_t)(row0 + ai * HALF + m * 16) * ldc + col0;
#pragma unroll
                for (int bj = 0; bj < 2; ++bj) { f32x4 v0 = acc[ai][bj][m][0] + bv[bj][0], v1 = acc[ai][bj][m][1] + bv[bj][1];
                    if (ACT == 1) { f32x2 a = gelu_pk((f32x2){v0[0], v0[1]}), b = gelu_pk((f32x2){v0[2], v0[3]}), c = gelu_pk((f32x2){v1[0], v1[1]}), d = gelu_pk((f32x2){v1[2], v1[3]});
                        v0 = (f32x4){a.x, a.y, b.x, b.y}; v1 = (f32x4){c.x, c.y, d.x, d.y}; }
                    v0 = v0 * sc; v1 = v1 * sc; u32x4 w; w.x = cvt_pk_bf16(v0[0], v0[1]); w.y = cvt_pk_bf16(v0[2], v0[3]); w.z = cvt_pk_bf16(v1[0], v1[1]); w.w = cvt_pk_bf16(v1[2], v1[3]);
                    *(u32x4*)(rowp + bj * HALF) = w; } }
    }
};
struct EpiF32 {
    static constexpr bool PERM = false, AFTER_DRAIN = false;
    float* O; int ldc;
    __device__ __forceinline__ void operator()(const f32x4 (&acc)[2][2][4][2], const Unit& u, int wr, int wc, int fr, int fq) const {
        const int row0 = u.pm * BM + wr * 64 + fr, col0 = u.pn * BM + wc * 32 + 4 * fq;
#pragma unroll
        for (int ai = 0; ai < 2; ++ai)
#pragma unroll
            for (int m = 0; m < 4; ++m) { float* rowp = O + (size_t)(row0 + ai * HALF + m * 16) * ldc + col0;
#pragma unroll
                for (int bj = 0; bj < 2; ++bj)
#pragma unroll
                    for (int n = 0; n < 2; ++n) *(f32x4*)(rowp + bj * HALF + n * 16) = acc[ai][bj][m][n]; }
    }
};
__device__ __forceinline__ float swiglu1(float g, float u) { return g * u * __builtin_amdgcn_rcpf(1.0f + __expf(-g)); }
struct EpiSwiGLU {
    static constexpr bool PERM = true, AFTER_DRAIN = false;
    bf16_t* O; int ldc;
    __device__ __forceinline__ void operator()(const f32x4 (&acc)[2][2][4][2], const Unit& u, int wr, int wc, int fr, int fq) const {
        const int row0 = u.pm * BM + wr * 64 + fr, col0 = u.pn * HALF + wc * 32 + 8 * fq;
#pragma unroll
        for (int ai = 0; ai < 2; ++ai)
#pragma unroll
            for (int m = 0; m < 4; ++m) { bf16_t* rowp = O + (size_t)(row0 + ai * HALF + m * 16) * ldc + col0;
                const f32x4 g0 = acc[ai][0][m][0], g1 = acc[ai][0][m][1], u0 = acc[ai][1][m][0], u1 = acc[ai][1][m][1];
                u32x4 w; w.x = cvt_pk_bf16(swiglu1(g0[0], u0[0]), swiglu1(g0[1], u0[1])); w.y = cvt_pk_bf16(swiglu1(g0[2], u0[2]), swiglu1(g0[3], u0[3]));
                w.z = cvt_pk_bf16(swiglu1(g1[0], u1[0]), swiglu1(g1[1], u1[1])); w.w = cvt_pk_bf16(swiglu1(g1[2], u1[2]), swiglu1(g1[3], u1[3]));
                *(u32x4*)rowp = w; }
    }
};

struct PanelSS {
    unsigned* xbuf;
    unsigned* cnt;
    float inv_n, eps;
    __device__ __forceinline__ void run(const f32x4 (&v)[2][2][4][2], const Unit& u, int wr, int wc, int fr, int fq, PG8_LAS unsigned char* lds, int wid, int lane) const {
        PG8_LAS float* P = (PG8_LAS float*)lds;
        PG8_LAS float* S = (PG8_LAS float*)(lds + 4096);
#pragma unroll
        for (int ai = 0; ai < 2; ++ai)
#pragma unroll
            for (int m = 0; m < 4; ++m) {
                float q = 0.f;
#pragma unroll
                for (int bj = 0; bj < 2; ++bj)
#pragma unroll
                    for (int n = 0; n < 2; ++n) { const f32x4 x = v[ai][bj][m][n]; q += (x[0] * x[0] + x[1] * x[1]) + (x[2] * x[2] + x[3] * x[3]); }
                q += __shfl_xor(q, 16); q += __shfl_xor(q, 32);
                if (fq == 0) P[(ai * HALF + wr * 64 + m * 16 + fr) * 4 + wc] = q;
            }
        asm volatile("s_waitcnt lgkmcnt(0)" ::: "memory"); __builtin_amdgcn_s_barrier(); asm volatile("" ::: "memory");
        const int row = wid * 32 + (lane & 31);
        unsigned* slot = xbuf + ((size_t)(u.pm * BM + row) * 8);
        if (lane < 32) { const float q = (P[row * 4 + 0] + P[row * 4 + 1]) + (P[row * 4 + 2] + P[row * 4 + 3]);
            __hip_atomic_store(slot + u.pn, __float_as_uint(q), __ATOMIC_RELAXED, __HIP_MEMORY_SCOPE_AGENT); }
        asm volatile("s_waitcnt vmcnt(0)" ::: "memory");
        if (lane == 0) __hip_atomic_fetch_add(cnt + 64 * u.pm, 1u, __ATOMIC_RELAXED, __HIP_MEMORY_SCOPE_AGENT);
        if (wid == 0) {
            unsigned sp = 0;
            while ((unsigned)__builtin_amdgcn_readfirstlane(__hip_atomic_load(cnt + 64 * u.pm, __ATOMIC_RELAXED, __HIP_MEMORY_SCOPE_AGENT)) < 64u) { __builtin_amdgcn_s_sleep(2); if (++sp > (1u << 22)) break; }
            __builtin_amdgcn_fence(__ATOMIC_ACQUIRE, "agent");
        }
        asm volatile("s_waitcnt vmcnt(0) lgkmcnt(0)" ::: "memory"); __builtin_amdgcn_s_barrier(); asm volatile("" ::: "memory");
        if (lane < 32) { float q = 0.f;
#pragma unroll
            for (int t = 0; t < 8; ++t) q += __uint_as_float(__hip_atomic_load(slot + t, __ATOMIC_RELAXED, __HIP_MEMORY_SCOPE_AGENT));
            S[row] = 1.0f / sqrtf(q * inv_n + eps); }
        asm volatile("s_waitcnt lgkmcnt(0)" ::: "memory"); __builtin_amdgcn_s_barrier(); asm volatile("" ::: "memory");
    }
};
struct EpiRmsResRms {
    static constexpr bool PERM = false, AFTER_DRAIN = true;
    const float* base; float* out; bf16_t* xn; int ldc; const float* g1; const float* g2; PanelSS st1, st2;
    __device__ __forceinline__ void operator()(const f32x4 (&)[2][2][4][2], const Unit&, int, int, int, int) const {}
    __device__ __forceinline__ void fused(f32x4 (&acc)[2][2][4][2], const Unit& u, int wr, int wc, int fr, int fq, PG8_LAS unsigned char* lds, int wid, int lane) const {
        typedef unsigned u32x2v __attribute__((ext_vector_type(2)));
        const PG8_LAS float* S = (const PG8_LAS float*)(lds + 4096);
        const int col0 = u.pn * BM + wc * 32 + 4 * fq;
        st1.run(acc, u, wr, wc, fr, fq, lds, wid, lane);
        {
            f32x4 gv[2][2];
#pragma unroll
            for (int bj = 0; bj < 2; ++bj)
#pragma unroll
                for (int n = 0; n < 2; ++n) gv[bj][n] = *(const f32x4*)(g1 + col0 + bj * HALF + n * 16);
#pragma unroll
            for (int ai = 0; ai < 2; ++ai)
#pragma unroll
                for (int m = 0; m < 4; ++m) { const int r = ai * HALF + wr * 64 + m * 16 + fr; const float sr = S[r]; const size_t off = (size_t)(u.pm * BM + r) * ldc + col0;
#pragma unroll
                    for (int bj = 0; bj < 2; ++bj)
#pragma unroll
                        for (int n = 0; n < 2; ++n) { const f32x4 bs = *(const f32x4*)(base + off + bj * HALF + n * 16); acc[ai][bj][m][n] = bs + acc[ai][bj][m][n] * sr * gv[bj][n]; }
                    asm volatile("" : "+v"(acc[ai][0][m][0]), "+v"(acc[ai][0][m][1]), "+v"(acc[ai][1][m][0]), "+v"(acc[ai][1][m][1]));
                    if (m & 1) asm volatile("" ::: "memory"); }
        }
        if (g2) {
            st2.run(acc, u, wr, wc, fr, fq, lds, wid, lane);
            f32x4 gv[2][2];
#pragma unroll
            for (int bj = 0; bj < 2; ++bj)
#pragma unroll
                for (int n = 0; n < 2; ++n) gv[bj][n] = *(const f32x4*)(g2 + col0 + bj * HALF + n * 16);
#pragma unroll
            for (int ai = 0; ai < 2; ++ai)
#pragma unroll
                for (int m = 0; m < 4; ++m) { const int r = ai * HALF + wr * 64 + m * 16 + fr; const float sr = S[r]; const size_t off = (size_t)(u.pm * BM + r) * ldc + col0;
#pragma unroll
                    for (int bj = 0; bj < 2; ++bj)
#pragma unroll
                        for (int n = 0; n < 2; ++n) { const f32x4 x1 = acc[ai][bj][m][n]; *(f32x4*)(out + off + bj * HALF + n * 16) = x1;
                            const f32x4 o = x1 * sr * gv[bj][n]; u32x2v w; w.x = cvt_pk_bf16(o[0], o[1]); w.y = cvt_pk_bf16(o[2], o[3]);
                            *(u32x2v*)(xn + off + bj * HALF + n * 16) = w; }
                    asm volatile("" ::: "memory"); }
        } else {
#pragma unroll
            for (int ai = 0; ai < 2; ++ai)
#pragma unroll
                for (int m = 0; m < 4; ++m) { const int r = ai * HALF + wr * 64 + m * 16 + fr; const size_t off = (size_t)(u.pm * BM + r) * ldc + col0;
#pragma unroll
                    for (int bj = 0; bj < 2; ++bj)
#pragma unroll
                        for (int n = 0; n < 2; ++n) *(f32x4*)(out + off + bj * HALF + n * 16) = acc[ai][bj][m][n]; }
        }
    }
};

__device__ __forceinline__ float bflo(unsigned w) { return __builtin_bit_cast(float, w << 16); }
__device__ __forceinline__ float bfhi(unsigned w) { return __builtin_bit_cast(float, w & 0xffff0000u); }
struct EpiRmsFused {
    static constexpr bool PERM = true, AFTER_DRAIN = true;
    const bf16_t* base_b;
    float* out_f; bf16_t* out_b;
    bf16_t* xn; const float* g1; const float* g2;
    unsigned long long* xbuf;
    unsigned* cnt;
    __device__ __forceinline__ void operator()(const f32x4 (&)[2][2][4][2], const Unit&, int, int, int, int) const {}
    __device__ __forceinline__ void fused(f32x4 (&acc)[2][2][4][2], const Unit& u, int wr, int wc, int fr, int fq, PG8_LAS unsigned char* lds, int wid, int lane) const {
        typedef unsigned u32x2v __attribute__((ext_vector_type(2)));
        constexpr int ldc = 2048; constexpr float inv_n = 1.0f / 2048.0f, eps = 1e-6f;
        PG8_LAS f32x4* P = (PG8_LAS f32x4*)(lds + 131072);
        PG8_LAS float* S = (PG8_LAS float*)(lds + 131072 + 16384);
        const int col0 = u.pn * BM + wc * 32 + 8 * fq;
        f32x4 gv[2][2];
#pragma unroll
        for (int bj = 0; bj < 2; ++bj)
#pragma unroll
            for (int n = 0; n < 2; ++n) gv[bj][n] = *(const f32x4*)(g1 + col0 + bj * HALF + n * 4);
        PG8_LAS u32x4* XL = (PG8_LAS u32x4*)lds + (wid * 64 + lane);
#pragma unroll
        for (int ai = 0; ai < 2; ++ai)
#pragma unroll
            for (int m = 0; m < 4; ++m) { const size_t off = (size_t)(u.pm * BM + ai * HALF + wr * 64 + m * 16 + fr) * ldc + col0;
#pragma unroll
                for (int bj = 0; bj < 2; ++bj) XL[((ai * 4 + m) * 2 + bj) * 512] = *(const u32x4*)(base_b + off + bj * HALF); }
#pragma unroll
        for (int ai = 0; ai < 2; ++ai)
#pragma unroll
            for (int m = 0; m < 4; ++m) {
                float saa = 0.f, sxx = 0.f, sxag = 0.f, sgg = 0.f;
#pragma unroll
                for (int bj = 0; bj < 2; ++bj) { const u32x4 w4 = XL[((ai * 4 + m) * 2 + bj) * 512];
#pragma unroll
                    for (int n = 0; n < 2; ++n) { const f32x4 a = acc[ai][bj][m][n]; const f32x4 ag = a * gv[bj][n]; const unsigned wx = n == 0 ? w4.x : w4.z, wy = n == 0 ? w4.y : w4.w;
                        const f32x4 x = (f32x4){bflo(wx), bfhi(wx), bflo(wy), bfhi(wy)};
                        saa += (a[0] * a[0] + a[1] * a[1]) + (a[2] * a[2] + a[3] * a[3]); sxx += (x[0] * x[0] + x[1] * x[1]) + (x[2] * x[2] + x[3] * x[3]);
                        sxag += (x[0] * ag[0] + x[1] * ag[1]) + (x[2] * ag[2] + x[3] * ag[3]); sgg += (ag[0] * ag[0] + ag[1] * ag[1]) + (ag[2] * ag[2] + ag[3] * ag[3]); } }
                asm volatile("" : "+v"(saa), "+v"(sxx), "+v"(sxag), "+v"(sgg));
                saa += __shfl_xor(saa, 16); sxx += __shfl_xor(sxx, 16); sxag += __shfl_xor(sxag, 16); sgg += __shfl_xor(sgg, 16);
                saa += __shfl_xor(saa, 32); sxx += __shfl_xor(sxx, 32); sxag += __shfl_xor(sxag, 32); sgg += __shfl_xor(sgg, 32);
                if (fq == 0) P[(ai * HALF + wr * 64 + m * 16 + fr) * 4 + wc] = (f32x4){saa, sxx, sxag, sgg};
                __builtin_amdgcn_sched_barrier(0);
            }
        asm volatile("s_waitcnt lgkmcnt(0)" ::: "memory"); __builtin_amdgcn_s_barrier(); asm volatile("" ::: "memory");
        const int row = wid * 32 + (lane & 31);
        unsigned long long* slot = xbuf + ((size_t)(u.pm * BM + row) * 8) * 2;
        if (lane < 32) { const f32x4 q = (P[row * 4 + 0] + P[row * 4 + 1]) + (P[row * 4 + 2] + P[row * 4 + 3]);
            __hip_atomic_store(slot + u.pn * 2, ((unsigned long long)__float_as_uint(q[1]) << 32) | __float_as_uint(q[0]), __ATOMIC_RELAXED, __HIP_MEMORY_SCOPE_AGENT);
            __hip_atomic_store(slot + u.pn * 2 + 1, ((unsigned long long)__float_as_uint(q[3]) << 32) | __float_as_uint(q[2]), __ATOMIC_RELAXED, __HIP_MEMORY_SCOPE_AGENT); }
        asm volatile("s_waitcnt vmcnt(0)" ::: "memory"); __builtin_amdgcn_s_barrier(); asm volatile("" ::: "memory");
        if (wid == 0) {
            if (lane == 0) __hip_atomic_fetch_add(cnt + 64 * u.pm, 1u, __ATOMIC_RELAXED, __HIP_MEMORY_SCOPE_AGENT);
            unsigned sp = 0;
            while ((unsigned)__builtin_amdgcn_readfirstlane(__hip_atomic_load(cnt + 64 * u.pm, __ATOMIC_RELAXED, __HIP_MEMORY_SCOPE_AGENT)) < 8u) { __builtin_amdgcn_s_sleep(1); if (++sp > (1u << 22)) break; }
            __builtin_amdgcn_fence(__ATOMIC_ACQUIRE, "agent");
        }
        asm volatile("s_waitcnt vmcnt(0) lgkmcnt(0)" ::: "memory"); __builtin_amdgcn_s_barrier(); asm volatile("" ::: "memory");
        { const int hsel = lane >> 5; float pa = 0.f, pb = 0.f;
#pragma unroll
            for (int t = 0; t < 8; ++t) { const unsigned long long w = __hip_atomic_load(slot + t * 2 + hsel, __ATOMIC_RELAXED, __HIP_MEMORY_SCOPE_AGENT); pa += __uint_as_float((unsigned)w); pb += __uint_as_float((unsigned)(w >> 32)); }
            const float qa = __shfl_xor(pa, 32), qb = __shfl_xor(pb, 32);
            if (lane < 32) { const float saa = pa, sxx = pb, sxag = qa, sgg = qb;
                const float r1 = 1.0f / sqrtf(saa * inv_n + eps);
                float s1 = sxx + 2.0f * r1 * sxag + r1 * r1 * sgg; s1 = s1 < 0.f ? 0.f : s1;
                S[row * 2] = r1; S[row * 2 + 1] = 1.0f / sqrtf(s1 * inv_n + eps); } }
        asm volatile("s_waitcnt lgkmcnt(0)" ::: "memory"); __builtin_amdgcn_s_barrier(); asm volatile("" ::: "memory");
        int fr2 = fr, col2 = col0; asm volatile("" : "+v"(fr2), "+v"(col2));
        f32x4 g2v[2][2], g1v[2][2];
#pragma unroll
        for (int bj = 0; bj < 2; ++bj)
#pragma unroll
            for (int n = 0; n < 2; ++n) { g2v[bj][n] = g2 ? *(const f32x4*)(g2 + col2 + bj * HALF + n * 4) : (f32x4){0.f, 0.f, 0.f, 0.f}; g1v[bj][n] = gv[bj][n]; }
#pragma unroll
        for (int ai = 0; ai < 2; ++ai)
#pragma unroll
            for (int m = 0; m < 4; ++m) { const int r = ai * HALF + wr * 64 + m * 16 + fr2; const float r1 = S[r * 2], r2 = S[r * 2 + 1]; const size_t off = (size_t)(u.pm * BM + r) * ldc + col2;
#pragma unroll
                for (int bj = 0; bj < 2; ++bj) { u32x4 w4 = XL[((ai * 4 + m) * 2 + bj) * 512]; asm volatile("" : "+v"(w4.x), "+v"(w4.y), "+v"(w4.z), "+v"(w4.w));
                    const f32x4 xa = (f32x4){bflo(w4.x), bfhi(w4.x), bflo(w4.y), bfhi(w4.y)}, xb = (f32x4){bflo(w4.z), bfhi(w4.z), bflo(w4.w), bfhi(w4.w)};
                    const f32x4 x1a = xa + acc[ai][bj][m][0] * r1 * g1v[bj][0], x1b = xb + acc[ai][bj][m][1] * r1 * g1v[bj][1];
                    if (out_f) { *(f32x4*)(out_f + off + bj * HALF) = x1a; *(f32x4*)(out_f + off + bj * HALF + 4) = x1b; }
                    else { u32x4 o; o.x = cvt_pk_bf16(x1a[0], x1a[1]); o.y = cvt_pk_bf16(x1a[2], x1a[3]); o.z = cvt_pk_bf16(x1b[0], x1b[1]); o.w = cvt_pk_bf16(x1b[2], x1b[3]); *(u32x4*)(out_b + off + bj * HALF) = o; }
                    if (g2) { const f32x4 ya = x1a * r2 * g2v[bj][0], yb = x1b * r2 * g2v[bj][1]; u32x4 o; o.x = cvt_pk_bf16(ya[0], ya[1]); o.y = cvt_pk_bf16(ya[2], ya[3]); o.z = cvt_pk_bf16(yb[0], yb[1]); o.w = cvt_pk_bf16(yb[2], yb[3]);
                        *(u32x4*)(xn + off + bj * HALF) = o; } }
                asm volatile("" ::: "memory"); __builtin_amdgcn_sched_barrier(0); }
    }
};

struct EpiProj {
    static constexpr bool PERM = true, AFTER_DRAIN = false;
    bf16_t* O; int ldc; const float* rope; const float* qn; const float* kn; PG8_LAS float* X;
    __device__ __forceinline__ void operator()(const f32x4 (&acc)[2][2][4][2], const Unit& u, int wr, int wc, int fr_, int fq_) const {
        int fr = fr_, fq = fq_; asm volatile("" : "+v"(fr), "+v"(fq));
        const int pn = u.pn, kind = pn < 4 ? 1 : ((pn >= 10 && pn <= 12) ? 2 : 0);
        if (kind == 0) {
            const int row0 = u.pm * BM + wr * 64 + fr, col0 = pn * BM + wc * 32 + 8 * fq;
#pragma unroll
            for (int ai = 0; ai < 2; ++ai)
#pragma unroll
                for (int m = 0; m < 4; ++m) { bf16_t* rowp = O + (size_t)(row0 + ai * HALF + m * 16) * ldc + col0;
#pragma unroll
                    for (int bj = 0; bj < 2; ++bj) { const f32x4 v0 = acc[ai][bj][m][0], v1 = acc[ai][bj][m][1];
                        u32x4 w; w.x = cvt_pk_bf16(v0[0], v0[1]); w.y = cvt_pk_bf16(v0[2], v0[3]); w.z = cvt_pk_bf16(v1[0], v1[1]); w.w = cvt_pk_bf16(v1[2], v1[3]);
                        *(u32x4*)(rowp + bj * HALF) = w; } }
            return;
        }
        const int i0 = 8 * fq, c1 = pn * BM + 64 * wc + i0;
        float frev[8];
#pragma unroll
        for (int k = 0; k < 8; ++k) { constexpr float FK[8] = {0.15915494309189535f, 0.11934937021124886f, 0.08949940160889104f, 0.06711508300522727f, 0.05032921210448705f, 0.037741584717419785f, 0.02830219583062341f, 0.02122365276477767f};
            frev[k] = FK[k] * (fq == 0 ? 1.0f : (fq == 1 ? 0.1f : (fq == 2 ? 0.01f : 0.001f))); }
        f32x4 ga[2], gb[2];
        if (kind == 2) { const float* gn = (pn == 12 ? kn : qn) + 64 * (wc & 1) + i0;
            ga[0] = *(const f32x4*)gn; ga[1] = *(const f32x4*)(gn + 4); gb[0] = *(const f32x4*)(gn + 32); gb[1] = *(const f32x4*)(gn + 36);
#pragma unroll
            for (int ai = 0; ai < 2; ++ai)
#pragma unroll
                for (int m = 0; m < 4; ++m) { float q = 0.f;
#pragma unroll
                    for (int bj = 0; bj < 2; ++bj)
#pragma unroll
                        for (int n = 0; n < 2; ++n) { const f32x4 x = acc[ai][bj][m][n]; q += (x[0] * x[0] + x[1] * x[1]) + (x[2] * x[2] + x[3] * x[3]); }
                    q += __shfl_xor(q, 16); q += __shfl_xor(q, 32);
                    if (fq == 0) X[(ai * HALF + wr * 64 + m * 16 + fr) * 4 + wc] = q; }
            asm volatile("s_waitcnt lgkmcnt(0)" ::: "memory"); __builtin_amdgcn_s_barrier(); asm volatile("" ::: "memory");
        } else { ga[0] = ga[1] = gb[0] = gb[1] = (f32x4){1.f, 1.f, 1.f, 1.f}; }
#pragma unroll
        for (int ai = 0; ai < 2; ++ai)
#pragma unroll
            for (int m = 0; m < 4; ++m) { const int r = ai * HALF + wr * 64 + m * 16 + fr, row = u.pm * BM + r, t = row & 4095;
                const int pos = kind == 1 ? t : ((wc & 1) ? (t & 63) : (t >> 6));
                const float fpos = (float)pos;
                float rs = 1.f;
                if (kind == 2) rs = 1.0f / sqrtf((X[r * 4 + wc] + X[r * 4 + (wc ^ 1)]) * (1.0f / 128.0f) + 1e-6f);
                u32x4 w1, w2;
#pragma unroll
                for (int n = 0; n < 2; ++n) {
                    f32x4 c, sn;
#pragma unroll
                    for (int j = 0; j < 4; ++j) { const float rev = __builtin_amdgcn_fractf(fpos * frev[4 * n + j]); c[j] = __builtin_amdgcn_cosf(rev); sn[j] = __builtin_amdgcn_sinf(rev); }
                    const f32x4 a = acc[ai][0][m][n] * rs * ga[n], b = acc[ai][1][m][n] * rs * gb[n];
                    const f32x4 o1 = a * c - b * sn, o2 = a * sn + b * c;
                    if (n == 0) { w1.x = cvt_pk_bf16(o1[0], o1[1]); w1.y = cvt_pk_bf16(o1[2], o1[3]); w2.x = cvt_pk_bf16(o2[0], o2[1]); w2.y = cvt_pk_bf16(o2[2], o2[3]); }
                    else { w1.z = cvt_pk_bf16(o1[0], o1[1]); w1.w = cvt_pk_bf16(o1[2], o1[3]); w2.z = cvt_pk_bf16(o2[0], o2[1]); w2.w = cvt_pk_bf16(o2[2], o2[3]); }
                }
                bf16_t* rowp = O + (size_t)row * ldc + c1;
                *(u32x4*)rowp = w1;
                *(u32x4*)(rowp + 32) = w2; __builtin_amdgcn_sched_barrier(0); }
    }
};
struct StrideOrder {
    int first, G, count, nN;
    __device__ bool next(int i, Unit& u) const { const int j = first + i * G; if (j >= count) return false; u.pm = j / nN; u.pn = j % nN; return true; }
    __device__ __forceinline__ void a_ready(const Unit&) const {}
    __device__ __forceinline__ void done(const Unit&) const {}
};
template <class Epi, class Sched, bool ALIGN_EPI = false, bool SP2 = false>
__device__ __forceinline__ void gemm_phase(PG8_LAS unsigned char* lds, const Gemm g, const Sched& S, const Epi& E) {
    const int tid = opaque_tid(), wid = __builtin_amdgcn_readfirstlane(tid >> 6), lane = tid & 63, wr = wid >> 2, wc = wid & 3, fr = lane & 15, fq = lane >> 4;
    const int K = g.K, nt = K / BK;
    unsigned voffA[2], voffB[2];
#pragma unroll
    for (int i = 0; i < 2; ++i) { int R, C; stage_rc(tid * 16 + i * 8192, R, C); const int Rb = Epi::PERM ? ((R & ~31) + perm32(R & 31)) : R;
        voffA[i] = (unsigned)(R * K + C) * 2u; voffB[i] = (unsigned)(Rb * K + C) * 2u; }
    const size_t kstep = (size_t)(BK * 2);
    const size_t hstep = (size_t)HALF * K * 2;
    const size_t tstep = 2 * hstep;
    const unsigned ldsw = (unsigned)wid * 1024u;
    const int aoff = lds_byte(wr * 64 + fr, fq * 8), boff = lds_byte(wc * 32 + fr, fq * 8);
#define PG8_SA(b, h) (((b) * 2 + (h)) * HTB)
#define PG8_SB(b, h) ((4 + (b) * 2 + (h)) * HTB)
#define PG8_STAGE(bufoff, gbase, voff) do { _Pragma("unroll") for (int _i = 0; _i < 2; ++_i) \
        __builtin_amdgcn_global_load_lds((const unsigned*)((const char*)(gbase) + (voff)[_i]), (PG8_LAS unsigned*)(lds + (bufoff) + ldsw + _i * 8192), 16, 0, 0); } while (0)
#define PG8_LDA(dst, b, h) do { _Pragma("unroll") for (int m = 0; m < 4; ++m) _Pragma("unroll") for (int k = 0; k < 2; ++k) dst[m][k] = *(const PG8_LAS bf16x8*)(lds + PG8_SA(b, h) + aoff + m * 2048 + k * 1024); } while (0)
#define PG8_LDB(dst, b, h) do { _Pragma("unroll") for (int n = 0; n < 2; ++n) _Pragma("unroll") for (int k = 0; k < 2; ++k) dst[n][k] = *(const PG8_LAS bf16x8*)(lds + PG8_SB(b, h) + boff + n * 2048 + k * 1024); } while (0)
#define PG8_MMA(ai, bj, At, Bt) do { __builtin_amdgcn_s_setprio(1); _Pragma("unroll") for (int m = 0; m < 4; ++m) _Pragma("unroll") for (int n = 0; n < 2; ++n) _Pragma("unroll") for (int k = 0; k < 2; ++k) \
        acc[ai][bj][m][n] = __builtin_amdgcn_mfma_f32_16x16x32_bf16(Bt[n][k], At[m][k], acc[ai][bj][m][n], 0, 0, 0); __builtin_amdgcn_s_setprio(0); } while (0)
#define PG8_WAIT_V(n) asm volatile("s_waitcnt vmcnt(" #n ")" ::: "memory")
#define PG8_WAIT_L(n) asm volatile("s_waitcnt lgkmcnt(" #n ")" ::: "memory")
#define PG8_BAR __builtin_amdgcn_s_barrier()
#define PG8_SCHED __builtin_amdgcn_sched_barrier(0)
    Unit cur, nxt; int ui = 0;
    if (!S.next(0, cur)) return;
    f32x4 acc[2][2][4][2];
#pragma unroll
    for (int a = 0; a < 2; ++a)
#pragma unroll
        for (int b = 0; b < 2; ++b)
#pragma unroll
            for (int m = 0; m < 4; ++m)
#pragma unroll
                for (int n = 0; n < 2; ++n) acc[a][b][m][n] = (f32x4){0.f, 0.f, 0.f, 0.f};
    bf16x8 At[4][2], B0[2][2], B1[2][2];
    const char* cA = (const char*)g.A + (size_t)cur.pm * tstep; const char* cB = (const char*)g.Bt + (size_t)cur.pn * tstep;
    S.a_ready(cur);
    if constexpr (SP2) {
        PG8_STAGE(PG8_SB(0, 0), cB, voffB); PG8_STAGE(PG8_SB(0, 1), cB + hstep, voffB); PG8_STAGE(PG8_SA(0, 0), cA, voffA); PG8_STAGE(PG8_SA(0, 1), cA + hstep, voffA);
        if (wr == 1) PG8_BAR;
        PG8_WAIT_V(2); PG8_BAR;
        PG8_STAGE(PG8_SB(1, 0), cB + kstep, voffB); PG8_STAGE(PG8_SA(1, 0), cA + kstep, voffA); PG8_STAGE(PG8_SB(1, 1), cB + hstep + kstep, voffB);
        PG8_WAIT_V(6); PG8_BAR;
    } else {
        PG8_STAGE(PG8_SB(0, 0), cB, voffB); PG8_STAGE(PG8_SA(0, 0), cA, voffA); PG8_STAGE(PG8_SB(0, 1), cB + hstep, voffB); PG8_STAGE(PG8_SA(0, 1), cA + hstep, voffA);
        if (wr == 1) PG8_BAR;
        PG8_WAIT_V(4); PG8_BAR;
        PG8_STAGE(PG8_SB(1, 0), cB + kstep, voffB); PG8_STAGE(PG8_SA(1, 0), cA + kstep, voffA); PG8_STAGE(PG8_SB(1, 1), cB + hstep + kstep, voffB);
        PG8_WAIT_V(6); PG8_BAR;
    }
    for (;;) {
        const bool has_next = S.next(ui + 1, nxt);
        const char* nA = has_next ? (const char*)g.A + (size_t)nxt.pm * tstep : cA; const char* nB = has_next ? (const char*)g.Bt + (size_t)nxt.pn * tstep : cB;
        for (int t = 0; t < nt; t += 2) {
            const bool last = (t == nt - 2);
            const char* a1 = cA + (size_t)(t + 1) * kstep;
            const char* a2 = last ? nA : cA + (size_t)(t + 2) * kstep; const char* b2 = last ? nB : cB + (size_t)(t + 2) * kstep;
            const char* a3 = a2 + kstep; const char* b3 = b2 + kstep;
            if (last && has_next) S.a_ready(nxt);
            if constexpr (SP2) {
            PG8_LDB(B0, 0, 0); PG8_LDB(B1, 0, 1); PG8_SCHED; PG8_LDA(At, 0, 0); PG8_STAGE(PG8_SA(1, 1), a1 + hstep, voffA);
            PG8_WAIT_V(8); PG8_WAIT_L(0); PG8_BAR; PG8_MMA(0, 0, At, B0); PG8_MMA(0, 1, At, B1); PG8_BAR; PG8_SCHED;
            PG8_LDA(At, 0, 1); PG8_STAGE(PG8_SB(0, 0), b2, voffB); PG8_STAGE(PG8_SB(0, 1), b2 + hstep, voffB); PG8_STAGE(PG8_SA(0, 0), a2, voffA);
            PG8_WAIT_V(8); PG8_WAIT_L(0); PG8_BAR; PG8_MMA(1, 0, At, B0); PG8_MMA(1, 1, At, B1); PG8_BAR; PG8_SCHED;
            PG8_LDB(B0, 1, 0); PG8_LDB(B1, 1, 1); PG8_SCHED; PG8_LDA(At, 1, 0); PG8_STAGE(PG8_SA(0, 1), a2 + hstep, voffA);
            PG8_WAIT_V(8); PG8_WAIT_L(0); PG8_BAR; PG8_MMA(0, 0, At, B0); PG8_MMA(0, 1, At, B1); PG8_BAR; PG8_SCHED;
            PG8_LDA(At, 1, 1); PG8_STAGE(PG8_SB(1, 0), b3, voffB); PG8_STAGE(PG8_SB(1, 1), b3 + hstep, voffB); PG8_STAGE(PG8_SA(1, 0), a3, voffA);
            PG8_WAIT_V(8); PG8_WAIT_L(0); PG8_BAR; PG8_MMA(1, 0, At, B0); PG8_MMA(1, 1, At, B1); PG8_BAR; PG8_SCHED;
            } else {
            PG8_LDB(B0, 0, 0); PG8_SCHED; PG8_LDA(At, 0, 0); PG8_STAGE(PG8_SA(1, 1), a1 + hstep, voffA);
            PG8_WAIT_L(8); PG8_BAR; PG8_WAIT_L(0); PG8_MMA(0, 0, At, B0); PG8_BAR; PG8_SCHED;
            PG8_LDB(B1, 0, 1); PG8_STAGE(PG8_SB(0, 0), b2, voffB);
            PG8_BAR; PG8_WAIT_L(0); PG8_MMA(0, 1, At, B1); PG8_BAR;
            PG8_LDA(At, 0, 1); PG8_STAGE(PG8_SA(0, 0), a2, voffA);
            PG8_BAR; PG8_WAIT_L(0); PG8_MMA(1, 0, At, B0); PG8_BAR; PG8_SCHED;
            PG8_STAGE(PG8_SB(0, 1), b2 + hstep, voffB);
            PG8_WAIT_V(6); PG8_BAR; PG8_MMA(1, 1, At, B1); PG8_BAR;
            PG8_LDB(B0, 1, 0); PG8_SCHED; PG8_LDA(At, 1, 0); PG8_STAGE(PG8_SA(0, 1), a2 + hstep, voffA);
            PG8_WAIT_L(8); PG8_BAR; PG8_WAIT_L(0); PG8_MMA(0, 0, At, B0); PG8_BAR; PG8_SCHED;
            PG8_LDB(B1, 1, 1); PG8_STAGE(PG8_SB(1, 0), b3, voffB);
            PG8_BAR; PG8_WAIT_L(0); PG8_MMA(0, 1, At, B1); PG8_BAR;
            PG8_LDA(At, 1, 1); PG8_STAGE(PG8_SA(1, 0), a3, voffA);
            PG8_BAR; PG8_WAIT_L(0); PG8_MMA(1, 0, At, B0); PG8_BAR; PG8_SCHED;
            PG8_STAGE(PG8_SB(1, 1), b3 + hstep, voffB);
            PG8_WAIT_V(6); PG8_BAR; PG8_MMA(1, 1, At, B1); PG8_BAR;
            }
        }
        if constexpr (ALIGN_EPI) { if (wr == 0) PG8_BAR; }
        if constexpr (!Epi::AFTER_DRAIN) { E(acc, cur, wr, wc, fr, fq); S.done(cur); }
        if (!has_next) break;
#pragma unroll
        for (int a = 0; a < 2; ++a)
#pragma unroll
            for (int b = 0; b < 2; ++b)
#pragma unroll
                for (int m = 0; m < 4; ++m)
#pragma unroll
                    for (int n = 0; n < 2; ++n) acc[a][b][m][n] = (f32x4){0.f, 0.f, 0.f, 0.f};
        cur = nxt; cA = nA; cB = nB; ++ui;
        if constexpr (ALIGN_EPI) { if (wr == 1) PG8_BAR; }
    }
    PG8_WAIT_V(0);
    if constexpr (!ALIGN_EPI) { if (wr == 0) PG8_BAR; }
    PG8_BAR;
    if constexpr (Epi::AFTER_DRAIN) { E.fused(acc, cur, wr, wc, fr, fq, lds, wid, lane); S.done(cur); }
#undef PG8_SA
#undef PG8_SB
#undef PG8_STAGE
#undef PG8_LDA
#undef PG8_LDB
#undef PG8_MMA
#undef PG8_WAIT_V
#undef PG8_WAIT_L
#undef PG8_BAR
#undef PG8_SCHED
}
}
namespace att {
using bf16 = unsigned short;
using bf16x8 = __attribute__((ext_vector_type(8))) short;
using s16x4  = __attribute__((ext_vector_type(4))) short;
using f32x16 = __attribute__((ext_vector_type(16))) float;
using u32x4  = __attribute__((ext_vector_type(4))) unsigned;
constexpr int KVBLK = 64, LDP = 5120;
constexpr float THR = 8.f;
constexpr int SHM_V = 16384, SHM_K = 16384, SHM_ATTN = 2 * SHM_V + 2 * SHM_K + 8 * 64 * 4;
constexpr int RPB_OFF = SHM_ATTN, Q_OFF = SHM_ATTN + 2048;
#define SBAR() __builtin_amdgcn_sched_barrier(0)
template <int DK> __device__ __forceinline__ int kswz(int row, int colB) { return DK == 128 ? row * 256 + (colB ^ ((row & 7) << 4)) : row * 128 + (colB ^ (((row >> 1) & 7) << 4)); }
__device__ __forceinline__ int crow(int r, int hi) { return (r & 3) + 8 * (r >> 2) + 4 * hi; }
__device__ __forceinline__ unsigned cvtpk(float lo, float hi) { unsigned r; asm volatile("v_cvt_pk_bf16_f32 %0, %1, %2" : "=v"(r) : "v"(lo), "v"(hi)); return r; }

__device__ __forceinline__ void partialSM(f32x16& p0, f32x16& p1, float& m_reg, float& mn, float& alpha, float C, float thrRaw) {
  float pmax = p0[0];
#pragma unroll
  for (int r = 1; r < 16; ++r) pmax = fmaxf(pmax, p0[r]);
#pragma unroll
  for (int r = 0; r < 16; ++r) pmax = fmaxf(pmax, p1[r]);
  { auto rr = __builtin_amdgcn_permlane32_swap(__float_as_uint(pmax), __float_as_uint(pmax), false, false);
    pmax = fmaxf(__uint_as_float(rr[0]), __uint_as_float(rr[1])); }
  if (__builtin_expect(__all(pmax - m_reg <= thrRaw), 1)) { mn = m_reg; alpha = 1.f; }
  else { mn = fmaxf(m_reg, pmax); alpha = __builtin_amdgcn_exp2f((m_reg - mn) * C); m_reg = mn; }
  float mnC = -mn * C;
#pragma unroll
  for (int r = 0; r < 16; ++r) p0[r] = fmaf(p0[r], C, mnC);
#pragma unroll
  for (int r = 0; r < 16; ++r) p1[r] = fmaf(p1[r], C, mnC);
#pragma unroll
  for (int r = 0; r < 16; ++r) p0[r] = __builtin_amdgcn_exp2f(p0[r]);
}
__device__ __forceinline__ void finishSM(f32x16& p0, f32x16& p1, float alpha, float& l_reg, bf16x8& pa0, bf16x8& pa1, bf16x8& pa2, bf16x8& pa3) {
#pragma unroll
  for (int r = 0; r < 16; ++r) p1[r] = __builtin_amdgcn_exp2f(p1[r]);
  float ps = 0;
#pragma unroll
  for (int r = 0; r < 16; ++r) ps += p0[r];
#pragma unroll
  for (int r = 0; r < 16; ++r) ps += p1[r];
  { auto rr = __builtin_amdgcn_permlane32_swap(__float_as_uint(ps), __float_as_uint(ps), false, false);
    ps = __uint_as_float(rr[0]) + __uint_as_float(rr[1]); }
  l_reg = l_reg * alpha + ps;
#define PK4(P, BASE, OUT) do { unsigned a0 = cvtpk(P[BASE + 0], P[BASE + 1]), a1 = cvtpk(P[BASE + 2], P[BASE + 3]);   \
    unsigned b0 = cvtpk(P[BASE + 4], P[BASE + 5]), b1 = cvtpk(P[BASE + 6], P[BASE + 7]);                              \
    auto r0 = __builtin_amdgcn_permlane32_swap(a0, b0, false, false); auto r1 = __builtin_amdgcn_permlane32_swap(a1, b1, false, false); \
    u32x4 w = {r0[0], r1[0], r0[1], r1[1]}; OUT = *reinterpret_cast<bf16x8*>(&w); } while (0)
  PK4(p0, 0, pa0); PK4(p0, 8, pa1); PK4(p1, 0, pa2); PK4(p1, 8, pa3);
#undef PK4
}
template <int DK, bool QL>
__device__ __forceinline__ void qkt(f32x16& p0, f32x16& p1, const bf16* Ks, const bf16x8* qr, const char* ql, int r32, int hi) {
  p0 = f32x16{}; p1 = f32x16{};
#pragma unroll
  for (int d0 = 0; d0 < DK / 16; ++d0) { int cb = (d0 * 16 + hi * 8) * 2;
    const bf16x8 qv = QL ? *reinterpret_cast<const bf16x8*>(ql + d0 * 1024) : qr[d0];
    bf16x8 b0 = *reinterpret_cast<const bf16x8*>((const char*)Ks + kswz<DK>(r32, cb));
    bf16x8 b1 = *reinterpret_cast<const bf16x8*>((const char*)Ks + kswz<DK>(32 + r32, cb));
    p0 = __builtin_amdgcn_mfma_f32_32x32x16_bf16(b0, qv, p0, 0, 0, 0);
    p1 = __builtin_amdgcn_mfma_f32_32x32x16_bf16(b1, qv, p1, 0, 0, 0); }
}
__device__ __forceinline__ void na_hook(f32x16& p0, f32x16& p1, int kr, int q_row, int q_col, int win_r, int win_c, const float* rpb, float inv_scale, int hi) {
  const bool rowok = (kr >= win_r) && (kr < win_r + 8);
  int ir = kr - q_row + 7; ir = ir < 0 ? 0 : (ir > 14 ? 14 : ir);
  const float* rp = rpb + ir * 31;
#pragma unroll
  for (int r = 0; r < 16; ++r) {
    const int kc = crow(r, hi);
    { const bool ok = rowok && kc >= win_c && kc < win_c + 16; int ic = kc - q_col + 15; ic = ic < 0 ? 0 : (ic > 30 ? 30 : ic);
      p0[r] = ok ? fmaf(rp[ic], inv_scale, p0[r]) : -1e30f; }
    { const int kc2 = kc + 32; const bool ok = rowok && kc2 >= win_c && kc2 < win_c + 16; int ic = kc2 - q_col + 15; ic = ic < 0 ? 0 : (ic > 30 ? 30 : ic);
      p1[r] = ok ? fmaf(rp[ic], inv_scale, p1[r]) : -1e30f; }
  }
}
__device__ __forceinline__ int v_st(int k, int c) { const int kk = (k & ~0xC) | ((k & 4) << 1) | ((k & 8) >> 1); return ((kk >> 3) * 4 + (c >> 5)) * 512 + ((kk & 7) * 32 + (c & 31)) * 2; }
__device__ __forceinline__ int v_rd_base(int lane) { return ((lane & 3) << 3) | (((lane >> 2) & 3) << 6) | (((lane >> 4) & 1) << 5) | (((lane >> 5) & 1) << 8); }
constexpr int v_rd_off(int d0, int ks, int half) { return d0 * 512 + ks * 4096 + half * 2048; }
template <int OFF> __device__ __forceinline__ s16x4 tr_read(int vb) {
  s16x4 r; asm volatile("ds_read_b64_tr_b16 %0, %1 offset:%2" : "=&v"(r) : "v"(vb), "i"(OFF) : "memory"); return r;
}
template <int D0> __device__ __forceinline__ void pv_one(f32x16& od, int vb, bf16x8 pa0, bf16x8 pa1, bf16x8 pa2, bf16x8 pa3) {
  const s16x4 l0 = tr_read<v_rd_off(D0, 0, 0)>(vb), h0 = tr_read<v_rd_off(D0, 0, 1)>(vb), l1 = tr_read<v_rd_off(D0, 1, 0)>(vb), h1 = tr_read<v_rd_off(D0, 1, 1)>(vb);
  const s16x4 l2 = tr_read<v_rd_off(D0, 2, 0)>(vb), h2 = tr_read<v_rd_off(D0, 2, 1)>(vb), l3 = tr_read<v_rd_off(D0, 3, 0)>(vb), h3 = tr_read<v_rd_off(D0, 3, 1)>(vb);
  asm volatile("s_waitcnt lgkmcnt(0)" ::: "memory"); SBAR();
#define PK(L, H) (bf16x8){L[0], L[1], L[2], L[3], H[0], H[1], H[2], H[3]}
  od = __builtin_amdgcn_mfma_f32_32x32x16_bf16(pa0, PK(l0, h0), od, 0, 0, 0);
  od = __builtin_amdgcn_mfma_f32_32x32x16_bf16(pa1, PK(l1, h1), od, 0, 0, 0);
  od = __builtin_amdgcn_mfma_f32_32x32x16_bf16(pa2, PK(l2, h2), od, 0, 0, 0);
  od = __builtin_amdgcn_mfma_f32_32x32x16_bf16(pa3, PK(l3, h3), od, 0, 0, 0);
#undef PK
}
__device__ __forceinline__ void pv_d0(f32x16* o, int vb, bf16x8 pa0, bf16x8 pa1, bf16x8 pa2, bf16x8 pa3) {
  pv_one<0>(o[0], vb, pa0, pa1, pa2, pa3); pv_one<1>(o[1], vb, pa0, pa1, pa2, pa3); pv_one<2>(o[2], vb, pa0, pa1, pa2, pa3); pv_one<3>(o[3], vb, pa0, pa1, pa2, pa3);
}
template <int DK, bool NA, bool QL, int SD>
__device__ __forceinline__ void attn_body(const bf16* __restrict__ Qb, const bf16* __restrict__ Kh, const bf16* __restrict__ Vh, int NT, char* lds,
                                          float C, float thrRaw, f32x16 (&o)[4], int krow0, int q_row, int q_col, float inv_scale) {
  const int tid = opaque_tid(), wid = tid >> 6, lane = tid & 63, r32 = lane & 31, hi = lane >> 5;
  bf16* V_lds = (bf16*)lds; bf16* K_lds = (bf16*)(lds + 2 * SHM_V);
  float* ws = (float*)(lds + 2 * SHM_V + 2 * SHM_K) + wid * 64; float* li_l = ws; float* al_l = ws + 32;
  const float* rpb = (const float*)(lds + RPB_OFF);
  int win_r = q_row - 4; win_r = win_r < 0 ? 0 : (win_r > 56 ? 56 : win_r);
  int win_c = q_col - 8; win_c = win_c < 0 ? 0 : (win_c > 48 ? 48 : win_c);
  float m_reg = -1e30f, l_reg = 0; bf16x8 qr[QL ? 1 : DK / 16];
  char* ql = lds + Q_OFF + (wid * (DK / 16) * 64 + lane) * 16;
#pragma unroll
  for (int d = 0; d < 4; ++d) o[d] = f32x16{};
  const bf16* Qw = Qb + (long)(wid * 32 + r32) * LDP + hi * 8;
#pragma unroll
  for (int d0 = 0; d0 < DK / 16; ++d0) { const bf16x8 qv = *reinterpret_cast<const bf16x8*>(Qw + d0 * 16); if (QL) *reinterpret_cast<bf16x8*>(ql + d0 * 1024) = qv; else qr[d0] = qv; }
  const int sr = tid >> 4, sc = (tid & 15) * 8, vst0 = v_st(sr, sc), vst1 = v_st(32 + sr, sc);
  const int ksr = DK == 128 ? sr : (tid >> 3), ksc = DK == 128 ? sc : (tid & 7) * 8;
  const int vb0 = (int)(uintptr_t)V_lds + v_rd_base(lane);
  struct { bf16x8 vs0, vs1, ks0, ks1; } sr_[SD];
#define SLOAD(i, k0) do { sr_[i].vs0 = *reinterpret_cast<const bf16x8*>(&Vh[(long)((k0) + sr) * LDP + sc]); sr_[i].vs1 = *reinterpret_cast<const bf16x8*>(&Vh[(long)((k0) + 32 + sr) * LDP + sc]); \
    sr_[i].ks0 = *reinterpret_cast<const bf16x8*>(&Kh[(long)((k0) + ksr) * LDP + ksc]); if (DK == 128) sr_[i].ks1 = *reinterpret_cast<const bf16x8*>(&Kh[(long)((k0) + 32 + ksr) * LDP + ksc]); } while (0)
#define SWRITE(b, i) do { *(bf16x8*)((char*)V_lds + (b) * SHM_V + vst0) = sr_[i].vs0;          \
    *(bf16x8*)((char*)V_lds + (b) * SHM_V + vst1) = sr_[i].vs1; int kc = ksc * 2;               \
    *(bf16x8*)((char*)K_lds + (b) * SHM_K + kswz<DK>(ksr, kc)) = sr_[i].ks0;                       \
    if (DK == 128) *(bf16x8*)((char*)K_lds + (b) * SHM_K + kswz<DK>(32 + ksr, kc)) = sr_[i].ks1; } while (0)
#define SWAIT() do { if (SD == 1) asm volatile("s_waitcnt vmcnt(0)" ::: "memory"); else if (DK == 128) asm volatile("s_waitcnt vmcnt(4)" ::: "memory"); else asm volatile("s_waitcnt vmcnt(3)" ::: "memory"); } while (0)
#define RESC(a) do { if (__any((a) < 1.f)) { if (hi == 0) al_l[r32] = (a); asm volatile("s_waitcnt lgkmcnt(0)" ::: "memory"); \
    _Pragma("unroll") for (int d = 0; d < 4; ++d) _Pragma("unroll") for (int r = 0; r < 16; ++r) o[d][r] *= al_l[crow(r, hi)]; } } while (0)
#define HOOK(P0, P1, j) do { if (NA) na_hook(P0, P1, krow0 + (j), q_row, q_col, win_r, win_c, rpb, inv_scale, hi); } while (0)
  f32x16 pA0, pA1, pB0, pB1; float mnA, mnB, alA, alB; bf16x8 pa0, pa1, pa2, pa3;
  constexpr int SE = 0, SO = SD - 1;
  SLOAD(SE, 0); asm volatile("s_waitcnt vmcnt(0)" ::: "memory"); SWRITE(0, SE); __syncthreads();
  qkt<DK, QL>(pA0, pA1, K_lds, qr, ql, r32, hi); HOOK(pA0, pA1, 0); partialSM(pA0, pA1, m_reg, mnA, alA, C, thrRaw);
  SLOAD(SO, KVBLK); if (SD == 2) { if (2 < NT) SLOAD(SE, 2 * KVBLK); }
  SWAIT(); SWRITE(1, SO); __syncthreads();
  for (int j = 1; j + 1 < NT; j += 2) {
    SBAR(); qkt<DK, QL>(pB0, pB1, (bf16*)((char*)K_lds + SHM_K), qr, ql, r32, hi); HOOK(pB0, pB1, j);
    finishSM(pA0, pA1, alA, l_reg, pa0, pa1, pa2, pa3); SBAR();
    SLOAD(SO, (j + SD) * KVBLK); SBAR();
    pv_d0(o, vb0, pa0, pa1, pa2, pa3); partialSM(pB0, pB1, m_reg, mnB, alB, C, thrRaw);
    __syncthreads(); SWAIT(); SWRITE(0, SE);
    RESC(alB); __syncthreads();
    SBAR(); qkt<DK, QL>(pA0, pA1, K_lds, qr, ql, r32, hi); HOOK(pA0, pA1, j + 1);
    finishSM(pB0, pB1, alB, l_reg, pa0, pa1, pa2, pa3); SBAR();
    if (SD == 1 || j + 3 < NT) SLOAD(SE, (j + 1 + SD) * KVBLK); SBAR();
    pv_d0(o, vb0 + (int)SHM_V, pa0, pa1, pa2, pa3); partialSM(pA0, pA1, m_reg, mnA, alA, C, thrRaw);
    __syncthreads(); SWAIT(); SWRITE(1, SO);
    RESC(alA); __syncthreads();
  }
  SBAR(); qkt<DK, QL>(pB0, pB1, (bf16*)((char*)K_lds + SHM_K), qr, ql, r32, hi); HOOK(pB0, pB1, NT - 1);
  finishSM(pA0, pA1, alA, l_reg, pa0, pa1, pa2, pa3); SBAR();
  pv_d0(o, vb0, pa0, pa1, pa2, pa3); partialSM(pB0, pB1, m_reg, mnB, alB, C, thrRaw);
  __syncthreads(); RESC(alB);
  finishSM(pB0, pB1, alB, l_reg, pa0, pa1, pa2, pa3); SBAR();
  pv_d0(o, vb0 + (int)SHM_V, pa0, pa1, pa2, pa3);
  if (hi == 0) li_l[r32] = l_reg; asm volatile("s_waitcnt vmcnt(0) lgkmcnt(0)" ::: "memory");
#pragma unroll
  for (int r = 0; r < 16; ++r) { const float rl = __builtin_amdgcn_rcpf(li_l[crow(r, hi)]);
#pragma unroll
    for (int d = 0; d < 4; ++d) o[d][r] *= rl; }
#undef SLOAD
#undef SWRITE
#undef SWAIT
#undef RESC
#undef HOOK
}
#undef SBAR
}
#define GAS __attribute__((address_space(1)))
#define LAS __attribute__((address_space(3)))
typedef unsigned short bf16;
typedef unsigned v4u __attribute__((ext_vector_type(4)));
typedef unsigned v2u __attribute__((ext_vector_type(2)));
typedef float f32x4 __attribute__((ext_vector_type(4)));
typedef float f32x2 __attribute__((ext_vector_type(2)));
constexpr int NWAVES = 8, NTHR = 512;
constexpr int SEQ = 4096, M = 8192, DM = 2048, NIN = 5120, FF = 5632, DEPTH = 2, CC = 512;
constexpr float EPS = 1e-6f;
constexpr int PA_Q = 0, PA_K = 512, PA_V = 1024, PB_A = 1536, PB_G = 2048, PC_Q = 2560, PC_K = 3072, PC_V = 3328, PD_Q = 3584, PD_K = 4096, PD_V = 4608;
constexpr size_t MiB = 1u << 20;
constexpr size_t WS_ROPE = 1 * MiB;
constexpr size_t WS_WIN = 2 * MiB;
constexpr size_t WS_WOUT = WS_WIN + 40 * MiB;
constexpr size_t WS_WGU = WS_WOUT + 16 * MiB;
constexpr size_t WS_WDN = WS_WGU + 88 * MiB;
constexpr size_t WS_WPW = WS_WDN + 44 * MiB;
constexpr size_t WS_XN = WS_WPW + 1 * MiB;
constexpr size_t WS_PROJ = WS_XN + 32 * MiB;
constexpr size_t WS_CAT = WS_PROJ + 80 * MiB;
constexpr size_t WS_H = WS_PROJ;
constexpr size_t WS_MIX = WS_CAT + 32 * MiB;
constexpr size_t WS_CV = WS_MIX + 64 * MiB;
constexpr size_t WS_END = WS_CV + 8 * MiB;
constexpr int LDS_BYTES = 163840;

__device__ __forceinline__ unsigned f2bf(float f) { unsigned u = __builtin_bit_cast(unsigned, f); return (u + 0x7fffu + ((u >> 16) & 1u)) >> 16; }
__device__ __forceinline__ unsigned pk2(float lo, float hi) { return f2bf(lo) | (f2bf(hi) << 16); }
__device__ __forceinline__ float bf2f(unsigned short b) { return __builtin_bit_cast(float, (unsigned)b << 16); }
__device__ __forceinline__ float wave_sum(float v) {
#pragma unroll
    for (int o = 1; o < 64; o <<= 1) v += __shfl_xor(v, o);
    return v;
}
#define LDS_WAIT() asm volatile("s_waitcnt lgkmcnt(0)" ::: "memory")

#define XB_TMO      128
#define XB_XCNT(j)  (256  + 64 * (j))
#define XB_XSUB(j)  (1280 + 64 * (j))
#define XB_XGEN(j)  (2304 + 64 * (j))
#define XB_TOP      3328
#define XB_TOPGEN   3392
#define XCD_BAR_WORDS 3456
#define XB_SPIN_CAP (1u << 18)

__device__ __forceinline__ unsigned xb_ld(unsigned* p)              { return __hip_atomic_load(p, __ATOMIC_RELAXED, __HIP_MEMORY_SCOPE_AGENT); }
__device__ __forceinline__ unsigned xb_add(unsigned* p, unsigned v) { return __hip_atomic_fetch_add(p, v, __ATOMIC_RELAXED, __HIP_MEMORY_SCOPE_AGENT); }
__device__ __forceinline__ unsigned xb_xcc_id() { return (unsigned)__builtin_amdgcn_s_getreg((3 << 11) | 20) & 0xFu; }
#define XB_SPIN(cond, bar) do { unsigned _sp = 0; while (cond) { __builtin_amdgcn_s_sleep(1); \
    if ((++_sp & 255u) == 0u) { if (xb_ld(&(bar)[XB_TMO])) break; if (_sp > XB_SPIN_CAP) { atomicAdd(&(bar)[XB_TMO], 1u); break; } } } } while (0)

struct XcdBarrier {
    unsigned* bar; unsigned x;
    volatile LAS unsigned* st;
};

__device__ __forceinline__ XcdBarrier xcd_barrier_post(unsigned* bar, volatile LAS unsigned* st) {
    XcdBarrier b; b.bar = bar; b.x = xb_xcc_id(); b.st = st;
    if (threadIdx.x == 0) (void)xb_add(&bar[XB_XCNT(b.x)], 1u);
    return b;
}
__device__ __forceinline__ void xcd_barrier_complete(unsigned* bar, unsigned x, unsigned& nloc, unsigned& nx) {
    const unsigned G = gridDim.x * gridDim.y * gridDim.z;
    unsigned sum, cnt, mine, sp = 0u;
    for (;;) {
        sum = 0u; cnt = 0u; mine = 0u;
#pragma unroll
        for (unsigned j = 0; j < 16; ++j) { const unsigned c = xb_ld(&bar[XB_XCNT(j)]); sum += c; cnt += (c > 0u) ? 1u : 0u; mine = (j == x) ? c : mine; }
        if (sum == G) break;
        __builtin_amdgcn_s_sleep(1);
        if ((++sp & 255u) == 0u) { if (xb_ld(&bar[XB_TMO])) break; if (sp > XB_SPIN_CAP) { atomicAdd(&bar[XB_TMO], 1u); break; } }
    }
    nloc = mine > 0u ? mine : 1u; nx = cnt > 0u ? cnt : 1u;
}

__device__ __forceinline__ void xcd_barrier(const XcdBarrier& b) {
    asm volatile("s_waitcnt vmcnt(0)" ::: "memory");
    __syncthreads();
    if (threadIdx.x == 0) {
        unsigned* bar = b.bar;
        __builtin_amdgcn_s_waitcnt(0);
        unsigned nloc = b.st[0], nx = b.st[1];
        if (nloc == 0u) { xcd_barrier_complete(bar, b.x, nloc, nx); b.st[0] = nloc; b.st[1] = nx; }
        const unsigned old = xb_add(&bar[XB_XSUB(b.x)], 1u);
        const unsigned gen = old / nloc;
        if (old + 1u == (gen + 1u) * nloc) {
            __builtin_amdgcn_fence(__ATOMIC_RELEASE, "agent");
            asm volatile("s_waitcnt vmcnt(0)" ::: "memory");
            const unsigned og = xb_add(&bar[XB_TOP], 1u);
            const unsigned tg = og / nx;
            if (og + 1u == (tg + 1u) * nx) xb_add(&bar[XB_TOPGEN], 1u);
            else XB_SPIN(xb_ld(&bar[XB_TOPGEN]) == tg, bar);
            __builtin_amdgcn_fence(__ATOMIC_ACQUIRE, "agent");
            xb_add(&bar[XB_XGEN(b.x)], 1u);
            asm volatile("s_waitcnt vmcnt(0)" ::: "memory");
        } else {
            XB_SPIN(xb_ld(&bar[XB_XGEN(b.x)]) == gen, bar);
            __builtin_amdgcn_fence(__ATOMIC_ACQUIRE, "agent");
            asm volatile("s_waitcnt vmcnt(0)" ::: "memory");
        }
    }
    __syncthreads();
}

struct Params {
    const float* x; const float* norm_mix_pre; const float* norm_mix_post; const float* norm_ffn_pre; const float* norm_ffn_post;
    const float* w_in; const float* w_out; const float* diff_lambda; const float* diff_subln; const float* conv_dw; const float* conv_dw_b;
    const float* conv_ln_g; const float* conv_ln_b; const float* conv_pw; const float* conv_pw_b; const float* gqa_q_norm; const float* gqa_k_norm;
    const float* na_rpb; const float* ffn_gate; const float* ffn_up; const float* ffn_down;
    float* out; unsigned char* ws;
};

__device__ __forceinline__ void transpose_item(const float* __restrict__ W, int K, int N, bf16* WT, int k0, int n0, int dst_row0, LAS float* scr, int lane) {
    const int r = lane >> 3, q = lane & 7;
    f32x4 v[8];
#pragma unroll
    for (int i = 0; i < 8; ++i) v[i] = __builtin_nontemporal_load((const f32x4*)(W + (size_t)(k0 + 8 * i + r) * N + n0 + 4 * q));
#pragma unroll
    for (int i = 0; i < 8; ++i) { LAS float* d = scr + (8 * i + r) * 33 + 4 * q; d[0] = v[i].x; d[1] = v[i].y; d[2] = v[i].z; d[3] = v[i].w; }
    LDS_WAIT(); asm volatile("" ::: "memory");
    const int c = lane & 7;
#pragma unroll
    for (int j = 0; j < 4; ++j) { const int n = (lane >> 3) + 8 * j; const LAS float* s = scr + (8 * c) * 33 + n;
        v4u o; o.x = pk2(s[0 * 33], s[1 * 33]); o.y = pk2(s[2 * 33], s[3 * 33]); o.z = pk2(s[4 * 33], s[5 * 33]); o.w = pk2(s[6 * 33], s[7 * 33]);
        __builtin_nontemporal_store(o, (v4u*)(WT + (size_t)(dst_row0 + n) * K + k0 + 8 * c)); }
    LDS_WAIT(); asm volatile("" ::: "memory");
}
__device__ __forceinline__ void norm_row_bf16(const f32x4* v, const float* __restrict__ g, bf16* orow, int lane) {
    float s = 0.f;
#pragma unroll
    for (int j = 0; j < 8; ++j) s += (v[j].x * v[j].x + v[j].y * v[j].y) + (v[j].z * v[j].z + v[j].w * v[j].w);
    const float rstd = 1.0f / sqrtf(wave_sum(s) * (1.0f / DM) + EPS);
#pragma unroll
    for (int j = 0; j < 8; ++j) { const f32x4 gv = *(const f32x4*)(g + 4 * (lane + 64 * j));
        v2u o; o.x = pk2(v[j].x * rstd * gv.x, v[j].y * rstd * gv.y); o.y = pk2(v[j].z * rstd * gv.z, v[j].w * rstd * gv.w);
        *(v2u*)(orow + 4 * (lane + 64 * j)) = o; }
}
__device__ __forceinline__ void rows_update(const float* xin, const float* mix, const float* __restrict__ g_post, float* xout, const float* __restrict__ g_next, bf16* XN, int gw, int ngw, int lane) {
    for (int m = gw; m < M; m += ngw) {
        f32x4 a[8], v[8]; float s = 0.f;
#pragma unroll
        for (int j = 0; j < 8; ++j) { a[j] = *(const f32x4*)(mix + (size_t)m * DM + 4 * (lane + 64 * j)); v[j] = *(const f32x4*)(xin + (size_t)m * DM + 4 * (lane + 64 * j));
            s += (a[j].x * a[j].x + a[j].y * a[j].y) + (a[j].z * a[j].z + a[j].w * a[j].w); }
        const float rstd = 1.0f / sqrtf(wave_sum(s) * (1.0f / DM) + EPS);
#pragma unroll
        for (int j = 0; j < 8; ++j) { const f32x4 gv = *(const f32x4*)(g_post + 4 * (lane + 64 * j)); v[j] = v[j] + a[j] * rstd * gv;
            *(f32x4*)(xout + (size_t)m * DM + 4 * (lane + 64 * j)) = v[j]; }
        if (g_next) norm_row_bf16(v, g_next, XN + (size_t)m * DM, lane);
    }
}

constexpr int I_IN = 32 * 160, I_OUT = 32 * 64, I_G = 32 * 176, I_D = 88 * 64, I_PW = 8 * 16;
constexpr int I_LAYER = I_IN + I_OUT + 2 * I_G + I_D + I_PW;
constexpr int TAIL_ITEMS = 7168;
__device__ __forceinline__ void convert_item(const Params& p, unsigned char* ws, int l, int r, LAS float* scr, int lane) {
    bf16* WIN = (bf16*)(ws + WS_WIN); bf16* WOUT = (bf16*)(ws + WS_WOUT); bf16* WGU = (bf16*)(ws + WS_WGU); bf16* WDN = (bf16*)(ws + WS_WDN); bf16* WPW = (bf16*)(ws + WS_WPW);
    if (r < I_IN) { const int kb = r / 160, nb = r % 160, n0 = 32 * nb, tile = n0 >> 8, lc = n0 & 255; const bool rt = tile < 4 || (tile >= 10 && tile <= 12);
        transpose_item(p.w_in + (size_t)l * DM * NIN, DM, NIN, WIN + (size_t)l * NIN * DM, 64 * kb, n0, rt ? tile * 256 + 128 * ((lc >> 5) & 1) + 32 * (lc >> 6) : n0, scr, lane); return; } r -= I_IN;
    if (r < I_OUT) { const int kb = r / 64, nb = r % 64; transpose_item(p.w_out + (size_t)l * DM * DM, DM, DM, WOUT + (size_t)l * DM * DM, 64 * kb, 32 * nb, 32 * nb, scr, lane); return; } r -= I_OUT;
    if (r < I_G) { const int kb = r / 176, nb = r % 176, n0 = 32 * nb; transpose_item(p.ffn_gate + (size_t)l * DM * FF, DM, FF, WGU + (size_t)l * 2 * FF * DM, 64 * kb, n0, (n0 >> 7) * 256 + (n0 & 127), scr, lane); return; } r -= I_G;
    if (r < I_G) { const int kb = r / 176, nb = r % 176, n0 = 32 * nb; transpose_item(p.ffn_up + (size_t)l * DM * FF, DM, FF, WGU + (size_t)l * 2 * FF * DM, 64 * kb, n0, (n0 >> 7) * 256 + 128 + (n0 & 127), scr, lane); return; } r -= I_G;
    if (r < I_D) { const int kb = r / 64, nb = r % 64; transpose_item(p.ffn_down + (size_t)l * FF * DM, FF, DM, WDN + (size_t)l * DM * FF, 64 * kb, 32 * nb, 32 * nb, scr, lane); return; } r -= I_D;
    { const int kb = r / 16, nb = r % 16; transpose_item(p.conv_pw + (size_t)l * CC * CC, CC, CC, WPW + (size_t)l * CC * CC, 64 * kb, 32 * nb, 32 * nb, scr, lane); }
}
__device__ __forceinline__ void slot_item(int slot, int idx, int& l, int& r) {
    if (slot == 0) { l = 0; r = 5120 + idx; }
    else if (slot == 1) { if (idx < 5632) { l = 0; r = 18432 + idx; } else { l = 1; r = idx - 5632; } }
    else if (slot == 2) { l = 1; r = 7168 + idx; }
    else { l = 1; r = 18432 + idx; }
}
__device__ __forceinline__ void p0_item(int it, int& l, int& r) {
    if (it < 5120) { l = 0; r = it; return; } it -= 5120;
    if (it < 128) { l = 0; r = 24064 + it; return; } it -= 128;
    l = 1; r = 24064 + it;
}
constexpr int P0_ITEMS = 5376;
__device__ __forceinline__ void tail_convert(const Params& p, unsigned char* ws, int slot, PG8_LAS unsigned char* ldsl, int bx) {
    if (bx < 128) return;
    const int tid = opaque_tid(), lane = tid & 63, wave = __builtin_amdgcn_readfirstlane(tid >> 6);
    LAS float* scr = (LAS float*)(ldsl + wave * 16384);
    const int gwt = (bx - 128) * NWAVES + wave, count = slot == 0 ? 13312 : (slot == 1 ? 12800 : (slot == 2 ? 11264 : 5632));
    for (int it = gwt; it < count; it += 1024) { int l, r; slot_item(slot, it, l, r); convert_item(p, ws, l, r, scr, lane); }
}

__device__ __forceinline__ float wave_reduce32(const float (&v)[32], int lane) {
    float a[16], b[8], c[4], d[2], e;
    { const bool h = lane & 32;
#pragma unroll
      for (int t = 0; t < 16; ++t) { const float keep = h ? v[t + 16] : v[t], send = h ? v[t] : v[t + 16]; a[t] = keep + __shfl_xor(send, 32); } }
    { const bool h = lane & 16;
#pragma unroll
      for (int t = 0; t < 8; ++t) { const float keep = h ? a[t + 8] : a[t], send = h ? a[t] : a[t + 8]; b[t] = keep + __shfl_xor(send, 16); } }
    { const bool h = lane & 8;
#pragma unroll
      for (int t = 0; t < 4; ++t) { const float keep = h ? b[t + 4] : b[t], send = h ? b[t] : b[t + 4]; c[t] = keep + __shfl_xor(send, 8); } }
    { const bool h = lane & 4;
#pragma unroll
      for (int t = 0; t < 2; ++t) { const float keep = h ? c[t + 2] : c[t], send = h ? c[t] : c[t + 2]; d[t] = keep + __shfl_xor(send, 4); } }
    { const bool h = lane & 2; const float keep = h ? d[1] : d[0], send = h ? d[0] : d[1]; e = keep + __shfl_xor(send, 2); }
    e += __shfl_xor(e, 1);
    return e;
}
__device__ __forceinline__ void conv_tile(const Params& p, int l, int item, const bf16* PROJ, bf16* CV, LAS float* sl) {
    const int tid = opaque_tid(), lane = tid & 63, wave = __builtin_amdgcn_readfirstlane(tid >> 6), c = tid;
    const int m0 = item * 32, b = m0 / SEQ, s0 = m0 % SEQ;
    LAS float* part = sl; LAS float* stat = sl + 512;
    float u[62];
#pragma unroll
    for (int rr = 0; rr < 62; ++rr) { const int sq = s0 - 15 + rr; const bool ok = sq >= 0 && sq < SEQ; const bf16* pr = PROJ + (size_t)(b * SEQ + (ok ? sq : s0)) * NIN;
        const float a = bf2f(pr[PB_A + c]), g = bf2f(pr[PB_G + c]); u[rr] = ok ? a / (1.0f + __expf(-g)) : 0.f; }
    float w[31];
#pragma unroll
    for (int j = 0; j < 31; ++j) w[j] = p.conv_dw[(size_t)(l * 31 + j) * CC + c];
    const float bias = p.conv_dw_b[l * CC + c];
    float y[32], y2[32];
#pragma unroll
    for (int t = 0; t < 32; ++t) { float acc = bias;
#pragma unroll
        for (int j = 0; j < 31; ++j) acc = fmaf(u[t + j], w[j], acc);
        y[t] = acc; y2[t] = acc * acc; }
    const float r1 = wave_reduce32(y, lane), r2 = wave_reduce32(y2, lane);
    const int tl = 16 * ((lane >> 5) & 1) + 8 * ((lane >> 4) & 1) + 4 * ((lane >> 3) & 1) + 2 * ((lane >> 2) & 1) + ((lane >> 1) & 1);
    __syncthreads();
    if ((lane & 1) == 0) { part[(tl * 8 + wave) * 2] = r1; part[(tl * 8 + wave) * 2 + 1] = r2; }
    __syncthreads();
    if (tid < 32) { float S1 = 0.f, S2 = 0.f;
#pragma unroll
        for (int w8 = 0; w8 < 8; ++w8) { S1 += part[(tid * 8 + w8) * 2]; S2 += part[(tid * 8 + w8) * 2 + 1]; }
        const float mean = S1 * (1.0f / CC); float var = S2 * (1.0f / CC) - mean * mean; var = var < 0.f ? 0.f : var;
        stat[tid * 2] = mean; stat[tid * 2 + 1] = 1.0f / sqrtf(var + EPS); }
    __syncthreads();
    const float lg = p.conv_ln_g[l * CC + c], lb = p.conv_ln_b[l * CC + c];
#pragma unroll
    for (int t = 0; t < 32; ++t) { float v = (y[t] - stat[t * 2]) * stat[t * 2 + 1] * lg + lb; v = v / (1.0f + __expf(-v)); CV[(size_t)(m0 + t) * CC + c] = (bf16)f2bf(v); }
}
#ifndef QL64
#define QL64 false
#endif
#ifndef QL128
#define QL128 true
#endif
#ifndef SD64
#define SD64 2
#endif
#ifndef SD128
#define SD128 2
#endif
#ifndef SDNA
#define SDNA 1
#endif
#ifndef USE_CG_SYNC
#define USE_CG_SYNC 0
#endif
#define GSYNC() do { if (USE_CG_SYNC) grid.sync(); else xcd_barrier(xbar); } while (0)
#ifndef ROPE_PROBE
#define ROPE_PROBE 0
#endif
#ifndef REP_CONV
#define REP_CONV 1
#endif
#ifndef EXTRA_SYNC
#define EXTRA_SYNC 0
#endif
#ifndef REP_S3
#define REP_S3 1
#endif
#ifndef REP_GEMM
#define REP_GEMM 1
#endif
#ifndef REP_P0
#define REP_P0 1
#endif
#ifndef ON_DIFF
#define ON_DIFF 1
#endif
#ifndef ON_GQA
#define ON_GQA 1
#endif
#ifndef ON_NA
#define ON_NA 1
#endif
#ifndef ON_CONV
#define ON_CONV 1
#endif
#ifndef ON_ROPE
#define ON_ROPE 1
#endif
#ifndef ON_P0
#define ON_P0 1
#endif
#ifndef ON_GEMM
#define ON_GEMM 1
#endif
__device__ __forceinline__ void store_o_bf16(const att::f32x16 (&o)[4], bf16* base  , unsigned char* lds) {
    const int tid = opaque_tid(), lane = tid & 63, wave = __builtin_amdgcn_readfirstlane(tid >> 6), r32 = lane & 31, hi = lane >> 5;
    __syncthreads();
    float* T = (float*)(lds + wave * 16896);
#pragma unroll
    for (int r = 0; r < 16; ++r) { float* tp = T + att::crow(r, hi) * 132 + r32;
#pragma unroll
        for (int d = 0; d < 4; ++d) tp[32 * d] = o[d][r]; }
#pragma unroll
    for (int k = 0; k < 8; ++k) { const int chunk = k * 64 + lane, row = chunk >> 4, c8 = chunk & 15;
        const f32x4 a = *(const f32x4*)(T + row * 132 + c8 * 8), b = *(const f32x4*)(T + row * 132 + c8 * 8 + 4);
        v4u w; w.x = att::cvtpk(a.x, a.y); w.y = att::cvtpk(a.z, a.w); w.z = att::cvtpk(b.x, b.y); w.w = att::cvtpk(b.z, b.w);
        *(v4u*)(base + (size_t)(wave * 32 + row) * DM + c8 * 8) = w; }
}

__global__ void __launch_bounds__(NTHR) mega_fwd(Params p) {
    extern __shared__ __attribute__((aligned(16))) unsigned char lds[];
    cg::grid_group grid = cg::this_grid();
    const int G = gridDim.x, bx = blockIdx.x, ngw = G * NWAVES;
    unsigned char* ws = p.ws;
    bf16* WIN = (bf16*)(ws + WS_WIN); bf16* WOUT = (bf16*)(ws + WS_WOUT); bf16* WGU = (bf16*)(ws + WS_WGU); bf16* WDN = (bf16*)(ws + WS_WDN); bf16* WPW = (bf16*)(ws + WS_WPW);
    bf16* XN = (bf16*)(ws + WS_XN); bf16* PROJ = (bf16*)(ws + WS_PROJ); bf16* CAT = (bf16*)(ws + WS_CAT); bf16* HB = (bf16*)(ws + WS_H); bf16* CV = (bf16*)(ws + WS_CV);
    float* MIX = (float*)(ws + WS_MIX); unsigned long long* XSLOT = (unsigned long long*)(ws + WS_MIX + 48 * MiB); bf16* XB = (bf16*)(ws + WS_MIX + 16 * MiB);
    unsigned* CTL = (unsigned*)ws; f32x2* ROPE = (f32x2*)(ws + WS_ROPE);
    PG8_LAS unsigned char* ldsl = (PG8_LAS unsigned char*)lds;
    volatile LAS unsigned* bst = (volatile LAS unsigned*)(ldsl + LDS_BYTES - 16);
    if (threadIdx.x < 4) bst[threadIdx.x] = 0u;
    __syncthreads();
    const XcdBarrier xbar = xcd_barrier_post((unsigned*)ws, bst);

    for (int rp0 = 0; rp0 < REP_P0; ++rp0) {
        const int tid = opaque_tid(), lane = tid & 63, wave = __builtin_amdgcn_readfirstlane(tid >> 6), gw = bx * NWAVES + wave; (void)tid; (void)lane; (void)gw;
        LAS float* scr = (LAS float*)(ldsl + wave * 16384);
        for (int it = gw; it < ON_P0 * P0_ITEMS; it += ngw) { int cl, cr; p0_item(it, cl, cr); convert_item(p, ws, cl, cr, scr, lane); }
        for (int m = gw; m < M; m += ngw) { f32x4 v[8];
#pragma unroll
            for (int j = 0; j < 8; ++j) v[j] = *(const f32x4*)(p.x + (size_t)m * DM + 4 * (lane + 64 * j));
#pragma unroll
            for (int j = 0; j < 8; ++j) { v2u o; o.x = pk2(v[j].x, v[j].y); o.y = pk2(v[j].z, v[j].w); *(v2u*)(XB + (size_t)m * DM + 4 * (lane + 64 * j)) = o; }
            norm_row_bf16(v, p.norm_mix_pre, XN + (size_t)m * DM, lane); }
    }
    if (G != 256) grid.sync(); else GSYNC();
    for (int es = 0; es < EXTRA_SYNC; ++es) GSYNC();

    for (int l = 0; l < DEPTH; ++l) {
        _Pragma("unroll") for (int rg = 0; rg < REP_GEMM; ++rg) { pg8::Gemm g{XN, WIN + (size_t)l * NIN * DM, M, NIN, DM}; pg8::StaticOrder S; S.init(M, NIN, G, bx);
          pg8::EpiProj E{PROJ, NIN, (const float*)ROPE, p.gqa_q_norm + l * 128, p.gqa_k_norm + l * 128, (PG8_LAS float*)(ldsl + 131072)};
          pg8::gemm_phase<pg8::EpiProj, pg8::StaticOrder, true, true>(ldsl, g, S, E); }
        tail_convert(p, ws, l == 0 ? 0 : 2, ldsl, bx);
        GSYNC();

        for (int rep3 = 0; rep3 < REP_S3; ++rep3) {
            const int tid = opaque_tid(), lane = tid & 63, wave = __builtin_amdgcn_readfirstlane(tid >> 6), gw = bx * NWAVES + wave; (void)tid; (void)lane; (void)gw;
            const float lam_init = l == 0 ? 0.2f : 0.35550906759096934f;
            float lam; { const float* lp = p.diff_lambda + l * 256; const float sa = wave_sum(lp[lane] * lp[64 + lane]), sb = wave_sum(lp[128 + lane] * lp[192 + lane]); lam = expf(sa) - expf(sb) + lam_init; }
            constexpr float C64 = 0.125f * 1.4426950408889634f, THR64 = att::THR / 0.125f;
            constexpr float SC128 = 0.08838834764831845f, C128 = SC128 * 1.4426950408889634f, THR128 = att::THR / SC128;
            const int r32 = lane & 31, hi = lane >> 5;
            unsigned* ccnt = CTL + 32768 + l * 2048;
            if (ON_CONV && bx >= 128) {
                for (int ci = 0; ci < 2; ++ci) { const int item = 2 * (bx - 128) + ci;
                    conv_tile(p, l, item, PROJ, CV, (LAS float*)(ldsl + 131072));
                    asm volatile("s_waitcnt vmcnt(0)" ::: "memory"); __syncthreads();
                    if (tid == 0) { __builtin_amdgcn_fence(__ATOMIC_RELEASE, "agent"); asm volatile("s_waitcnt vmcnt(0)" ::: "memory"); __hip_atomic_fetch_add(ccnt + 64 * (item >> 3), 1u, __ATOMIC_RELAXED, __HIP_MEMORY_SCOPE_AGENT); } }
            }
            for (int round = 0;; ++round) {
                const int pc = (round & 1) ? (round + 1) * G - 1 - bx : round * G + bx;
                if (pc >= 384) break;
                const int kind = pc >> 7, xq = bx & 7, b = xq >> 2, h = xq & 3, qb = (bx & 127) >> 3;
                const size_t rowq = (size_t)b * SEQ + qb * 256, rowk = (size_t)b * SEQ;
                att::f32x16 o[4];
                __syncthreads();
                if (ON_DIFF && kind == 0) {
                    att::attn_body<64, false, QL64, SD64>(PROJ + rowq * NIN + PA_Q + h * 128, PROJ + rowk * NIN + PA_K + h * 128, PROJ + rowk * NIN + PA_V + h * 128, SEQ / 64, (char*)lds, C64, THR64, o, 0, 0, 0, 0.f);
                    { const int t2 = opaque_tid(); v4u* STv = (v4u*)((char*)lds + 69632) + t2;
#pragma unroll
                      for (int k = 0; k < 8; ++k) { const int d = k >> 1, r0 = 8 * (k & 1); v4u w;
                          w.x = att::cvtpk(o[d][r0], o[d][r0 + 1]); w.y = att::cvtpk(o[d][r0 + 2], o[d][r0 + 3]); w.z = att::cvtpk(o[d][r0 + 4], o[d][r0 + 5]); w.w = att::cvtpk(o[d][r0 + 6], o[d][r0 + 7]);
                          STv[k * 512] = w; } }
                    att::attn_body<64, false, QL64, SD64>(PROJ + rowq * NIN + PA_Q + h * 128 + 64, PROJ + rowk * NIN + PA_K + h * 128 + 64, PROJ + rowk * NIN + PA_V + h * 128, SEQ / 64, (char*)lds, C64, THR64, o, 0, 0, 0, 0.f);
                    { const int t3 = opaque_tid(), l3 = t3 & 63, r32 = l3 & 31; const v4u* STv = (const v4u*)((char*)lds + 69632) + t3;
                      const float* sg = p.diff_subln + l * 128;
                      float gsub[4], ss[16];
#pragma unroll
                      for (int d = 0; d < 4; ++d) gsub[d] = sg[32 * d + r32] * (1.0f - lam_init);
#pragma unroll
                      for (int r = 0; r < 16; ++r) ss[r] = 0.f;
#pragma unroll
                      for (int k = 0; k < 8; ++k) { const int d = k >> 1, r0 = 8 * (k & 1); const v4u w = STv[k * 512];
#pragma unroll
                          for (int i = 0; i < 4; ++i) { const unsigned wi = i == 0 ? w.x : (i == 1 ? w.y : (i == 2 ? w.z : w.w));
                              const float va = bf2f((unsigned short)(wi & 0xffffu)) - lam * o[d][r0 + 2 * i], vb = bf2f((unsigned short)(wi >> 16)) - lam * o[d][r0 + 2 * i + 1];
                              o[d][r0 + 2 * i] = va; o[d][r0 + 2 * i + 1] = vb; ss[r0 + 2 * i] += va * va; ss[r0 + 2 * i + 1] += vb * vb; } }
#pragma unroll
                      for (int r = 0; r < 16; ++r) { float q = ss[r]; q += __shfl_xor(q, 1); q += __shfl_xor(q, 2); q += __shfl_xor(q, 4); q += __shfl_xor(q, 8); q += __shfl_xor(q, 16);
                          const float rstd = 1.0f / sqrtf(q * (1.0f / 128.0f) + EPS);
#pragma unroll
                          for (int d = 0; d < 4; ++d) o[d][r] *= rstd * gsub[d]; } }
                    store_o_bf16(o, CAT + rowq * DM + h * 128, lds);
                } else if (ON_GQA && kind == 1) {
                    att::attn_body<128, false, QL128, SD128>(PROJ + rowq * NIN + PC_Q + h * 128, PROJ + rowk * NIN + PC_K + (h >> 1) * 128, PROJ + rowk * NIN + PC_V + (h >> 1) * 128, SEQ / 64, (char*)lds, C128, THR128, o, 0, 0, 0, 0.f);
                    store_o_bf16(o, CAT + rowq * DM + 1024 + h * 128, lds);
                } else if (ON_NA) {
                    { const float* rsrc = p.na_rpb + (size_t)(l * 4 + h) * 465; float* rdst = (float*)((char*)lds + att::RPB_OFF); for (int e = tid; e < 465; e += NTHR) rdst[e] = rsrc[e]; }
                    int krow0 = 4 * qb - 4; krow0 = krow0 < 0 ? 0 : (krow0 > 52 ? 52 : krow0);
                    const size_t rowkn = rowk + (size_t)krow0 * 64;
                    att::attn_body<128, true, QL128, SDNA>(PROJ + rowq * NIN + PD_Q + h * 128, PROJ + rowkn * NIN + PD_K + h * 128, PROJ + rowkn * NIN + PD_V + h * 128, 12, (char*)lds, C128, THR128, o,
                                              krow0, 4 * qb + (wave >> 1), (wave & 1) * 32 + r32, 11.313708498984761f);
                    store_o_bf16(o, CAT + rowq * DM + 1536 + h * 128, lds);
                }
            }
            __syncthreads();
            if (G - 1 - bx < 64) {
                if (tid == 0) { unsigned sp = 0; while (__hip_atomic_load(ccnt + 64 * ((G - 1 - bx) >> 1), __ATOMIC_RELAXED, __HIP_MEMORY_SCOPE_AGENT) < 8u) { __builtin_amdgcn_s_sleep(2); if (++sp > (1u << 24)) break; }
                    __builtin_amdgcn_fence(__ATOMIC_ACQUIRE, "agent"); asm volatile("s_waitcnt vmcnt(0)" ::: "memory"); }
                __syncthreads();
            }
            { pg8::Gemm g{CV, WPW + (size_t)l * CC * CC, M, CC, CC}; pg8::StrideOrder S{G - 1 - bx, G, 64, 2};
              pg8::EpiBf16<0> E{CAT + 512, DM, p.conv_pw_b + l * CC, 0, 0, 1.f};
              pg8::gemm_phase<pg8::EpiBf16<0>, pg8::StrideOrder, true, true>(ldsl, g, S, E); }
        }
        GSYNC();

        { pg8::Gemm g{CAT, WOUT + (size_t)l * DM * DM, M, DM, DM}; pg8::StaticOrder S; S.init(M, DM, G, bx);
          pg8::EpiRmsFused E{XB, nullptr, XB, XN, p.norm_mix_post + l * DM, p.norm_ffn_pre + l * DM, XSLOT + (size_t)(l * 2 + 0) * 131072, CTL + 16384 + (l * 2 + 0) * 2048};
          pg8::gemm_phase<pg8::EpiRmsFused, pg8::StaticOrder, false, true>(ldsl, g, S, E); }
        GSYNC();
        _Pragma("unroll") for (int rg = 0; rg < REP_GEMM; ++rg) { pg8::Gemm g{XN, WGU + (size_t)l * 2 * FF * DM, M, 2 * FF, DM}; pg8::StaticOrder S; S.init(M, 2 * FF, G, bx);
          pg8::EpiSwiGLU E{HB, FF};
          pg8::gemm_phase<pg8::EpiSwiGLU, pg8::StaticOrder, true, true>(ldsl, g, S, E); }
        tail_convert(p, ws, l == 0 ? 1 : 3, ldsl, bx);
        GSYNC();
        { pg8::Gemm g{HB, WDN + (size_t)l * DM * FF, M, DM, FF}; pg8::StaticOrder S; S.init(M, DM, G, bx);
          pg8::EpiRmsFused E{XB, l + 1 < DEPTH ? nullptr : p.out, XB, XN, p.norm_ffn_post + l * DM, l + 1 < DEPTH ? p.norm_mix_pre + (l + 1) * DM : nullptr, XSLOT + (size_t)(l * 2 + 1) * 131072, CTL + 16384 + (l * 2 + 1) * 2048};
          pg8::gemm_phase<pg8::EpiRmsFused, pg8::StaticOrder, false, true>(ldsl, g, S, E); }
        if (l + 1 < DEPTH) GSYNC();
    }
}

extern "C" void kernel_launch(void* const* d_in, const int* in_sizes, int n_in, void* d_out, int out_size, void* d_ws, size_t ws_size, hipStream_t stream) {
    static int grid = 0;
    if (grid == 0) {
        if (n_in != 21 || out_size != M * DM || ws_size < WS_END) { fprintf(stderr, "kernel_launch: unexpected shapes: n_in %d out %d ws %zu (need %zu)\n", n_in, out_size, ws_size, (size_t)WS_END); grid = -1; return; }
        int dev = 0, cus = 0, per_cu = 0;
        if (hipGetDevice(&dev) != hipSuccess || hipDeviceGetAttribute(&cus, hipDeviceAttributeMultiprocessorCount, dev) != hipSuccess) { fprintf(stderr, "kernel_launch: device query failed\n"); grid = -1; return; }
        if (hipFuncSetAttribute((const void*)mega_fwd, hipFuncAttributeMaxDynamicSharedMemorySize, LDS_BYTES) != hipSuccess) { fprintf(stderr, "kernel_launch: hipFuncSetAttribute failed\n"); grid = -1; return; }
        if (hipOccupancyMaxActiveBlocksPerMultiprocessor(&per_cu, (const void*)mega_fwd, NTHR, LDS_BYTES) != hipSuccess || per_cu < 1) { fprintf(stderr, "kernel_launch: occupancy query says %d\n", per_cu); (void)hipGetLastError(); per_cu = 1; }
        grid = cus * per_cu;
        if (grid < 256) { fprintf(stderr, "kernel_launch: needs 256 co-resident workgroups, device offers %d\n", grid); grid = -1; return; }
        grid = 256;
    }
    if (grid < 0) return;
    if (hipMemsetAsync(d_ws, 0, 196608, stream) != hipSuccess) { fprintf(stderr, "kernel_launch: memset failed\n"); return; }
    Params p{};
    const float** pp = (const float**)&p;
    for (int i = 0; i < 21; ++i) pp[i] = (const float*)d_in[i];
    p.out = (float*)d_out; p.ws = (unsigned char*)d_ws;
    void* args[] = {&p};
    hipError_t e = hipLaunchCooperativeKernel((const void*)mega_fwd, dim3(grid), dim3(NTHR), args, LDS_BYTES, stream);
    if (e != hipSuccess) fprintf(stderr, "cooperative launch failed: %s (grid %d)\n", hipGetErrorString(e), grid);
}
```

```cpp
#include <hip/hip_runtime.h>
#include <hip/hip_cooperative_groups.h>
#include <cstdio>
#include <cstdint>
namespace cg = cooperative_groups;
__device__ __forceinline__ int opaque_tid() { int t = threadIdx.x; asm volatile("" : "+v"(t)); return t; }
namespace pg8 {
#define PG8_LAS __attribute__((address_space(3)))
typedef unsigned short bf16_t;
typedef short bf16x8 __attribute__((ext_vector_type(8)));
typedef float f32x4 __attribute__((ext_vector_type(4)));
typedef unsigned u32x4 __attribute__((ext_vector_type(4)));
constexpr int BM = 256, BK = 64, HALF = 128, HTB = HALF * BK * 2  , STAGE_BYTES = 8 * HTB, NXCD = 8, WGM = 4;

__host__ __device__ __forceinline__ int lds_byte(int r, int c) { const int st = (r >> 4) * 2 + (c >> 5), rr = r & 15, cc = c & 31, ob = rr * 64 + cc * 2; return st * 1024 + (ob ^ (((ob >> 9) & 1) << 5)); }
__host__ __device__ __forceinline__ void stage_rc(int b, int& R, int& C) { const int st = b / 1024, sb = b % 1024, swz = sb ^ (((sb >> 9) & 1) << 5); R = (st >> 1) * 16 + swz / 64; C = (st & 1) * 32 + (swz % 64) / 2; }
__host__ __device__ __forceinline__ int perm32(int rho) { const int n = rho >> 4, i = rho & 15; return 8 * (i >> 2) + 4 * n + (i & 3); }

struct Unit { int pm, pn; };
struct Gemm { const bf16_t* A; const bf16_t* Bt; int M, N, K; };

struct StaticOrder {
    int nM, nN, nwg, G, c;
    __host__ __device__ void init(int M, int N, int G_, int c_) { nM = M / BM; nN = N / BM; nwg = nM * nN; G = G_; c = c_; }
    __host__ __device__ bool next(int i, Unit& u) const {
        const long L = (long)i * G + c; if (L >= nwg) return false;
        int wgid = (int)L; { const int q = nwg / NXCD, r = nwg % NXCD, xcd = wgid % NXCD, off = wgid / NXCD; wgid = (xcd < r ? xcd * (q + 1) : r * (q + 1) + (xcd - r) * q) + off; }
        const int nig = WGM * nN, gid = wgid / nig, fm = gid * WGM, gsz = (nM - fm) < WGM ? (nM - fm) : WGM;
        u.pm = fm + ((wgid % nig) % gsz); u.pn = (wgid % nig) / gsz; return true;
    }
    __device__ __forceinline__ void a_ready(const Unit&) const {}
    __device__ __forceinline__ void done(const Unit&) const {}
};

__device__ __forceinline__ unsigned cvt_pk_bf16(float lo, float hi) { unsigned r; asm volatile("v_cvt_pk_bf16_f32 %0, %1, %2" : "=v"(r) : "v"(lo), "v"(hi)); return r; }
typedef float f32x2 __attribute__((ext_vector_type(2)));
__device__ __forceinline__ f32x2 gelu_pk(f32x2 v) {
    const f32x2 av = __builtin_elementwise_abs(v), d = av * 0.2316418882f + 1.0f;
    f32x2 t; t.x = __builtin_amdgcn_rcpf(d.x); t.y = __builtin_amdgcn_rcpf(d.y);
    f32x2 q = t * 0.5307027145f + (-0.7265760135f); q = q * t + 0.7107068705f; q = q * t + (-0.142248368f); q = q * t + 0.127414796f; q = q * t;
    const f32x2 s = (v * v) * (-0.72134752044f);
    f32x2 e; e.x = __builtin_amdgcn_exp2f(s.x); e.y = __builtin_amdgcn_exp2f(s.y);
    const f32x2 m = v * (q * e), r = v - m;
    f32x2 o; o.x = v.x < 0.f ? m.x : r.x; o.y = v.y < 0.f ? m.y : r.y; return o;
}

template <int ACT  > struct EpiBf16 {
    static constexpr bool PERM = true, AFTER_DRAIN = false; static_assert(ACT == 0 || ACT == 1, "EpiBf16: ACT is 0 (none) or 1 (gelu_pk)");
    bf16_t* O; int ldc; const float* bias; int split_cols; size_t split_stride; float scale0;
    __device__ __forceinline__ void operator()(const f32x4 (&acc)[2][2][4][2], const Unit& u, int wr, int wc, int fr, int fq) const {
        const int row0 = u.pm * BM + wr * 64 + fr; int colt = u.pn * BM; bf16_t* base = O;
        float sc = 1.f; if (split_cols) { const int t = colt / split_cols; base += (size_t)t * split_stride; colt -= t * split_cols; if (t == 0) sc = scale0; }
        const int col0 = colt + wc * 32 + 8 * fq, bcol0 = u.pn * BM + wc * 32 + 8 * fq;
        f32x4 bv[2][2];
#pragma unroll
        for (int bj = 0; bj < 2; ++bj)
#pragma unroll
            for (int n = 0; n < 2; ++n) bv[bj][n] = bias ? *(const f32x4*)(bias + bcol0 + bj * HALF + 4 * n) : (f32x4){0.f, 0.f, 0.f, 0.f};
#pragma unroll
        for (int ai = 0; ai < 2; ++ai)
#pragma unroll
            for (int m = 0; m < 4; ++m) { bf16_t* rowp = base + (size_t)(row0 + ai * HALF + m * 16) * ldc + col0;
#pragma unroll
                for (int bj = 0; bj < 2; ++bj) { f32x4 v0 = acc[ai][bj][m][0] + bv[bj][0], v1 = acc[ai][bj][m][1] + bv[bj][1];
                    if (ACT == 1) { f32x2 a = gelu_pk((f32x2){v0[0], v0[1]}), b = gelu_pk((f32x2){v0[2], v0[3]}), c = gelu_pk((f32x2){v1[0], v1[1]}), d = gelu_pk((f32x2){v1[2], v1[3]});
                        v0 = (f32x4){a.x, a.y, b.x, b.y}; v1 = (f32x4){c.x, c.y, d.x, d.y}; }
                    v0 = v0 * sc; v1 = v1 * sc; u32x4 w; w.x = cvt_pk_bf16(v0[0], v0[1]); w.y = cvt_pk_bf16(v0[2], v0[3]); w.z = cvt_pk_bf16(v1[0], v1[1]); w.w = cvt_pk_bf16(v1[2], v1[3]);
                    *(u32x4*)(rowp + bj * HALF) = w; } }
    }
};
struct EpiF32 {
    static constexpr bool PERM = false, AFTER_DRAIN = false;
    float* O; int ldc;
    __device__ __forceinline__ void operator()(const f32x4 (&acc)[2][2][4][2], const Unit& u, int wr, int wc, int fr, int fq) const {
        const int row0 = u.pm * BM + wr * 64 + fr, col0 = u.pn * BM + wc * 32 + 4 * fq;
#pragma unroll
        for (int ai = 0; ai < 2; ++ai)
#pragma unroll
            for (int m = 0; m < 4; ++m) { float* rowp = O + (size_t)(row0 + ai * HALF + m * 16) * ldc + col0;
#pragma unroll
                for (int bj = 0; bj < 2; ++bj)
#pragma unroll
                    for (int n = 0; n < 2; ++n) *(f32x4*)(rowp + bj * HALF + n * 16) = acc[ai][bj][m][n]; }
    }
};
__device__ __forceinline__ float swiglu1(float g, float u) { return g * u * __builtin_amdgcn_rcpf(1.0f + __expf(-g)); }
struct EpiSwiGLU {
    static constexpr bool PERM = true, AFTER_DRAIN = false;
    bf16_t* O; int ldc;
    __device__ __forceinline__ void operator()(const f32x4 (&acc)[2][2][4][2], const Unit& u, int wr, int wc, int fr, int fq) const {
        const int row0 = u.pm * BM + wr * 64 + fr, col0 = u.pn * HALF + wc * 32 + 8 * fq;
#pragma unroll
        for (int ai = 0; ai < 2; ++ai)
#pragma unroll
            for (int m = 0; m < 4; ++m) { bf16_t* rowp = O + (size_t)(row0 + ai * HALF + m * 16) * ldc + col0;
                const f32x4 g0 = acc[ai][0][m][0], g1 = acc[ai][0][m][1], u0 = acc[ai][1][m][0], u1 = acc[ai][1][m][1];
                u32x4 w; w.x = cvt_pk_bf16(swiglu1(g0[0], u0[0]), swiglu1(g0[1], u0[1])); w.y = cvt_pk_bf16(swiglu1(g0[2], u0[2]), swiglu1(g0[3], u0[3]));
                w.z = cvt_pk_bf16(swiglu1(g1[0], u1[0]), swiglu1(g1[1], u1[1])); w.w = cvt_pk_bf16(swiglu1(g1[2], u1[2]), swiglu1(g1[3], u1[3]));
                *(u32x4*)rowp = w; }
    }
};

struct PanelSS {
    unsigned* xbuf;
    unsigned* cnt;
    float inv_n, eps;
    __device__ __forceinline__ void run(const f32x4 (&v)[2][2][4][2], const Unit& u, int wr, int wc, int fr, int fq, PG8_LAS unsigned char* lds, int wid, int lane) const {
        PG8_LAS float* P = (PG8_LAS float*)lds;
        PG8_LAS float* S = (PG8_LAS float*)(lds + 4096);
#pragma unroll
        for (int ai = 0; ai < 2; ++ai)
#pragma unroll
            for (int m = 0; m < 4; ++m) {
                float q = 0.f;
#pragma unroll
                for (int bj = 0; bj < 2; ++bj)
#pragma unroll
                    for (int n = 0; n < 2; ++n) { const f32x4 x = v[ai][bj][m][n]; q += (x[0] * x[0] + x[1] * x[1]) + (x[2] * x[2] + x[3] * x[3]); }
                q += __shfl_xor(q, 16); q += __shfl_xor(q, 32);
                if (fq == 0) P[(ai * HALF + wr * 64 + m * 16 + fr) * 4 + wc] = q;
            }
        asm volatile("s_waitcnt lgkmcnt(0)" ::: "memory"); __builtin_amdgcn_s_barrier(); asm volatile("" ::: "memory");
        const int row = wid * 32 + (lane & 31);
        unsigned* slot = xbuf + ((size_t)(u.pm * BM + row) * 8);
        if (lane < 32) { const float q = (P[row * 4 + 0] + P[row * 4 + 1]) + (P[row * 4 + 2] + P[row * 4 + 3]);
            __hip_atomic_store(slot + u.pn, __float_as_uint(q), __ATOMIC_RELAXED, __HIP_MEMORY_SCOPE_AGENT); }
        asm volatile("s_waitcnt vmcnt(0)" ::: "memory");
        if (lane == 0) __hip_atomic_fetch_add(cnt + 64 * u.pm, 1u, __ATOMIC_RELAXED, __HIP_MEMORY_SCOPE_AGENT);
        if (wid == 0) {
            unsigned sp = 0;
            while ((unsigned)__builtin_amdgcn_readfirstlane(__hip_atomic_load(cnt + 64 * u.pm, __ATOMIC_RELAXED, __HIP_MEMORY_SCOPE_AGENT)) < 64u) { __builtin_amdgcn_s_sleep(2); if (++sp > (1u << 22)) break; }
            __builtin_amdgcn_fence(__ATOMIC_ACQUIRE, "agent");
        }
        asm volatile("s_waitcnt vmcnt(0) lgkmcnt(0)" ::: "memory"); __builtin_amdgcn_s_barrier(); asm volatile("" ::: "memory");
        if (lane < 32) { float q = 0.f;
#pragma unroll
            for (int t = 0; t < 8; ++t) q += __uint_as_float(__hip_atomic_load(slot + t, __ATOMIC_RELAXED, __HIP_MEMORY_SCOPE_AGENT));
            S[row] = 1.0f / sqrtf(q * inv_n + eps); }
        asm volatile("s_waitcnt lgkmcnt(0)" ::: "memory"); __builtin_amdgcn_s_barrier(); asm volatile("" ::: "memory");
    }
};
struct EpiRmsResRms {
    static constexpr bool PERM = false, AFTER_DRAIN = true;
    const float* base; float* out; bf16_t* xn; int ldc; const float* g1; const float* g2; PanelSS st1, st2;
    __device__ __forceinline__ void operator()(const f32x4 (&)[2][2][4][2], const Unit&, int, int, int, int) const {}
    __device__ __forceinline__ void fused(f32x4 (&acc)[2][2][4][2], const Unit& u, int wr, int wc, int fr, int fq, PG8_LAS unsigned char* lds, int wid, int lane) const {
        typedef unsigned u32x2v __attribute__((ext_vector_type(2)));
        const PG8_LAS float* S = (const PG8_LAS float*)(lds + 4096);
        const int col0 = u.pn * BM + wc * 32 + 4 * fq;
        st1.run(acc, u, wr, wc, fr, fq, lds, wid, lane);
        {
            f32x4 gv[2][2];
#pragma unroll
            for (int bj = 0; bj < 2; ++bj)
#pragma unroll
                for (int n = 0; n < 2; ++n) gv[bj][n] = *(const f32x4*)(g1 + col0 + bj * HALF + n * 16);
#pragma unroll
            for (int ai = 0; ai < 2; ++ai)
#pragma unroll
                for (int m = 0; m < 4; ++m) { const int r = ai * HALF + wr * 64 + m * 16 + fr; const float sr = S[r]; const size_t off = (size_t)(u.pm * BM + r) * ldc + col0;
#pragma unroll
                    for (int bj = 0; bj < 2; ++bj)
#pragma unroll
                        for (int n = 0; n < 2; ++n) { const f32x4 bs = *(const f32x4*)(base + off + bj * HALF + n * 16); acc[ai][bj][m][n] = bs + acc[ai][bj][m][n] * sr * gv[bj][n]; }
                    asm volatile("" : "+v"(acc[ai][0][m][0]), "+v"(acc[ai][0][m][1]), "+v"(acc[ai][1][m][0]), "+v"(acc[ai][1][m][1]));
                    if (m & 1) asm volatile("" ::: "memory"); }
        }
        if (g2) {
            st2.run(acc, u, wr, wc, fr, fq, lds, wid, lane);
            f32x4 gv[2][2];
#pragma unroll
            for (int bj = 0; bj < 2; ++bj)
#pragma unroll
                for (int n = 0; n < 2; ++n) gv[bj][n] = *(const f32x4*)(g2 + col0 + bj * HALF + n * 16);
#pragma unroll
            for (int ai = 0; ai < 2; ++ai)
#pragma unroll
                for (int m = 0; m < 4; ++m) { const int r = ai * HALF + wr * 64 + m * 16 + fr; const float sr = S[r]; const size_t off = (size_t)(u.pm * BM + r) * ldc + col0;
#pragma unroll
                    for (int bj = 0; bj < 2; ++bj)
#pragma unroll
                        for (int n = 0; n < 2; ++n) { const f32x4 x1 = acc[ai][bj][m][n]; *(f32x4*)(out + off + bj * HALF + n * 16) = x1;
                            const f32x4 o = x1 * sr * gv[bj][n]; u32x2v w; w.x = cvt_pk_bf16(o[0], o[1]); w.y = cvt_pk_bf16(o[2], o[3]);
                            *(u32x2v*)(xn + off + bj * HALF + n * 16) = w; }
                    asm volatile("" ::: "memory"); }
        } else {
#pragma unroll
            for (int ai = 0; ai < 2; ++ai)
#pragma unroll
                for (int m = 0; m < 4; ++m) { const int r = ai * HALF + wr * 64 + m * 16 + fr; const size_t off = (size_t)(u.pm * BM + r) * ldc + col0;
#pragma unroll
                    for (int bj = 0; bj < 2; ++bj)
#pragma unroll
                        for (int n = 0; n < 2; ++n) *(f32x4*)(out + off + bj * HALF + n * 16) = acc[ai][bj][m][n]; }
        }
    }
};

__device__ __forceinline__ float bflo(unsigned w) { return __builtin_bit_cast(float, w << 16); }
__device__ __forceinline__ float bfhi(unsigned w) { return __builtin_bit_cast(float, w & 0xffff0000u); }
struct EpiRmsFused {
    static constexpr bool PERM = true, AFTER_DRAIN = true;
    const bf16_t* base_b;
    float* out_f; bf16_t* out_b;
    bf16_t* xn; const float* g1; const float* g2;
    unsigned long long* xbuf;
    unsigned* cnt;
    __device__ __forceinline__ void operator()(const f32x4 (&)[2][2][4][2], const Unit&, int, int, int, int) const {}
    __device__ __forceinline__ void fused(f32x4 (&acc)[2][2][4][2], const Unit& u, int wr, int wc, int fr, int fq, PG8_LAS unsigned char* lds, int wid, int lane) const {
        typedef unsigned u32x2v __attribute__((ext_vector_type(2)));
        constexpr int ldc = 2048; constexpr float inv_n = 1.0f / 2048.0f, eps = 1e-6f;
        PG8_LAS f32x4* P = (PG8_LAS f32x4*)(lds + 131072);
        PG8_LAS float* S = (PG8_LAS float*)(lds + 131072 + 16384);
        const int col0 = u.pn * BM + wc * 32 + 8 * fq;
        f32x4 gv[2][2];
#pragma unroll
        for (int bj = 0; bj < 2; ++bj)
#pragma unroll
            for (int n = 0; n < 2; ++n) gv[bj][n] = *(const f32x4*)(g1 + col0 + bj * HALF + n * 4);
        PG8_LAS u32x4* XL = (PG8_LAS u32x4*)lds + (wid * 64 + lane);
#pragma unroll
        for (int ai = 0; ai < 2; ++ai)
#pragma unroll
            for (int m = 0; m < 4; ++m) { const size_t off = (size_t)(u.pm * BM + ai * HALF + wr * 64 + m * 16 + fr) * ldc + col0;
#pragma unroll
                for (int bj = 0; bj < 2; ++bj) XL[((ai * 4 + m) * 2 + bj) * 512] = *(const u32x4*)(base_b + off + bj * HALF); }
#pragma unroll
        for (int ai = 0; ai < 2; ++ai)
#pragma unroll
            for (int m = 0; m < 4; ++m) {
                float saa = 0.f, sxx = 0.f, sxag = 0.f, sgg = 0.f;
#pragma unroll
                for (int bj = 0; bj < 2; ++bj) { const u32x4 w4 = XL[((ai * 4 + m) * 2 + bj) * 512];
#pragma unroll
                    for (int n = 0; n < 2; ++n) { const f32x4 a = acc[ai][bj][m][n]; const f32x4 ag = a * gv[bj][n]; const unsigned wx = n == 0 ? w4.x : w4.z, wy = n == 0 ? w4.y : w4.w;
                        const f32x4 x = (f32x4){bflo(wx), bfhi(wx), bflo(wy), bfhi(wy)};
                        saa += (a[0] * a[0] + a[1] * a[1]) + (a[2] * a[2] + a[3] * a[3]); sxx += (x[0] * x[0] + x[1] * x[1]) + (x[2] * x[2] + x[3] * x[3]);
                        sxag += (x[0] * ag[0] + x[1] * ag[1]) + (x[2] * ag[2] + x[3] * ag[3]); sgg += (ag[0] * ag[0] + ag[1] * ag[1]) + (ag[2] * ag[2] + ag[3] * ag[3]); } }
                asm volatile("" : "+v"(saa), "+v"(sxx), "+v"(sxag), "+v"(sgg));
                saa += __shfl_xor(saa, 16); sxx += __shfl_xor(sxx, 16); sxag += __shfl_xor(sxag, 16); sgg += __shfl_xor(sgg, 16);
                saa += __shfl_xor(saa, 32); sxx += __shfl_xor(sxx, 32); sxag += __shfl_xor(sxag, 32); sgg += __shfl_xor(sgg, 32);
                if (fq == 0) P[(ai * HALF + wr * 64 + m * 16 + fr) * 4 + wc] = (f32x4){saa, sxx, sxag, sgg};
                __builtin_amdgcn_sched_barrier(0);
            }
        asm volatile("s_waitcnt lgkmcnt(0)" ::: "memory"); __builtin_amdgcn_s_barrier(); asm volatile("" ::: "memory");
        const int row = wid * 32 + (lane & 31);
        unsigned long long* slot = xbuf + ((size_t)(u.pm * BM + row) * 8) * 2;
        if (lane < 32) { const f32x4 q = (P[row * 4 + 0] + P[row * 4 + 1]) + (P[row * 4 + 2] + P[row * 4 + 3]);
            __hip_atomic_store(slot + u.pn * 2, ((unsigned long long)__float_as_uint(q[1]) << 32) | __float_as_uint(q[0]), __ATOMIC_RELAXED, __HIP_MEMORY_SCOPE_AGENT);
            __hip_atomic_store(slot + u.pn * 2 + 1, ((unsigned long long)__float_as_uint(q[3]) << 32) | __float_as_uint(q[2]), __ATOMIC_RELAXED, __HIP_MEMORY_SCOPE_AGENT); }
        asm volatile("s_waitcnt vmcnt(0)" ::: "memory"); __builtin_amdgcn_s_barrier(); asm volatile("" ::: "memory");
        if (wid == 0) {
            if (lane == 0) __hip_atomic_fetch_add(cnt + 64 * u.pm, 1u, __ATOMIC_RELAXED, __HIP_MEMORY_SCOPE_AGENT);
            unsigned sp = 0;
            while ((unsigned)__builtin_amdgcn_readfirstlane(__hip_atomic_load(cnt + 64 * u.pm, __ATOMIC_RELAXED, __HIP_MEMORY_SCOPE_AGENT)) < 8u) { __builtin_amdgcn_s_sleep(1); if (++sp > (1u << 22)) break; }
            __builtin_amdgcn_fence(__ATOMIC_ACQUIRE, "agent");
        }
        asm volatile("s_waitcnt vmcnt(0) lgkmcnt(0)" ::: "memory"); __builtin_amdgcn_s_barrier(); asm volatile("" ::: "memory");
        if (lane < 32) { float saa = 0.f, sxx = 0.f, sxag = 0.f, sgg = 0.f;
#pragma unroll
            for (int t = 0; t < 8; ++t) { const unsigned long long w0 = __hip_atomic_load(slot + t * 2, __ATOMIC_RELAXED, __HIP_MEMORY_SCOPE_AGENT), w1 = __hip_atomic_load(slot + t * 2 + 1, __ATOMIC_RELAXED, __HIP_MEMORY_SCOPE_AGENT);
                saa += __uint_as_float((unsigned)w0); sxx += __uint_as_float((unsigned)(w0 >> 32)); sxag += __uint_as_float((unsigned)w1); sgg += __uint_as_float((unsigned)(w1 >> 32)); }
            const float r1 = 1.0f / sqrtf(saa * inv_n + eps);
            float s1 = sxx + 2.0f * r1 * sxag + r1 * r1 * sgg; s1 = s1 < 0.f ? 0.f : s1;
            S[row * 2] = r1; S[row * 2 + 1] = 1.0f / sqrtf(s1 * inv_n + eps); }
        asm volatile("s_waitcnt lgkmcnt(0)" ::: "memory"); __builtin_amdgcn_s_barrier(); asm volatile("" ::: "memory");
        int fr2 = fr, col2 = col0; asm volatile("" : "+v"(fr2), "+v"(col2));
        f32x4 g2v[2][2], g1v[2][2];
#pragma unroll
        for (int bj = 0; bj < 2; ++bj)
#pragma unroll
            for (int n = 0; n < 2; ++n) { g2v[bj][n] = g2 ? *(const f32x4*)(g2 + col2 + bj * HALF + n * 4) : (f32x4){0.f, 0.f, 0.f, 0.f}; g1v[bj][n] = *(const f32x4*)(g1 + col2 + bj * HALF + n * 4); }
#pragma unroll
        for (int ai = 0; ai < 2; ++ai)
#pragma unroll
            for (int m = 0; m < 4; ++m) { const int r = ai * HALF + wr * 64 + m * 16 + fr2; const float r1 = S[r * 2], r2 = S[r * 2 + 1]; const size_t off = (size_t)(u.pm * BM + r) * ldc + col2;
#pragma unroll
                for (int bj = 0; bj < 2; ++bj) { u32x4 w4 = XL[((ai * 4 + m) * 2 + bj) * 512]; asm volatile("" : "+v"(w4.x), "+v"(w4.y), "+v"(w4.z), "+v"(w4.w));
                    const f32x4 xa = (f32x4){bflo(w4.x), bfhi(w4.x), bflo(w4.y), bfhi(w4.y)}, xb = (f32x4){bflo(w4.z), bfhi(w4.z), bflo(w4.w), bfhi(w4.w)};
                    const f32x4 x1a = xa + acc[ai][bj][m][0] * r1 * g1v[bj][0], x1b = xb + acc[ai][bj][m][1] * r1 * g1v[bj][1];
                    if (out_f) { *(f32x4*)(out_f + off + bj * HALF) = x1a; *(f32x4*)(out_f + off + bj * HALF + 4) = x1b; }
                    else { u32x4 o; o.x = cvt_pk_bf16(x1a[0], x1a[1]); o.y = cvt_pk_bf16(x1a[2], x1a[3]); o.z = cvt_pk_bf16(x1b[0], x1b[1]); o.w = cvt_pk_bf16(x1b[2], x1b[3]); *(u32x4*)(out_b + off + bj * HALF) = o; }
                    if (g2) { const f32x4 ya = x1a * r2 * g2v[bj][0], yb = x1b * r2 * g2v[bj][1]; u32x4 o; o.x = cvt_pk_bf16(ya[0], ya[1]); o.y = cvt_pk_bf16(ya[2], ya[3]); o.z = cvt_pk_bf16(yb[0], yb[1]); o.w = cvt_pk_bf16(yb[2], yb[3]);
                        *(u32x4*)(xn + off + bj * HALF) = o; } }
                asm volatile("" ::: "memory"); __builtin_amdgcn_sched_barrier(0); }
    }
};

struct EpiProj {
    static constexpr bool PERM = true, AFTER_DRAIN = false;
    bf16_t* O; int ldc; const float* rope; const float* qn; const float* kn; PG8_LAS float* X;
    __device__ __forceinline__ void operator()(const f32x4 (&acc)[2][2][4][2], const Unit& u, int wr, int wc, int fr_, int fq_) const {
        int fr = fr_, fq = fq_; asm volatile("" : "+v"(fr), "+v"(fq));
        const int pn = u.pn, kind = pn < 4 ? 1 : ((pn >= 10 && pn <= 12) ? 2 : 0);
        if (kind == 0) {
            const int row0 = u.pm * BM + wr * 64 + fr, col0 = pn * BM + wc * 32 + 8 * fq;
#pragma unroll
            for (int ai = 0; ai < 2; ++ai)
#pragma unroll
                for (int m = 0; m < 4; ++m) { bf16_t* rowp = O + (size_t)(row0 + ai * HALF + m * 16) * ldc + col0;
#pragma unroll
                    for (int bj = 0; bj < 2; ++bj) { const f32x4 v0 = acc[ai][bj][m][0], v1 = acc[ai][bj][m][1];
                        u32x4 w; w.x = cvt_pk_bf16(v0[0], v0[1]); w.y = cvt_pk_bf16(v0[2], v0[3]); w.z = cvt_pk_bf16(v1[0], v1[1]); w.w = cvt_pk_bf16(v1[2], v1[3]);
                        *(u32x4*)(rowp + bj * HALF) = w; } }
            return;
        }
        const int i0 = 8 * fq, c1 = pn * BM + 64 * wc + i0;
        float frev[8];
#pragma unroll
        for (int k = 0; k < 8; ++k) { constexpr float FK[8] = {0.15915494309189535f, 0.11934937021124886f, 0.08949940160889104f, 0.06711508300522727f, 0.05032921210448705f, 0.037741584717419785f, 0.02830219583062341f, 0.02122365276477767f};
            frev[k] = FK[k] * (fq == 0 ? 1.0f : (fq == 1 ? 0.1f : (fq == 2 ? 0.01f : 0.001f))); }
        f32x4 ga[2], gb[2];
        if (kind == 2) { const float* gn = (pn == 12 ? kn : qn) + 64 * (wc & 1) + i0;
            ga[0] = *(const f32x4*)gn; ga[1] = *(const f32x4*)(gn + 4); gb[0] = *(const f32x4*)(gn + 32); gb[1] = *(const f32x4*)(gn + 36);
#pragma unroll
            for (int ai = 0; ai < 2; ++ai)
#pragma unroll
                for (int m = 0; m < 4; ++m) { float q = 0.f;
#pragma unroll
                    for (int bj = 0; bj < 2; ++bj)
#pragma unroll
                        for (int n = 0; n < 2; ++n) { const f32x4 x = acc[ai][bj][m][n]; q += (x[0] * x[0] + x[1] * x[1]) + (x[2] * x[2] + x[3] * x[3]); }
                    q += __shfl_xor(q, 16); q += __shfl_xor(q, 32);
                    if (fq == 0) X[(ai * HALF + wr * 64 + m * 16 + fr) * 4 + wc] = q; }
            asm volatile("s_waitcnt lgkmcnt(0)" ::: "memory"); __builtin_amdgcn_s_barrier(); asm volatile("" ::: "memory");
        } else { ga[0] = ga[1] = gb[0] = gb[1] = (f32x4){1.f, 1.f, 1.f, 1.f}; }
#pragma unroll
        for (int ai = 0; ai < 2; ++ai)
#pragma unroll
            for (int m = 0; m < 4; ++m) { const int r = ai * HALF + wr * 64 + m * 16 + fr, row = u.pm * BM + r, t = row & 4095;
                const int pos = kind == 1 ? t : ((wc & 1) ? (t & 63) : (t >> 6));
                const float fpos = (float)pos;
                float rs = 1.f;
                if (kind == 2) rs = 1.0f / sqrtf((X[r * 4 + wc] + X[r * 4 + (wc ^ 1)]) * (1.0f / 128.0f) + 1e-6f);
                u32x4 w1, w2;
#pragma unroll
                for (int n = 0; n < 2; ++n) {
                    f32x4 c, sn;
#pragma unroll
                    for (int j = 0; j < 4; ++j) { const float rev = __builtin_amdgcn_fractf(fpos * frev[4 * n + j]); c[j] = __builtin_amdgcn_cosf(rev); sn[j] = __builtin_amdgcn_sinf(rev); }
                    const f32x4 a = acc[ai][0][m][n] * rs * ga[n], b = acc[ai][1][m][n] * rs * gb[n];
                    const f32x4 o1 = a * c - b * sn, o2 = a * sn + b * c;
                    if (n == 0) { w1.x = cvt_pk_bf16(o1[0], o1[1]); w1.y = cvt_pk_bf16(o1[2], o1[3]); w2.x = cvt_pk_bf16(o2[0], o2[1]); w2.y = cvt_pk_bf16(o2[2], o2[3]); }
                    else { w1.z = cvt_pk_bf16(o1[0], o1[1]); w1.w = cvt_pk_bf16(o1[2], o1[3]); w2.z = cvt_pk_bf16(o2[0], o2[1]); w2.w = cvt_pk_bf16(o2[2], o2[3]); }
                }
                bf16_t* rowp = O + (size_t)row * ldc + c1;
                *(u32x4*)rowp = w1;
                *(u32x4*)(rowp + 32) = w2; __builtin_amdgcn_sched_barrier(0); }
    }
};
struct StrideOrder {
    int first, G, count, nN;
    __device__ bool next(int i, Unit& u) const { const int j = first + i * G; if (j >= count) return false; u.pm = j / nN; u.pn = j % nN; return true; }
    __device__ __forceinline__ void a_ready(const Unit&) const {}
    __device__ __forceinline__ void done(const Unit&) const {}
};
template <class Epi, class Sched, bool ALIGN_EPI = false, bool SP2 = false>
__device__ __forceinline__ void gemm_phase(PG8_LAS unsigned char* lds, const Gemm g, const Sched& S, const Epi& E) {
    const int tid = opaque_tid(), wid = __builtin_amdgcn_readfirstlane(tid >> 6), lane = tid & 63, wr = wid >> 2, wc = wid & 3, fr = lane & 15, fq = lane >> 4;
    const int K = g.K, nt = K / BK;
    unsigned voffA[2], voffB[2];
#pragma unroll
    for (int i = 0; i < 2; ++i) { int R, C; stage_rc(tid * 16 + i * 8192, R, C); const int Rb = Epi::PERM ? ((R & ~31) + perm32(R & 31)) : R;
        voffA[i] = (unsigned)(R * K + C) * 2u; voffB[i] = (unsigned)(Rb * K + C) * 2u; }
    const size_t kstep = (size_t)(BK * 2);
    const size_t hstep = (size_t)HALF * K * 2;
    const size_t tstep = 2 * hstep;
    const unsigned ldsw = (unsigned)wid * 1024u;
    const int aoff = lds_byte(wr * 64 + fr, fq * 8), boff = lds_byte(wc * 32 + fr, fq * 8);
#define PG8_SA(b, h) (((b) * 2 + (h)) * HTB)
#define PG8_SB(b, h) ((4 + (b) * 2 + (h)) * HTB)
#define PG8_STAGE(bufoff, gbase, voff) do { _Pragma("unroll") for (int _i = 0; _i < 2; ++_i) \
        __builtin_amdgcn_global_load_lds((const unsigned*)((const char*)(gbase) + (voff)[_i]), (PG8_LAS unsigned*)(lds + (bufoff) + ldsw + _i * 8192), 16, 0, 0); } while (0)
#define PG8_LDA(dst, b, h) do { _Pragma("unroll") for (int m = 0; m < 4; ++m) _Pragma("unroll") for (int k = 0; k < 2; ++k) dst[m][k] = *(const PG8_LAS bf16x8*)(lds + PG8_SA(b, h) + aoff + m * 2048 + k * 1024); } while (0)
#define PG8_LDB(dst, b, h) do { _Pragma("unroll") for (int n = 0; n < 2; ++n) _Pragma("unroll") for (int k = 0; k < 2; ++k) dst[n][k] = *(const PG8_LAS bf16x8*)(lds + PG8_SB(b, h) + boff + n * 2048 + k * 1024); } while (0)
#define PG8_MMA(ai, bj, At, Bt) do { __builtin_amdgcn_s_setprio(1); _Pragma("unroll") for (int m = 0; m < 4; ++m) _Pragma("unroll") for (int n = 0; n < 2; ++n) _Pragma("unroll") for (int k = 0; k < 2; ++k) \
        acc[ai][bj][m][n] = __builtin_amdgcn_mfma_f32_16x16x32_bf16(Bt[n][k], At[m][k], acc[ai][bj][m][n], 0, 0, 0); __builtin_amdgcn_s_setprio(0); } while (0)
#define PG8_WAIT_V(n) asm volatile("s_waitcnt vmcnt(" #n ")" ::: "memory")
#define PG8_WAIT_L(n) asm volatile("s_waitcnt lgkmcnt(" #n ")" ::: "memory")
#define PG8_BAR __builtin_amdgcn_s_barrier()
#define PG8_SCHED __builtin_amdgcn_sched_barrier(0)
    Unit cur, nxt; int ui = 0;
    if (!S.next(0, cur)) return;
    f32x4 acc[2][2][4][2];
#pragma unroll
    for (int a = 0; a < 2; ++a)
#pragma unroll
        for (int b = 0; b < 2; ++b)
#pragma unroll
            for (int m = 0; m < 4; ++m)
#pragma unroll
                for (int n = 0; n < 2; ++n) acc[a][b][m][n] = (f32x4){0.f, 0.f, 0.f, 0.f};
    bf16x8 At[4][2], B0[2][2], B1[2][2];
    const char* cA = (const char*)g.A + (size_t)cur.pm * tstep; const char* cB = (const char*)g.Bt + (size_t)cur.pn * tstep;
    S.a_ready(cur);
    if constexpr (SP2) {
        PG8_STAGE(PG8_SB(0, 0), cB, voffB); PG8_STAGE(PG8_SB(0, 1), cB + hstep, voffB); PG8_STAGE(PG8_SA(0, 0), cA, voffA); PG8_STAGE(PG8_SA(0, 1), cA + hstep, voffA);
        if (wr == 1) PG8_BAR;
        PG8_WAIT_V(2); PG8_BAR;
        PG8_STAGE(PG8_SB(1, 0), cB + kstep, voffB); PG8_STAGE(PG8_SA(1, 0), cA + kstep, voffA); PG8_STAGE(PG8_SB(1, 1), cB + hstep + kstep, voffB);
        PG8_WAIT_V(6); PG8_BAR;
    } else {
        PG8_STAGE(PG8_SB(0, 0), cB, voffB); PG8_STAGE(PG8_SA(0, 0), cA, voffA); PG8_STAGE(PG8_SB(0, 1), cB + hstep, voffB); PG8_STAGE(PG8_SA(0, 1), cA + hstep, voffA);
        if (wr == 1) PG8_BAR;
        PG8_WAIT_V(4); PG8_BAR;
        PG8_STAGE(PG8_SB(1, 0), cB + kstep, voffB); PG8_STAGE(PG8_SA(1, 0), cA + kstep, voffA); PG8_STAGE(PG8_SB(1, 1), cB + hstep + kstep, voffB);
        PG8_WAIT_V(6); PG8_BAR;
    }
    for (;;) {
        const bool has_next = S.next(ui + 1, nxt);
        const char* nA = has_next ? (const char*)g.A + (size_t)nxt.pm * tstep : cA; const char* nB = has_next ? (const char*)g.Bt + (size_t)nxt.pn * tstep : cB;
        for (int t = 0; t < nt; t += 2) {
            const bool last = (t == nt - 2);
            const char* a1 = cA + (size_t)(t + 1) * kstep;
            const char* a2 = last ? nA : cA + (size_t)(t + 2) * kstep; const char* b2 = last ? nB : cB + (size_t)(t + 2) * kstep;
            const char* a3 = a2 + kstep; const char* b3 = b2 + kstep;
            if (last && has_next) S.a_ready(nxt);
            if constexpr (SP2) {
            PG8_LDB(B0, 0, 0); PG8_LDB(B1, 0, 1); PG8_SCHED; PG8_LDA(At, 0, 0); PG8_STAGE(PG8_SA(1, 1), a1 + hstep, voffA);
            PG8_WAIT_V(8); PG8_WAIT_L(0); PG8_BAR; PG8_MMA(0, 0, At, B0); PG8_MMA(0, 1, At, B1); PG8_BAR; PG8_SCHED;
            PG8_LDA(At, 0, 1); PG8_STAGE(PG8_SB(0, 0), b2, voffB); PG8_STAGE(PG8_SB(0, 1), b2 + hstep, voffB); PG8_STAGE(PG8_SA(0, 0), a2, voffA);
            PG8_WAIT_V(8); PG8_WAIT_L(0); PG8_BAR; PG8_MMA(1, 0, At, B0); PG8_MMA(1, 1, At, B1); PG8_BAR; PG8_SCHED;
            PG8_LDB(B0, 1, 0); PG8_LDB(B1, 1, 1); PG8_SCHED; PG8_LDA(At, 1, 0); PG8_STAGE(PG8_SA(0, 1), a2 + hstep, voffA);
            PG8_WAIT_V(8); PG8_WAIT_L(0); PG8_BAR; PG8_MMA(0, 0, At, B0); PG8_MMA(0, 1, At, B1); PG8_BAR; PG8_SCHED;
            PG8_LDA(At, 1, 1); PG8_STAGE(PG8_SB(1, 0), b3, voffB); PG8_STAGE(PG8_SB(1, 1), b3 + hstep, voffB); PG8_STAGE(PG8_SA(1, 0), a3, voffA);
            PG8_WAIT_V(8); PG8_WAIT_L(0); PG8_BAR; PG8_MMA(1, 0, At, B0); PG8_MMA(1, 1, At, B1); PG8_BAR; PG8_SCHED;
            } else {
            PG8_LDB(B0, 0, 0); PG8_SCHED; PG8_LDA(At, 0, 0); PG8_STAGE(PG8_SA(1, 1), a1 + hstep, voffA);
            PG8_WAIT_L(8); PG8_BAR; PG8_WAIT_L(0); PG8_MMA(0, 0, At, B0); PG8_BAR; PG8_SCHED;
            PG8_LDB(B1, 0, 1); PG8_STAGE(PG8_SB(0, 0), b2, voffB);
            PG8_BAR; PG8_WAIT_L(0); PG8_MMA(0, 1, At, B1); PG8_BAR;
            PG8_LDA(At, 0, 1); PG8_STAGE(PG8_SA(0, 0), a2, voffA);
            PG8_BAR; PG8_WAIT_L(0); PG8_MMA(1, 0, At, B0); PG8_BAR; PG8_SCHED;
            PG8_STAGE(PG8_SB(0, 1), b2 + hstep, voffB);
            PG8_WAIT_V(6); PG8_BAR; PG8_MMA(1, 1, At, B1); PG8_BAR;
            PG8_LDB(B0, 1, 0); PG8_SCHED; PG8_LDA(At, 1, 0); PG8_STAGE(PG8_SA(0, 1), a2 + hstep, voffA);
            PG8_WAIT_L(8); PG8_BAR; PG8_WAIT_L(0); PG8_MMA(0, 0, At, B0); PG8_BAR; PG8_SCHED;
            PG8_LDB(B1, 1, 1); PG8_STAGE(PG8_SB(1, 0), b3, voffB);
            PG8_BAR; PG8_WAIT_L(0); PG8_MMA(0, 1, At, B1); PG8_BAR;
            PG8_LDA(At, 1, 1); PG8_STAGE(PG8_SA(1, 0), a3, voffA);
            PG8_BAR; PG8_WAIT_L(0); PG8_MMA(1, 0, At, B0); PG8_BAR; PG8_SCHED;
            PG8_STAGE(PG8_SB(1, 1), b3 + hstep, voffB);
            PG8_WAIT_V(6); PG8_BAR; PG8_MMA(1, 1, At, B1); PG8_BAR;
            }
        }
        if constexpr (ALIGN_EPI) { if (wr == 0) PG8_BAR; }
        if constexpr (!Epi::AFTER_DRAIN) { E(acc, cur, wr, wc, fr, fq); S.done(cur); }
        if (!has_next) break;
#pragma unroll
        for (int a = 0; a < 2; ++a)
#pragma unroll
            for (int b = 0; b < 2; ++b)
#pragma unroll
                for (int m = 0; m < 4; ++m)
#pragma unroll
                    for (int n = 0; n < 2; ++n) acc[a][b][m][n] = (f32x4){0.f, 0.f, 0.f, 0.f};
        cur = nxt; cA = nA; cB = nB; ++ui;
        if constexpr (ALIGN_EPI) { if (wr == 1) PG8_BAR; }
    }
    PG8_WAIT_V(0);
    if constexpr (!ALIGN_EPI) { if (wr == 0) PG8_BAR; }
    PG8_BAR;
    if constexpr (Epi::AFTER_DRAIN) { E.fused(acc, cur, wr, wc, fr, fq, lds, wid, lane); S.done(cur); }
#undef PG8_SA
#undef PG8_SB
#undef PG8_STAGE
#undef PG8_LDA
#undef PG8_LDB
#undef PG8_MMA
#undef PG8_WAIT_V
#undef PG8_WAIT_L
#undef PG8_BAR
#undef PG8_SCHED
}
}
namespace att {
using bf16 = unsigned short;
using bf16x8 = __attribute__((ext_vector_type(8))) short;
using s16x4  = __attribute__((ext_vector_type(4))) short;
using f32x16 = __attribute__((ext_vector_type(16))) float;
using u32x4  = __attribute__((ext_vector_type(4))) unsigned;
constexpr int KVBLK = 64, LDP = 5120;
constexpr float THR = 8.f;
constexpr int SHM_V = 16384, SHM_K = 16384, SHM_ATTN = 2 * SHM_V + 2 * SHM_K + 8 * 64 * 4;
constexpr int RPB_OFF = SHM_ATTN, Q_OFF = SHM_ATTN + 2048;
#define SBAR() __builtin_amdgcn_sched_barrier(0)
template <int DK> __device__ __forceinline__ int kswz(int row, int colB) { return DK == 128 ? row * 256 + (colB ^ ((row & 7) << 4)) : row * 128 + (colB ^ (((row >> 1) & 7) << 4)); }
__device__ __forceinline__ int crow(int r, int hi) { return (r & 3) + 8 * (r >> 2) + 4 * hi; }
__device__ __forceinline__ unsigned cvtpk(float lo, float hi) { unsigned r; asm volatile("v_cvt_pk_bf16_f32 %0, %1, %2" : "=v"(r) : "v"(lo), "v"(hi)); return r; }

__device__ __forceinline__ void partialSM(f32x16& p0, f32x16& p1, float& m_reg, float& mn, float& alpha, float C, float thrRaw) {
  float pmax = p0[0];
#pragma unroll
  for (int r = 1; r < 16; ++r) pmax = fmaxf(pmax, p0[r]);
#pragma unroll
  for (int r = 0; r < 16; ++r) pmax = fmaxf(pmax, p1[r]);
  { auto rr = __builtin_amdgcn_permlane32_swap(__float_as_uint(pmax), __float_as_uint(pmax), false, false);
    pmax = fmaxf(__uint_as_float(rr[0]), __uint_as_float(rr[1])); }
  if (__builtin_expect(__all(pmax - m_reg <= thrRaw), 1)) { mn = m_reg; alpha = 1.f; }
  else { mn = fmaxf(m_reg, pmax); alpha = __builtin_amdgcn_exp2f((m_reg - mn) * C); m_reg = mn; }
  float mnC = -mn * C;
#pragma unroll
  for (int r = 0; r < 16; ++r) p0[r] = fmaf(p0[r], C, mnC);
#pragma unroll
  for (int r = 0; r < 16; ++r) p1[r] = fmaf(p1[r], C, mnC);
#pragma unroll
  for (int r = 0; r < 16; ++r) p0[r] = __builtin_amdgcn_exp2f(p0[r]);
}
__device__ __forceinline__ void finishSM(f32x16& p0, f32x16& p1, float alpha, float& l_reg, bf16x8& pa0, bf16x8& pa1, bf16x8& pa2, bf16x8& pa3) {
#pragma unroll
  for (int r = 0; r < 16; ++r) p1[r] = __builtin_amdgcn_exp2f(p1[r]);
  float ps = 0;
#pragma unroll
  for (int r = 0; r < 16; ++r) ps += p0[r];
#pragma unroll
  for (int r = 0; r < 16; ++r) ps += p1[r];
  { auto rr = __builtin_amdgcn_permlane32_swap(__float_as_uint(ps), __float_as_uint(ps), false, false);
    ps = __uint_as_float(rr[0]) + __uint_as_float(rr[1]); }
  l_reg = l_reg * alpha + ps;
#define PK4(P, BASE, OUT) do { unsigned a0 = cvtpk(P[BASE + 0], P[BASE + 1]), a1 = cvtpk(P[BASE + 2], P[BASE + 3]);   \
    unsigned b0 = cvtpk(P[BASE + 4], P[BASE + 5]), b1 = cvtpk(P[BASE + 6], P[BASE + 7]);                              \
    auto r0 = __builtin_amdgcn_permlane32_swap(a0, b0, false, false); auto r1 = __builtin_amdgcn_permlane32_swap(a1, b1, false, false); \
    u32x4 w = {r0[0], r1[0], r0[1], r1[1]}; OUT = *reinterpret_cast<bf16x8*>(&w); } while (0)
  PK4(p0, 0, pa0); PK4(p0, 8, pa1); PK4(p1, 0, pa2); PK4(p1, 8, pa3);
#undef PK4
}
template <int DK, bool QL>
__device__ __forceinline__ void qkt(f32x16& p0, f32x16& p1, const bf16* Ks, const bf16x8* qr, const char* ql, int r32, int hi) {
  p0 = f32x16{}; p1 = f32x16{};
#pragma unroll
  for (int d0 = 0; d0 < DK / 16; ++d0) { int cb = (d0 * 16 + hi * 8) * 2;
    const bf16x8 qv = QL ? *reinterpret_cast<const bf16x8*>(ql + d0 * 1024) : qr[d0];
    bf16x8 b0 = *reinterpret_cast<const bf16x8*>((const char*)Ks + kswz<DK>(r32, cb));
    bf16x8 b1 = *reinterpret_cast<const bf16x8*>((const char*)Ks + kswz<DK>(32 + r32, cb));
    p0 = __builtin_amdgcn_mfma_f32_32x32x16_bf16(b0, qv, p0, 0, 0, 0);
    p1 = __builtin_amdgcn_mfma_f32_32x32x16_bf16(b1, qv, p1, 0, 0, 0); }
}
__device__ __forceinline__ void na_hook(f32x16& p0, f32x16& p1, int kr, int q_row, int q_col, int win_r, int win_c, const float* rpb, float inv_scale, int hi) {
  const bool rowok = (kr >= win_r) && (kr < win_r + 8);
  int ir = kr - q_row + 7; ir = ir < 0 ? 0 : (ir > 14 ? 14 : ir);
  const float* rp = rpb + ir * 31;
#pragma unroll
  for (int r = 0; r < 16; ++r) {
    const int kc = crow(r, hi);
    { const bool ok = rowok && kc >= win_c && kc < win_c + 16; int ic = kc - q_col + 15; ic = ic < 0 ? 0 : (ic > 30 ? 30 : ic);
      p0[r] = ok ? fmaf(rp[ic], inv_scale, p0[r]) : -1e30f; }
    { const int kc2 = kc + 32; const bool ok = rowok && kc2 >= win_c && kc2 < win_c + 16; int ic = kc2 - q_col + 15; ic = ic < 0 ? 0 : (ic > 30 ? 30 : ic);
      p1[r] = ok ? fmaf(rp[ic], inv_scale, p1[r]) : -1e30f; }
  }
}
__device__ __forceinline__ int v_st(int k, int c) { const int kk = (k & ~0xC) | ((k & 4) << 1) | ((k & 8) >> 1); return ((kk >> 3) * 4 + (c >> 5)) * 512 + ((kk & 7) * 32 + (c & 31)) * 2; }
__device__ __forceinline__ int v_rd_base(int lane) { return ((lane & 3) << 3) | (((lane >> 2) & 3) << 6) | (((lane >> 4) & 1) << 5) | (((lane >> 5) & 1) << 8); }
constexpr int v_rd_off(int d0, int ks, int half) { return d0 * 512 + ks * 4096 + half * 2048; }
template <int OFF> __device__ __forceinline__ s16x4 tr_read(int vb) {
  s16x4 r; asm volatile("ds_read_b64_tr_b16 %0, %1 offset:%2" : "=&v"(r) : "v"(vb), "i"(OFF) : "memory"); return r;
}
template <int D0> __device__ __forceinline__ void pv_one(f32x16& od, int vb, bf16x8 pa0, bf16x8 pa1, bf16x8 pa2, bf16x8 pa3) {
  const s16x4 l0 = tr_read<v_rd_off(D0, 0, 0)>(vb), h0 = tr_read<v_rd_off(D0, 0, 1)>(vb), l1 = tr_read<v_rd_off(D0, 1, 0)>(vb), h1 = tr_read<v_rd_off(D0, 1, 1)>(vb);
  const s16x4 l2 = tr_read<v_rd_off(D0, 2, 0)>(vb), h2 = tr_read<v_rd_off(D0, 2, 1)>(vb), l3 = tr_read<v_rd_off(D0, 3, 0)>(vb), h3 = tr_read<v_rd_off(D0, 3, 1)>(vb);
  asm volatile("s_waitcnt lgkmcnt(0)" ::: "memory"); SBAR();
#define PK(L, H) (bf16x8){L[0], L[1], L[2], L[3], H[0], H[1], H[2], H[3]}
  od = __builtin_amdgcn_mfma_f32_32x32x16_bf16(pa0, PK(l0, h0), od, 0, 0, 0);
  od = __builtin_amdgcn_mfma_f32_32x32x16_bf16(pa1, PK(l1, h1), od, 0, 0, 0);
  od = __builtin_amdgcn_mfma_f32_32x32x16_bf16(pa2, PK(l2, h2), od, 0, 0, 0);
  od = __builtin_amdgcn_mfma_f32_32x32x16_bf16(pa3, PK(l3, h3), od, 0, 0, 0);
#undef PK
}
__device__ __forceinline__ void pv_d0(f32x16* o, int vb, bf16x8 pa0, bf16x8 pa1, bf16x8 pa2, bf16x8 pa3) {
  pv_one<0>(o[0], vb, pa0, pa1, pa2, pa3); pv_one<1>(o[1], vb, pa0, pa1, pa2, pa3); pv_one<2>(o[2], vb, pa0, pa1, pa2, pa3); pv_one<3>(o[3], vb, pa0, pa1, pa2, pa3);
}
template <int DK, bool NA, bool QL, int SD>
__device__ __forceinline__ void attn_body(const bf16* __restrict__ Qb, const bf16* __restrict__ Kh, const bf16* __restrict__ Vh, int NT, char* lds,
                                          float C, float thrRaw, f32x16 (&o)[4], int krow0, int q_row, int q_col, float inv_scale) {
  const int tid = opaque_tid(), wid = tid >> 6, lane = tid & 63, r32 = lane & 31, hi = lane >> 5;
  bf16* V_lds = (bf16*)lds; bf16* K_lds = (bf16*)(lds + 2 * SHM_V);
  float* ws = (float*)(lds + 2 * SHM_V + 2 * SHM_K) + wid * 64; float* li_l = ws; float* al_l = ws + 32;
  const float* rpb = (const float*)(lds + RPB_OFF);
  int win_r = q_row - 4; win_r = win_r < 0 ? 0 : (win_r > 56 ? 56 : win_r);
  int win_c = q_col - 8; win_c = win_c < 0 ? 0 : (win_c > 48 ? 48 : win_c);
  float m_reg = -1e30f, l_reg = 0; bf16x8 qr[QL ? 1 : DK / 16];
  char* ql = lds + Q_OFF + (wid * (DK / 16) * 64 + lane) * 16;
#pragma unroll
  for (int d = 0; d < 4; ++d) o[d] = f32x16{};
  const bf16* Qw = Qb + (long)(wid * 32 + r32) * LDP + hi * 8;
#pragma unroll
  for (int d0 = 0; d0 < DK / 16; ++d0) { const bf16x8 qv = *reinterpret_cast<const bf16x8*>(Qw + d0 * 16); if (QL) *reinterpret_cast<bf16x8*>(ql + d0 * 1024) = qv; else qr[d0] = qv; }
  const int sr = tid >> 4, sc = (tid & 15) * 8, vst0 = v_st(sr, sc), vst1 = v_st(32 + sr, sc);
  const int ksr = DK == 128 ? sr : (tid >> 3), ksc = DK == 128 ? sc : (tid & 7) * 8;
  const int vb0 = (int)(uintptr_t)V_lds + v_rd_base(lane);
  struct { bf16x8 vs0, vs1, ks0, ks1; } sr_[SD];
#define SLOAD(i, k0) do { sr_[i].vs0 = *reinterpret_cast<const bf16x8*>(&Vh[(long)((k0) + sr) * LDP + sc]); sr_[i].vs1 = *reinterpret_cast<const bf16x8*>(&Vh[(long)((k0) + 32 + sr) * LDP + sc]); \
    sr_[i].ks0 = *reinterpret_cast<const bf16x8*>(&Kh[(long)((k0) + ksr) * LDP + ksc]); if (DK == 128) sr_[i].ks1 = *reinterpret_cast<const bf16x8*>(&Kh[(long)((k0) + 32 + ksr) * LDP + ksc]); } while (0)
#define SWRITE(b, i) do { *(bf16x8*)((char*)V_lds + (b) * SHM_V + vst0) = sr_[i].vs0;          \
    *(bf16x8*)((char*)V_lds + (b) * SHM_V + vst1) = sr_[i].vs1; int kc = ksc * 2;               \
    *(bf16x8*)((char*)K_lds + (b) * SHM_K + kswz<DK>(ksr, kc)) = sr_[i].ks0;                       \
    if (DK == 128) *(bf16x8*)((char*)K_lds + (b) * SHM_K + kswz<DK>(32 + ksr, kc)) = sr_[i].ks1; } while (0)
#define SWAIT() do { if (SD == 1) asm volatile("s_waitcnt vmcnt(0)" ::: "memory"); else if (DK == 128) asm volatile("s_waitcnt vmcnt(4)" ::: "memory"); else asm volatile("s_waitcnt vmcnt(3)" ::: "memory"); } while (0)
#define RESC(a) do { if (__any((a) < 1.f)) { if (hi == 0) al_l[r32] = (a); asm volatile("s_waitcnt lgkmcnt(0)" ::: "memory"); \
    _Pragma("unroll") for (int d = 0; d < 4; ++d) _Pragma("unroll") for (int r = 0; r < 16; ++r) o[d][r] *= al_l[crow(r, hi)]; } } while (0)
#define HOOK(P0, P1, j) do { if (NA) na_hook(P0, P1, krow0 + (j), q_row, q_col, win_r, win_c, rpb, inv_scale, hi); } while (0)
  f32x16 pA0, pA1, pB0, pB1; float mnA, mnB, alA, alB; bf16x8 pa0, pa1, pa2, pa3;
  constexpr int SE = 0, SO = SD - 1;
  SLOAD(SE, 0); asm volatile("s_waitcnt vmcnt(0)" ::: "memory"); SWRITE(0, SE); __syncthreads();
  qkt<DK, QL>(pA0, pA1, K_lds, qr, ql, r32, hi); HOOK(pA0, pA1, 0); partialSM(pA0, pA1, m_reg, mnA, alA, C, thrRaw);
  SLOAD(SO, KVBLK); if (SD == 2) { if (2 < NT) SLOAD(SE, 2 * KVBLK); }
  SWAIT(); SWRITE(1, SO); __syncthreads();
  for (int j = 1; j + 1 < NT; j += 2) {
    SBAR(); qkt<DK, QL>(pB0, pB1, (bf16*)((char*)K_lds + SHM_K), qr, ql, r32, hi); HOOK(pB0, pB1, j);
    finishSM(pA0, pA1, alA, l_reg, pa0, pa1, pa2, pa3); SBAR();
    SLOAD(SO, (j + SD) * KVBLK); SBAR();
    pv_d0(o, vb0, pa0, pa1, pa2, pa3); partialSM(pB0, pB1, m_reg, mnB, alB, C, thrRaw);
    __syncthreads(); SWAIT(); SWRITE(0, SE);
    RESC(alB); __syncthreads();
    SBAR(); qkt<DK, QL>(pA0, pA1, K_lds, qr, ql, r32, hi); HOOK(pA0, pA1, j + 1);
    finishSM(pB0, pB1, alB, l_reg, pa0, pa1, pa2, pa3); SBAR();
    if (SD == 1 || j + 3 < NT) SLOAD(SE, (j + 1 + SD) * KVBLK); SBAR();
    pv_d0(o, vb0 + (int)SHM_V, pa0, pa1, pa2, pa3); partialSM(pA0, pA1, m_reg, mnA, alA, C, thrRaw);
    __syncthreads(); SWAIT(); SWRITE(1, SO);
    RESC(alA); __syncthreads();
  }
  SBAR(); qkt<DK, QL>(pB0, pB1, (bf16*)((char*)K_lds + SHM_K), qr, ql, r32, hi); HOOK(pB0, pB1, NT - 1);
  finishSM(pA0, pA1, alA, l_reg, pa0, pa1, pa2, pa3); SBAR();
  pv_d0(o, vb0, pa0, pa1, pa2, pa3); partialSM(pB0, pB1, m_reg, mnB, alB, C, thrRaw);
  __syncthreads(); RESC(alB);
  finishSM(pB0, pB1, alB, l_reg, pa0, pa1, pa2, pa3); SBAR();
  pv_d0(o, vb0 + (int)SHM_V, pa0, pa1, pa2, pa3);
  if (hi == 0) li_l[r32] = l_reg; asm volatile("s_waitcnt vmcnt(0) lgkmcnt(0)" ::: "memory");
#pragma unroll
  for (int r = 0; r < 16; ++r) { const float rl = __builtin_amdgcn_rcpf(li_l[crow(r, hi)]);
#pragma unroll
    for (int d = 0; d < 4; ++d) o[d][r] *= rl; }
#undef SLOAD
#undef SWRITE
#undef SWAIT
#undef RESC
#undef HOOK
}
#undef SBAR
}
#define GAS __attribute__((address_space(1)))
#define LAS __attribute__((address_space(3)))
typedef unsigned short bf16;
typedef unsigned v4u __attribute__((ext_vector_type(4)));
typedef unsigned v2u __attribute__((ext_vector_type(2)));
typedef float f32x4 __attribute__((ext_vector_type(4)));
typedef float f32x2 __attribute__((ext_vector_type(2)));
constexpr int NWAVES = 8, NTHR = 512;
constexpr int SEQ = 4096, M = 8192, DM = 2048, NIN = 5120, FF = 5632, DEPTH = 2, CC = 512;
constexpr float EPS = 1e-6f;
constexpr int PA_Q = 0, PA_K = 512, PA_V = 1024, PB_A = 1536, PB_G = 2048, PC_Q = 2560, PC_K = 3072, PC_V = 3328, PD_Q = 3584, PD_K = 4096, PD_V = 4608;
constexpr size_t MiB = 1u << 20;
constexpr size_t WS_ROPE = 1 * MiB;
constexpr size_t WS_WIN = 2 * MiB;
constexpr size_t WS_WOUT = WS_WIN + 40 * MiB;
constexpr size_t WS_WGU = WS_WOUT + 16 * MiB;
constexpr size_t WS_WDN = WS_WGU + 88 * MiB;
constexpr size_t WS_WPW = WS_WDN + 44 * MiB;
constexpr size_t WS_XN = WS_WPW + 1 * MiB;
constexpr size_t WS_PROJ = WS_XN + 32 * MiB;
constexpr size_t WS_CAT = WS_PROJ + 80 * MiB;
constexpr size_t WS_H = WS_PROJ;
constexpr size_t WS_MIX = WS_CAT + 32 * MiB;
constexpr size_t WS_CV = WS_MIX + 64 * MiB;
constexpr size_t WS_END = WS_CV + 8 * MiB;
constexpr int LDS_BYTES = 163840;

__device__ __forceinline__ unsigned f2bf(float f) { unsigned u = __builtin_bit_cast(unsigned, f); return (u + 0x7fffu + ((u >> 16) & 1u)) >> 16; }
__device__ __forceinline__ unsigned pk2(float lo, float hi) { return f2bf(lo) | (f2bf(hi) << 16); }
__device__ __forceinline__ float bf2f(unsigned short b) { return __builtin_bit_cast(float, (unsigned)b << 16); }
__device__ __forceinline__ float wave_sum(float v) {
#pragma unroll
    for (int o = 1; o < 64; o <<= 1) v += __shfl_xor(v, o);
    return v;
}
#define LDS_WAIT() asm volatile("s_waitcnt lgkmcnt(0)" ::: "memory")

#define XB_TMO      128
#define XB_XCNT(j)  (256  + 64 * (j))
#define XB_XSUB(j)  (1280 + 64 * (j))
#define XB_XGEN(j)  (2304 + 64 * (j))
#define XB_TOP      3328
#define XB_TOPGEN   3392
#define XCD_BAR_WORDS 3456
#define XB_SPIN_CAP (1u << 18)

__device__ __forceinline__ unsigned xb_ld(unsigned* p)              { return __hip_atomic_load(p, __ATOMIC_RELAXED, __HIP_MEMORY_SCOPE_AGENT); }
__device__ __forceinline__ unsigned xb_add(unsigned* p, unsigned v) { return __hip_atomic_fetch_add(p, v, __ATOMIC_RELAXED, __HIP_MEMORY_SCOPE_AGENT); }
__device__ __forceinline__ unsigned xb_xcc_id() { return (unsigned)__builtin_amdgcn_s_getreg((3 << 11) | 20) & 0xFu; }
#define XB_SPIN(cond, bar) do { unsigned _sp = 0; while (cond) { __builtin_amdgcn_s_sleep(1); \
    if ((++_sp & 255u) == 0u) { if (xb_ld(&(bar)[XB_TMO])) break; if (_sp > XB_SPIN_CAP) { atomicAdd(&(bar)[XB_TMO], 1u); break; } } } } while (0)

struct XcdBarrier {
    unsigned* bar; unsigned x;
    volatile LAS unsigned* st;
};

__device__ __forceinline__ XcdBarrier xcd_barrier_post(unsigned* bar, volatile LAS unsigned* st) {
    XcdBarrier b; b.bar = bar; b.x = xb_xcc_id(); b.st = st;
    if (threadIdx.x == 0) (void)xb_add(&bar[XB_XCNT(b.x)], 1u);
    return b;
}
__device__ __forceinline__ void xcd_barrier_complete(unsigned* bar, unsigned x, unsigned& nloc, unsigned& nx) {
    const unsigned G = gridDim.x * gridDim.y * gridDim.z;
    unsigned sum, cnt, mine, sp = 0u;
    for (;;) {
        sum = 0u; cnt = 0u; mine = 0u;
#pragma unroll
        for (unsigned j = 0; j < 16; ++j) { const unsigned c = xb_ld(&bar[XB_XCNT(j)]); sum += c; cnt += (c > 0u) ? 1u : 0u; mine = (j == x) ? c : mine; }
        if (sum == G) break;
        __builtin_amdgcn_s_sleep(1);
        if ((++sp & 255u) == 0u) { if (xb_ld(&bar[XB_TMO])) break; if (sp > XB_SPIN_CAP) { atomicAdd(&bar[XB_TMO], 1u); break; } }
    }
    nloc = mine > 0u ? mine : 1u; nx = cnt > 0u ? cnt : 1u;
}

__device__ __forceinline__ void xcd_barrier(const XcdBarrier& b) {
    asm volatile("s_waitcnt vmcnt(0)" ::: "memory");
    __syncthreads();
    if (threadIdx.x == 0) {
        unsigned* bar = b.bar;
        __builtin_amdgcn_s_waitcnt(0);
        unsigned nloc = b.st[0], nx = b.st[1];
        if (nloc == 0u) { xcd_barrier_complete(bar, b.x, nloc, nx); b.st[0] = nloc; b.st[1] = nx; }
        const unsigned old = xb_add(&bar[XB_XSUB(b.x)], 1u);
        const unsigned gen = old / nloc;
        if (old + 1u == (gen + 1u) * nloc) {
            __builtin_amdgcn_fence(__ATOMIC_RELEASE, "agent");
            asm volatile("s_waitcnt vmcnt(0)" ::: "memory");
            const unsigned og = xb_add(&bar[XB_TOP], 1u);
            const unsigned tg = og / nx;
            if (og + 1u == (tg + 1u) * nx) xb_add(&bar[XB_TOPGEN], 1u);
            else XB_SPIN(xb_ld(&bar[XB_TOPGEN]) == tg, bar);
            __builtin_amdgcn_fence(__ATOMIC_ACQUIRE, "agent");
            xb_add(&bar[XB_XGEN(b.x)], 1u);
            asm volatile("s_waitcnt vmcnt(0)" ::: "memory");
        } else {
            XB_SPIN(xb_ld(&bar[XB_XGEN(b.x)]) == gen, bar);
            __builtin_amdgcn_fence(__ATOMIC_ACQUIRE, "agent");
            asm volatile("s_waitcnt vmcnt(0)" ::: "memory");
        }
    }
    __syncthreads();
}

struct Params {
    const float* x; const float* norm_mix_pre; const float* norm_mix_post; const float* norm_ffn_pre; const float* norm_ffn_post;
    const float* w_in; const float* w_out; const float* diff_lambda; const float* diff_subln; const float* conv_dw; const float* conv_dw_b;
    const float* conv_ln_g; const float* conv_ln_b; const float* conv_pw; const float* conv_pw_b; const float* gqa_q_norm; const float* gqa_k_norm;
    const float* na_rpb; const float* ffn_gate; const float* ffn_up; const float* ffn_down;
    float* out; unsigned char* ws;
};

__device__ __forceinline__ void transpose_item(const float* __restrict__ W, int K, int N, bf16* WT, int k0, int n0, int dst_row0, LAS float* scr, int lane) {
    const int r = lane >> 3, q = lane & 7;
    f32x4 v[8];
#pragma unroll
    for (int i = 0; i < 8; ++i) v[i] = __builtin_nontemporal_load((const f32x4*)(W + (size_t)(k0 + 8 * i + r) * N + n0 + 4 * q));
#pragma unroll
    for (int i = 0; i < 8; ++i) { LAS float* d = scr + (8 * i + r) * 33 + 4 * q; d[0] = v[i].x; d[1] = v[i].y; d[2] = v[i].z; d[3] = v[i].w; }
    LDS_WAIT(); asm volatile("" ::: "memory");
    const int c = lane & 7;
#pragma unroll
    for (int j = 0; j < 4; ++j) { const int n = (lane >> 3) + 8 * j; const LAS float* s = scr + (8 * c) * 33 + n;
        v4u o; o.x = pk2(s[0 * 33], s[1 * 33]); o.y = pk2(s[2 * 33], s[3 * 33]); o.z = pk2(s[4 * 33], s[5 * 33]); o.w = pk2(s[6 * 33], s[7 * 33]);
        __builtin_nontemporal_store(o, (v4u*)(WT + (size_t)(dst_row0 + n) * K + k0 + 8 * c)); }
    LDS_WAIT(); asm volatile("" ::: "memory");
}
__device__ __forceinline__ void norm_row_bf16(const f32x4* v, const float* __restrict__ g, bf16* orow, int lane) {
    float s = 0.f;
#pragma unroll
    for (int j = 0; j < 8; ++j) s += (v[j].x * v[j].x + v[j].y * v[j].y) + (v[j].z * v[j].z + v[j].w * v[j].w);
    const float rstd = 1.0f / sqrtf(wave_sum(s) * (1.0f / DM) + EPS);
#pragma unroll
    for (int j = 0; j < 8; ++j) { const f32x4 gv = *(const f32x4*)(g + 4 * (lane + 64 * j));
        v2u o; o.x = pk2(v[j].x * rstd * gv.x, v[j].y * rstd * gv.y); o.y = pk2(v[j].z * rstd * gv.z, v[j].w * rstd * gv.w);
        *(v2u*)(orow + 4 * (lane + 64 * j)) = o; }
}
__device__ __forceinline__ void rows_update(const float* xin, const float* mix, const float* __restrict__ g_post, float* xout, const float* __restrict__ g_next, bf16* XN, int gw, int ngw, int lane) {
    for (int m = gw; m < M; m += ngw) {
        f32x4 a[8], v[8]; float s = 0.f;
#pragma unroll
        for (int j = 0; j < 8; ++j) { a[j] = *(const f32x4*)(mix + (size_t)m * DM + 4 * (lane + 64 * j)); v[j] = *(const f32x4*)(xin + (size_t)m * DM + 4 * (lane + 64 * j));
            s += (a[j].x * a[j].x + a[j].y * a[j].y) + (a[j].z * a[j].z + a[j].w * a[j].w); }
        const float rstd = 1.0f / sqrtf(wave_sum(s) * (1.0f / DM) + EPS);
#pragma unroll
        for (int j = 0; j < 8; ++j) { const f32x4 gv = *(const f32x4*)(g_post + 4 * (lane + 64 * j)); v[j] = v[j] + a[j] * rstd * gv;
            *(f32x4*)(xout + (size_t)m * DM + 4 * (lane + 64 * j)) = v[j]; }
        if (g_next) norm_row_bf16(v, g_next, XN + (size_t)m * DM, lane);
    }
}

constexpr int I_IN = 32 * 160, I_OUT = 32 * 64, I_G = 32 * 176, I_D = 88 * 64, I_PW = 8 * 16;
constexpr int I_LAYER = I_IN + I_OUT + 2 * I_G + I_D + I_PW;
constexpr int TAIL_ITEMS = 7168;
__device__ __forceinline__ void convert_item(const Params& p, unsigned char* ws, int l, int r, LAS float* scr, int lane) {
    bf16* WIN = (bf16*)(ws + WS_WIN); bf16* WOUT = (bf16*)(ws + WS_WOUT); bf16* WGU = (bf16*)(ws + WS_WGU); bf16* WDN = (bf16*)(ws + WS_WDN); bf16* WPW = (bf16*)(ws + WS_WPW);
    if (r < I_IN) { const int kb = r / 160, nb = r % 160, n0 = 32 * nb, tile = n0 >> 8, lc = n0 & 255; const bool rt = tile < 4 || (tile >= 10 && tile <= 12);
        transpose_item(p.w_in + (size_t)l * DM * NIN, DM, NIN, WIN + (size_t)l * NIN * DM, 64 * kb, n0, rt ? tile * 256 + 128 * ((lc >> 5) & 1) + 32 * (lc >> 6) : n0, scr, lane); return; } r -= I_IN;
    if (r < I_OUT) { const int kb = r / 64, nb = r % 64; transpose_item(p.w_out + (size_t)l * DM * DM, DM, DM, WOUT + (size_t)l * DM * DM, 64 * kb, 32 * nb, 32 * nb, scr, lane); return; } r -= I_OUT;
    if (r < I_G) { const int kb = r / 176, nb = r % 176, n0 = 32 * nb; transpose_item(p.ffn_gate + (size_t)l * DM * FF, DM, FF, WGU + (size_t)l * 2 * FF * DM, 64 * kb, n0, (n0 >> 7) * 256 + (n0 & 127), scr, lane); return; } r -= I_G;
    if (r < I_G) { const int kb = r / 176, nb = r % 176, n0 = 32 * nb; transpose_item(p.ffn_up + (size_t)l * DM * FF, DM, FF, WGU + (size_t)l * 2 * FF * DM, 64 * kb, n0, (n0 >> 7) * 256 + 128 + (n0 & 127), scr, lane); return; } r -= I_G;
    if (r < I_D) { const int kb = r / 64, nb = r % 64; transpose_item(p.ffn_down + (size_t)l * FF * DM, FF, DM, WDN + (size_t)l * DM * FF, 64 * kb, 32 * nb, 32 * nb, scr, lane); return; } r -= I_D;
    { const int kb = r / 16, nb = r % 16; transpose_item(p.conv_pw + (size_t)l * CC * CC, CC, CC, WPW + (size_t)l * CC * CC, 64 * kb, 32 * nb, 32 * nb, scr, lane); }
}
__device__ __forceinline__ void slot_item(int slot, int idx, int& l, int& r) {
    if (slot == 0) { l = 0; r = 5120 + idx; }
    else if (slot == 1) { if (idx < 5632) { l = 0; r = 18432 + idx; } else { l = 1; r = idx - 5632; } }
    else if (slot == 2) { l = 1; r = 7168 + idx; }
    else { l = 1; r = 18432 + idx; }
}
__device__ __forceinline__ void p0_item(int it, int& l, int& r) {
    if (it < 5120) { l = 0; r = it; return; } it -= 5120;
    if (it < 128) { l = 0; r = 24064 + it; return; } it -= 128;
    l = 1; r = 24064 + it;
}
constexpr int P0_ITEMS = 5376;
__device__ __forceinline__ void tail_convert(const Params& p, unsigned char* ws, int slot, PG8_LAS unsigned char* ldsl, int bx) {
    if (bx < 128) return;
    const int tid = opaque_tid(), lane = tid & 63, wave = __builtin_amdgcn_readfirstlane(tid >> 6);
    LAS float* scr = (LAS float*)(ldsl + wave * 16384);
    const int gwt = (bx - 128) * NWAVES + wave, count = slot == 0 ? 13312 : (slot == 1 ? 12800 : (slot == 2 ? 11264 : 5632));
    for (int it = gwt; it < count; it += 1024) { int l, r; slot_item(slot, it, l, r); convert_item(p, ws, l, r, scr, lane); }
}

__device__ __forceinline__ float wave_reduce32(const float (&v)[32], int lane) {
    float a[16], b[8], c[4], d[2], e;
    { const bool h = lane & 32;
#pragma unroll
      for (int t = 0; t < 16; ++t) { const float keep = h ? v[t + 16] : v[t], send = h ? v[t] : v[t + 16]; a[t] = keep + __shfl_xor(send, 32); } }
    { const bool h = lane & 16;
#pragma unroll
      for (int t = 0; t < 8; ++t) { const float keep = h ? a[t + 8] : a[t], send = h ? a[t] : a[t + 8]; b[t] = keep + __shfl_xor(send, 16); } }
    { const bool h = lane & 8;
#pragma unroll
      for (int t = 0; t < 4; ++t) { const float keep = h ? b[t + 4] : b[t], send = h ? b[t] : b[t + 4]; c[t] = keep + __shfl_xor(send, 8); } }
    { const bool h = lane & 4;
#pragma unroll
      for (int t = 0; t < 2; ++t) { const float keep = h ? c[t + 2] : c[t], send = h ? c[t] : c[t + 2]; d[t] = keep + __shfl_xor(send, 4); } }
    { const bool h = lane & 2; const float keep = h ? d[1] : d[0], send = h ? d[0] : d[1]; e = keep + __shfl_xor(send, 2); }
    e += __shfl_xor(e, 1);
    return e;
}
__device__ __forceinline__ void conv_tile(const Params& p, int l, int item, const bf16* PROJ, bf16* CV, LAS float* sl) {
    const int tid = opaque_tid(), lane = tid & 63, wave = __builtin_amdgcn_readfirstlane(tid >> 6), c = tid;
    const int m0 = item * 32, b = m0 / SEQ, s0 = m0 % SEQ;
    LAS float* part = sl; LAS float* stat = sl + 512;
    float u[62];
#pragma unroll
    for (int rr = 0; rr < 62; ++rr) { const int sq = s0 - 15 + rr; const bool ok = sq >= 0 && sq < SEQ; const bf16* pr = PROJ + (size_t)(b * SEQ + (ok ? sq : s0)) * NIN;
        const float a = bf2f(pr[PB_A + c]), g = bf2f(pr[PB_G + c]); u[rr] = ok ? a / (1.0f + __expf(-g)) : 0.f; }
    float w[31];
#pragma unroll
    for (int j = 0; j < 31; ++j) w[j] = p.conv_dw[(size_t)(l * 31 + j) * CC + c];
    const float bias = p.conv_dw_b[l * CC + c];
    float y[32], y2[32];
#pragma unroll
    for (int t = 0; t < 32; ++t) { float acc = bias;
#pragma unroll
        for (int j = 0; j < 31; ++j) acc = fmaf(u[t + j], w[j], acc);
        y[t] = acc; y2[t] = acc * acc; }
    const float r1 = wave_reduce32(y, lane), r2 = wave_reduce32(y2, lane);
    const int tl = 16 * ((lane >> 5) & 1) + 8 * ((lane >> 4) & 1) + 4 * ((lane >> 3) & 1) + 2 * ((lane >> 2) & 1) + ((lane >> 1) & 1);
    __syncthreads();
    if ((lane & 1) == 0) { part[(tl * 8 + wave) * 2] = r1; part[(tl * 8 + wave) * 2 + 1] = r2; }
    __syncthreads();
    if (tid < 32) { float S1 = 0.f, S2 = 0.f;
#pragma unroll
        for (int w8 = 0; w8 < 8; ++w8) { S1 += part[(tid * 8 + w8) * 2]; S2 += part[(tid * 8 + w8) * 2 + 1]; }
        const float mean = S1 * (1.0f / CC); float var = S2 * (1.0f / CC) - mean * mean; var = var < 0.f ? 0.f : var;
        stat[tid * 2] = mean; stat[tid * 2 + 1] = 1.0f / sqrtf(var + EPS); }
    __syncthreads();
    const float lg = p.conv_ln_g[l * CC + c], lb = p.conv_ln_b[l * CC + c];
#pragma unroll
    for (int t = 0; t < 32; ++t) { float v = (y[t] - stat[t * 2]) * stat[t * 2 + 1] * lg + lb; v = v / (1.0f + __expf(-v)); CV[(size_t)(m0 + t) * CC + c] = (bf16)f2bf(v); }
}
#ifndef QL64
#define QL64 false
#endif
#ifndef QL128
#define QL128 true
#endif
#ifndef SD64
#define SD64 2
#endif
#ifndef SD128
#define SD128 2
#endif
#ifndef SDNA
#define SDNA 1
#endif
#ifndef USE_CG_SYNC
#define USE_CG_SYNC 0
#endif
#define GSYNC() do { if (USE_CG_SYNC) grid.sync(); else xcd_barrier(xbar); } while (0)
#ifndef ROPE_PROBE
#define ROPE_PROBE 0
#endif
#ifndef REP_CONV
#define REP_CONV 1
#endif
#ifndef EXTRA_SYNC
#define EXTRA_SYNC 0
#endif
#ifndef REP_S3
#define REP_S3 1
#endif
#ifndef REP_GEMM
#define REP_GEMM 1
#endif
#ifndef REP_P0
#define REP_P0 1
#endif
#ifndef ON_DIFF
#define ON_DIFF 1
#endif
#ifndef ON_GQA
#define ON_GQA 1
#endif
#ifndef ON_NA
#define ON_NA 1
#endif
#ifndef ON_CONV
#define ON_CONV 1
#endif
#ifndef ON_ROPE
#define ON_ROPE 1
#endif
#ifndef ON_P0
#define ON_P0 1
#endif
#ifndef ON_GEMM
#define ON_GEMM 1
#endif
__device__ __forceinline__ void store_o_bf16(const att::f32x16 (&o)[4], bf16* base  , unsigned char* lds) {
    const int tid = opaque_tid(), lane = tid & 63, wave = __builtin_amdgcn_readfirstlane(tid >> 6), r32 = lane & 31, hi = lane >> 5;
    __syncthreads();
    float* T = (float*)(lds + wave * 16896);
#pragma unroll
    for (int r = 0; r < 16; ++r) { float* tp = T + att::crow(r, hi) * 132 + r32;
#pragma unroll
        for (int d = 0; d < 4; ++d) tp[32 * d] = o[d][r]; }
#pragma unroll
    for (int k = 0; k < 8; ++k) { const int chunk = k * 64 + lane, row = chunk >> 4, c8 = chunk & 15;
        const f32x4 a = *(const f32x4*)(T + row * 132 + c8 * 8), b = *(const f32x4*)(T + row * 132 + c8 * 8 + 4);
        v4u w; w.x = att::cvtpk(a.x, a.y); w.y = att::cvtpk(a.z, a.w); w.z = att::cvtpk(b.x, b.y); w.w = att::cvtpk(b.z, b.w);
        *(v4u*)(base + (size_t)(wave * 32 + row) * DM + c8 * 8) = w; }
}

__global__ void __launch_bounds__(NTHR) mega_fwd(Params p) {
    extern __shared__ __attribute__((aligned(16))) unsigned char lds[];
    cg::grid_group grid = cg::this_grid();
    const int G = gridDim.x, bx = blockIdx.x, ngw = G * NWAVES;
    unsigned char* ws = p.ws;
    bf16* WIN = (bf16*)(ws + WS_WIN); bf16* WOUT = (bf16*)(ws + WS_WOUT); bf16* WGU = (bf16*)(ws + WS_WGU); bf16* WDN = (bf16*)(ws + WS_WDN); bf16* WPW = (bf16*)(ws + WS_WPW);
    bf16* XN = (bf16*)(ws + WS_XN); bf16* PROJ = (bf16*)(ws + WS_PROJ); bf16* CAT = (bf16*)(ws + WS_CAT); bf16* HB = (bf16*)(ws + WS_H); bf16* CV = (bf16*)(ws + WS_CV);
    float* MIX = (float*)(ws + WS_MIX); unsigned long long* XSLOT = (unsigned long long*)(ws + WS_MIX + 48 * MiB); bf16* XB = (bf16*)(ws + WS_MIX + 16 * MiB);
    unsigned* CTL = (unsigned*)ws; f32x2* ROPE = (f32x2*)(ws + WS_ROPE);
    PG8_LAS unsigned char* ldsl = (PG8_LAS unsigned char*)lds;
    volatile LAS unsigned* bst = (volatile LAS unsigned*)(ldsl + LDS_BYTES - 16);
    if (threadIdx.x < 4) bst[threadIdx.x] = 0u;
    __syncthreads();
    const XcdBarrier xbar = xcd_barrier_post((unsigned*)ws, bst);

    for (int rp0 = 0; rp0 < REP_P0; ++rp0) {
        const int tid = opaque_tid(), lane = tid & 63, wave = __builtin_amdgcn_readfirstlane(tid >> 6), gw = bx * NWAVES + wave; (void)tid; (void)lane; (void)gw;
        LAS float* scr = (LAS float*)(ldsl + wave * 16384);
        for (int it = gw; it < ON_P0 * P0_ITEMS; it += ngw) { int cl, cr; p0_item(it, cl, cr); convert_item(p, ws, cl, cr, scr, lane); }
        for (int m = gw; m < M; m += ngw) { f32x4 v[8];
#pragma unroll
            for (int j = 0; j < 8; ++j) v[j] = *(const f32x4*)(p.x + (size_t)m * DM + 4 * (lane + 64 * j));
#pragma unroll
            for (int j = 0; j < 8; ++j) { v2u o; o.x = pk2(v[j].x, v[j].y); o.y = pk2(v[j].z, v[j].w); *(v2u*)(XB + (size_t)m * DM + 4 * (lane + 64 * j)) = o; }
            norm_row_bf16(v, p.norm_mix_pre, XN + (size_t)m * DM, lane); }
    }
    if (G != 256) grid.sync(); else GSYNC();
    for (int es = 0; es < EXTRA_SYNC; ++es) GSYNC();

    for (int l = 0; l < DEPTH; ++l) {
        _Pragma("unroll") for (int rg = 0; rg < REP_GEMM; ++rg) { pg8::Gemm g{XN, WIN + (size_t)l * NIN * DM, M, NIN, DM}; pg8::StaticOrder S; S.init(M, NIN, G, bx);
          pg8::EpiProj E{PROJ, NIN, (const float*)ROPE, p.gqa_q_norm + l * 128, p.gqa_k_norm + l * 128, (PG8_LAS float*)(ldsl + 131072)};
          pg8::gemm_phase<pg8::EpiProj, pg8::StaticOrder, true, true>(ldsl, g, S, E); }
        tail_convert(p, ws, l == 0 ? 0 : 2, ldsl, bx);
        GSYNC();

        for (int rep3 = 0; rep3 < REP_S3; ++rep3) {
            const int tid = opaque_tid(), lane = tid & 63, wave = __builtin_amdgcn_readfirstlane(tid >> 6), gw = bx * NWAVES + wave; (void)tid; (void)lane; (void)gw;
            const float lam_init = l == 0 ? 0.2f : 0.35550906759096934f;
            float lam; { const float* lp = p.diff_lambda + l * 256; const float sa = wave_sum(lp[lane] * lp[64 + lane]), sb = wave_sum(lp[128 + lane] * lp[192 + lane]); lam = expf(sa) - expf(sb) + lam_init; }
            constexpr float C64 = 0.125f * 1.4426950408889634f, THR64 = att::THR / 0.125f;
            constexpr float SC128 = 0.08838834764831845f, C128 = SC128 * 1.4426950408889634f, THR128 = att::THR / SC128;
            const int r32 = lane & 31, hi = lane >> 5;
            unsigned* ccnt = CTL + 32768 + l * 2048;
            if (ON_CONV && bx >= 128) {
                for (int ci = 0; ci < 2; ++ci) { const int item = 2 * (bx - 128) + ci;
                    conv_tile(p, l, item, PROJ, CV, (LAS float*)(ldsl + 131072));
                    asm volatile("s_waitcnt vmcnt(0)" ::: "memory"); __syncthreads();
                    if (tid == 0) { __builtin_amdgcn_fence(__ATOMIC_RELEASE, "agent"); asm volatile("s_waitcnt vmcnt(0)" ::: "memory"); __hip_atomic_fetch_add(ccnt + 64 * (item >> 3), 1u, __ATOMIC_RELAXED, __HIP_MEMORY_SCOPE_AGENT); } }
            }
            for (int round = 0;; ++round) {
                const int pc = (round & 1) ? (round + 1) * G - 1 - bx : round * G + bx;
                if (pc >= 384) break;
                const int kind = pc >> 7, xq = bx & 7, b = xq >> 2, h = xq & 3, qb = (bx & 127) >> 3;
                const size_t rowq = (size_t)b * SEQ + qb * 256, rowk = (size_t)b * SEQ;
                att::f32x16 o[4];
                __syncthreads();
                if (ON_DIFF && kind == 0) {
                    att::attn_body<64, false, QL64, SD64>(PROJ + rowq * NIN + PA_Q + h * 128, PROJ + rowk * NIN + PA_K + h * 128, PROJ + rowk * NIN + PA_V + h * 128, SEQ / 64, (char*)lds, C64, THR64, o, 0, 0, 0, 0.f);
                    { const int t2 = opaque_tid(); v4u* STv = (v4u*)((char*)lds + 69632) + t2;
#pragma unroll
                      for (int k = 0; k < 8; ++k) { const int d = k >> 1, r0 = 8 * (k & 1); v4u w;
                          w.x = att::cvtpk(o[d][r0], o[d][r0 + 1]); w.y = att::cvtpk(o[d][r0 + 2], o[d][r0 + 3]); w.z = att::cvtpk(o[d][r0 + 4], o[d][r0 + 5]); w.w = att::cvtpk(o[d][r0 + 6], o[d][r0 + 7]);
                          STv[k * 512] = w; } }
                    att::attn_body<64, false, QL64, SD64>(PROJ + rowq * NIN + PA_Q + h * 128 + 64, PROJ + rowk * NIN + PA_K + h * 128 + 64, PROJ + rowk * NIN + PA_V + h * 128, SEQ / 64, (char*)lds, C64, THR64, o, 0, 0, 0, 0.f);
                    { const int t3 = opaque_tid(), l3 = t3 & 63, r32 = l3 & 31; const v4u* STv = (const v4u*)((char*)lds + 69632) + t3;
                      const float* sg = p.diff_subln + l * 128;
                      float gsub[4], ss[16];
#pragma unroll
                      for (int d = 0; d < 4; ++d) gsub[d] = sg[32 * d + r32] * (1.0f - lam_init);
#pragma unroll
                      for (int r = 0; r < 16; ++r) ss[r] = 0.f;
#pragma unroll
                      for (int k = 0; k < 8; ++k) { const int d = k >> 1, r0 = 8 * (k & 1); const v4u w = STv[k * 512];
#pragma unroll
                          for (int i = 0; i < 4; ++i) { const unsigned wi = i == 0 ? w.x : (i == 1 ? w.y : (i == 2 ? w.z : w.w));
                              const float va = bf2f((unsigned short)(wi & 0xffffu)) - lam * o[d][r0 + 2 * i], vb = bf2f((unsigned short)(wi >> 16)) - lam * o[d][r0 + 2 * i + 1];
                              o[d][r0 + 2 * i] = va; o[d][r0 + 2 * i + 1] = vb; ss[r0 + 2 * i] += va * va; ss[r0 + 2 * i + 1] += vb * vb; } }
#pragma unroll
                      for (int r = 0; r < 16; ++r) { float q = ss[r]; q += __shfl_xor(q, 1); q += __shfl_xor(q, 2); q += __shfl_xor(q, 4); q += __shfl_xor(q, 8); q += __shfl_xor(q, 16);
                          const float rstd = 1.0f / sqrtf(q * (1.0f / 128.0f) + EPS);
#pragma unroll
                          for (int d = 0; d < 4; ++d) o[d][r] *= rstd * gsub[d]; } }
                    store_o_bf16(o, CAT + rowq * DM + h * 128, lds);
                } else if (ON_GQA && kind == 1) {
                    att::attn_body<128, false, QL128, SD128>(PROJ + rowq * NIN + PC_Q + h * 128, PROJ + rowk * NIN + PC_K + (h >> 1) * 128, PROJ + rowk * NIN + PC_V + (h >> 1) * 128, SEQ / 64, (char*)lds, C128, THR128, o, 0, 0, 0, 0.f);
                    store_o_bf16(o, CAT + rowq * DM + 1024 + h * 128, lds);
                } else if (ON_NA) {
                    { const float* rsrc = p.na_rpb + (size_t)(l * 4 + h) * 465; float* rdst = (float*)((char*)lds + att::RPB_OFF); for (int e = tid; e < 465; e += NTHR) rdst[e] = rsrc[e]; }
                    int krow0 = 4 * qb - 4; krow0 = krow0 < 0 ? 0 : (krow0 > 52 ? 52 : krow0);
                    const size_t rowkn = rowk + (size_t)krow0 * 64;
                    att::attn_body<128, true, QL128, SDNA>(PROJ + rowq * NIN + PD_Q + h * 128, PROJ + rowkn * NIN + PD_K + h * 128, PROJ + rowkn * NIN + PD_V + h * 128, 12, (char*)lds, C128, THR128, o,
                                              krow0, 4 * qb + (wave >> 1), (wave & 1) * 32 + r32, 11.313708498984761f);
                    store_o_bf16(o, CAT + rowq * DM + 1536 + h * 128, lds);
                }
            }
            __syncthreads();
            if (G - 1 - bx < 64) {
                if (tid == 0) { unsigned sp = 0; while (__hip_atomic_load(ccnt + 64 * ((G - 1 - bx) >> 1), __ATOMIC_RELAXED, __HIP_MEMORY_SCOPE_AGENT) < 8u) { __builtin_amdgcn_s_sleep(2); if (++sp > (1u << 24)) break; }
                    __builtin_amdgcn_fence(__ATOMIC_ACQUIRE, "agent"); asm volatile("s_waitcnt vmcnt(0)" ::: "memory"); }
                __syncthreads();
            }
            { pg8::Gemm g{CV, WPW + (size_t)l * CC * CC, M, CC, CC}; pg8::StrideOrder S{G - 1 - bx, G, 64, 2};
              pg8::EpiBf16<0> E{CAT + 512, DM, p.conv_pw_b + l * CC, 0, 0, 1.f};
              pg8::gemm_phase<pg8::EpiBf16<0>, pg8::StrideOrder, true, true>(ldsl, g, S, E); }
        }
        GSYNC();

        { pg8::Gemm g{CAT, WOUT + (size_t)l * DM * DM, M, DM, DM}; pg8::StaticOrder S; S.init(M, DM, G, bx);
          pg8::EpiRmsFused E{XB, nullptr, XB, XN, p.norm_mix_post + l * DM, p.norm_ffn_pre + l * DM, XSLOT + (size_t)(l * 2 + 0) * 131072, CTL + 16384 + (l * 2 + 0) * 2048};
          pg8::gemm_phase<pg8::EpiRmsFused, pg8::StaticOrder, false, true>(ldsl, g, S, E); }
        GSYNC();
        _Pragma("unroll") for (int rg = 0; rg < REP_GEMM; ++rg) { pg8::Gemm g{XN, WGU + (size_t)l * 2 * FF * DM, M, 2 * FF, DM}; pg8::StaticOrder S; S.init(M, 2 * FF, G, bx);
          pg8::EpiSwiGLU E{HB, FF};
          pg8::gemm_phase<pg8::EpiSwiGLU, pg8::StaticOrder, true, true>(ldsl, g, S, E); }
        tail_convert(p, ws, l == 0 ? 1 : 3, ldsl, bx);
        GSYNC();
        { pg8::Gemm g{HB, WDN + (size_t)l * DM * FF, M, DM, FF}; pg8::StaticOrder S; S.init(M, DM, G, bx);
          pg8::EpiRmsFused E{XB, l + 1 < DEPTH ? nullptr : p.out, XB, XN, p.norm_ffn_post + l * DM, l + 1 < DEPTH ? p.norm_mix_pre + (l + 1) * DM : nullptr, XSLOT + (size_t)(l * 2 + 1) * 131072, CTL + 16384 + (l * 2 + 1) * 2048};
          pg8::gemm_phase<pg8::EpiRmsFused, pg8::StaticOrder, false, true>(ldsl, g, S, E); }
        if (l + 1 < DEPTH) GSYNC();
    }
}

extern "C" void kernel_launch(void* const* d_in, const int* in_sizes, int n_in, void* d_out, int out_size, void* d_ws, size_t ws_size, hipStream_t stream) {
    static int grid = 0;
    if (grid == 0) {
        if (n_in != 21 || out_size != M * DM || ws_size < WS_END) { fprintf(stderr, "kernel_launch: unexpected shapes: n_in %d out %d ws %zu (need %zu)\n", n_in, out_size, ws_size, (size_t)WS_END); grid = -1; return; }
        int dev = 0, cus = 0, per_cu = 0;
        if (hipGetDevice(&dev) != hipSuccess || hipDeviceGetAttribute(&cus, hipDeviceAttributeMultiprocessorCount, dev) != hipSuccess) { fprintf(stderr, "kernel_launch: device query failed\n"); grid = -1; return; }
        if (hipFuncSetAttribute((const void*)mega_fwd, hipFuncAttributeMaxDynamicSharedMemorySize, LDS_BYTES) != hipSuccess) { fprintf(stderr, "kernel_launch: hipFuncSetAttribute failed\n"); grid = -1; return; }
        if (hipOccupancyMaxActiveBlocksPerMultiprocessor(&per_cu, (const void*)mega_fwd, NTHR, LDS_BYTES) != hipSuccess || per_cu < 1) { fprintf(stderr, "kernel_launch: occupancy query says %d\n", per_cu); (void)hipGetLastError(); per_cu = 1; }
        grid = cus * per_cu;
        if (grid < 256) { fprintf(stderr, "kernel_launch: needs 256 co-resident workgroups, device offers %d\n", grid); grid = -1; return; }
        grid = 256;
    }
    if (grid < 0) return;
    if (hipMemsetAsync(d_ws, 0, 196608, stream) != hipSuccess) { fprintf(stderr, "kernel_launch: memset failed\n"); return; }
    Params p{};
    const float** pp = (const float**)&p;
    for (int i = 0; i < 21; ++i) pp[i] = (const float*)d_in[i];
    p.out = (float*)d_out; p.ws = (unsigned char*)d_ws;
    void* args[] = {&p};
    hipError_t e = hipLaunchCooperativeKernel((const void*)mega_fwd, dim3(grid), dim3(NTHR), args, LDS_BYTES, stream);
    if (e != hipSuccess) fprintf(stderr, "cooperative launch failed: %s (grid %d)\n", hipGetErrorString(e), grid);
}
```

```cpp
#include <hip/hip_runtime.h>
#include <hip/hip_cooperative_groups.h>
#include <cstdio>
#include <cstdint>
namespace cg = cooperative_groups;
__device__ __forceinline__ int opaque_tid() { int t = threadIdx.x; asm volatile("" : "+v"(t)); return t; }
namespace pg8 {
#define PG8_LAS __attribute__((address_space(3)))
typedef unsigned short bf16_t;
typedef short bf16x8 __attribute__((ext_vector_type(8)));
typedef float f32x4 __attribute__((ext_vector_type(4)));
typedef unsigned u32x4 __attribute__((ext_vector_type(4)));
constexpr int BM = 256, BK = 64, HALF = 128, HTB = HALF * BK * 2  , STAGE_BYTES = 8 * HTB, NXCD = 8, WGM = 8;

__host__ __device__ __forceinline__ int lds_byte(int r, int c) { const int st = (r >> 4) * 2 + (c >> 5), rr = r & 15, cc = c & 31, ob = rr * 64 + cc * 2; return st * 1024 + (ob ^ (((ob >> 9) & 1) << 5)); }
__host__ __device__ __forceinline__ void stage_rc(int b, int& R, int& C) { const int st = b / 1024, sb = b % 1024, swz = sb ^ (((sb >> 9) & 1) << 5); R = (st >> 1) * 16 + swz / 64; C = (st & 1) * 32 + (swz % 64) / 2; }
__host__ __device__ __forceinline__ int perm32(int rho) { const int n = rho >> 4, i = rho & 15; return 8 * (i >> 2) + 4 * n + (i & 3); }

struct Unit { int pm, pn; };
struct Gemm { const bf16_t* A; const bf16_t* Bt; int M, N, K; };

struct StaticOrder {
    int nM, nN, nwg, G, c;
    __host__ __device__ void init(int M, int N, int G_, int c_) { nM = M / BM; nN = N / BM; nwg = nM * nN; G = G_; c = c_; }
    __host__ __device__ bool next(int i, Unit& u) const {
        const long L = (long)i * G + c; if (L >= nwg) return false;
        int wgid = (int)L; { const int q = nwg / NXCD, r = nwg % NXCD, xcd = wgid % NXCD, off = wgid / NXCD; wgid = (xcd < r ? xcd * (q + 1) : r * (q + 1) + (xcd - r) * q) + off; }
        const int nig = WGM * nN, gid = wgid / nig, fm = gid * WGM, gsz = (nM - fm) < WGM ? (nM - fm) : WGM;
        u.pm = fm + ((wgid % nig) % gsz); u.pn = (wgid % nig) / gsz; return true;
    }
    __device__ __forceinline__ void a_ready(const Unit&) const {}
    __device__ __forceinline__ void done(const Unit&) const {}
};

__device__ __forceinline__ unsigned cvt_pk_bf16(float lo, float hi) { unsigned r; asm volatile("v_cvt_pk_bf16_f32 %0, %1, %2" : "=v"(r) : "v"(lo), "v"(hi)); return r; }
typedef float f32x2 __attribute__((ext_vector_type(2)));
__device__ __forceinline__ f32x2 gelu_pk(f32x2 v) {
    const f32x2 av = __builtin_elementwise_abs(v), d = av * 0.2316418882f + 1.0f;
    f32x2 t; t.x = __builtin_amdgcn_rcpf(d.x); t.y = __builtin_amdgcn_rcpf(d.y);
    f32x2 q = t * 0.5307027145f + (-0.7265760135f); q = q * t + 0.7107068705f; q = q * t + (-0.142248368f); q = q * t + 0.127414796f; q = q * t;
    const f32x2 s = (v * v) * (-0.72134752044f);
    f32x2 e; e.x = __builtin_amdgcn_exp2f(s.x); e.y = __builtin_amdgcn_exp2f(s.y);
    const f32x2 m = v * (q * e), r = v - m;
    f32x2 o; o.x = v.x < 0.f ? m.x : r.x; o.y = v.y < 0.f ? m.y : r.y; return o;
}

template <int ACT  > struct EpiBf16 {
    static constexpr bool PERM = true, AFTER_DRAIN = false; static_assert(ACT == 0 || ACT == 1, "EpiBf16: ACT is 0 (none) or 1 (gelu_pk)");
    bf16_t* O; int ldc; const float* bias; int split_cols; size_t split_stride; float scale0;
    __device__ __forceinline__ void operator()(const f32x4 (&acc)[2][2][4][2], const Unit& u, int wr, int wc, int fr, int fq) const {
        const int row0 = u.pm * BM + wr * 64 + fr; int colt = u.pn * BM; bf16_t* base = O;
        float sc = 1.f; if (split_cols) { const int t = colt / split_cols; base += (size_t)t * split_stride; colt -= t * split_cols; if (t == 0) sc = scale0; }
        const int col0 = colt + wc * 32 + 8 * fq, bcol0 = u.pn * BM + wc * 32 + 8 * fq;
        f32x4 bv[2][2];
#pragma unroll
        for (int bj = 0; bj < 2; ++bj)
#pragma unroll
            for (int n = 0; n < 2; ++n) bv[bj][n] = bias ? *(const f32x4*)(bias + bcol0 + bj * HALF + 4 * n) : (f32x4){0.f, 0.f, 0.f, 0.f};
#pragma unroll
        for (int ai = 0; ai < 2; ++ai)
#pragma unroll
            for (int m = 0; m < 4; ++m) { bf16_t* rowp = base + (size_t)(row0 + ai * HALF + m * 16) * ldc + col0;
#pragma unroll
                for (int bj = 0; bj < 2; ++bj) { f32x4 v0 = acc[ai][bj][m][0] + bv[bj][0], v1 = acc[ai][bj][m][1] + bv[bj][1];
                    if (ACT == 1) { f32x2 a = gelu_pk((f32x2){v0[0], v0[1]}), b = gelu_pk((f32x2){v0[2], v0[3]}), c = gelu_pk((f32x2){v1[0], v1[1]}), d = gelu_pk((f32x2){v1[2], v1[3]});
                        v0 = (f32x4){a.x, a.y, b.x, b.y}; v1 = (f32x4){c.x, c.y, d.x, d.y}; }
                    v0 = v0 * sc; v1 = v1 * sc; u32x4 w; w.x = cvt_pk_bf16(v0[0], v0[1]); w.y = cvt_pk_bf16(v0[2], v0[3]); w.z = cvt_pk_bf16(v1[0], v1[1]); w.w = cvt_pk_bf16(v1[2], v1[3]);
                    *(u32x4*)(rowp + bj * HALF) = w; } }
    }
};
struct EpiF32 {
    static constexpr bool PERM = false, AFTER_DRAIN = false;
    float* O; int ldc;
    __device__ __forceinline__ void operator()(const f32x4 (&acc)[2][2][4][2], const Unit& u, int wr, int wc, int fr, int fq) const {
        const int row0 = u.pm * BM + wr * 64 + fr, col0 = u.pn * BM + wc * 32 + 4 * fq;
#pragma unroll
        for (int ai = 0; ai < 2; ++ai)
#pragma unroll
            for (int m = 0; m < 4; ++m) { float* rowp = O + (size_t)(row0 + ai * HALF + m * 16) * ldc + col0;
#pragma unroll
                for (int bj = 0; bj < 2; ++bj)
#pragma unroll
                    for (int n = 0; n < 2; ++n) *(f32x4*)(rowp + bj * HALF + n * 16) = acc[ai][bj][m][n]; }
    }
};
__device__ __forceinline__ float swiglu1(float g, float u) { return g * u * __builtin_amdgcn_rcpf(1.0f + __expf(-g)); }
struct EpiSwiGLU {
    static constexpr bool PERM = true, AFTER_DRAIN = false;
    bf16_t* O; int ldc;
    __device__ __forceinline__ void operator()(const f32x4 (&acc)[2][2][4][2], const Unit& u, int wr, int wc, int fr, int fq) const {
        const int row0 = u.pm * BM + wr * 64 + fr, col0 = u.pn * HALF + wc * 32 + 8 * fq;
#pragma unroll
        for (int ai = 0; ai < 2; ++ai)
#pragma unroll
            for (int m = 0; m < 4; ++m) { bf16_t* rowp = O + (size_t)(row0 + ai * HALF + m * 16) * ldc + col0;
                const f32x4 g0 = acc[ai][0][m][0], g1 = acc[ai][0][m][1], u0 = acc[ai][1][m][0], u1 = acc[ai][1][m][1];
                u32x4 w; w.x = cvt_pk_bf16(swiglu1(g0[0], u0[0]), swiglu1(g0[1], u0[1])); w.y = cvt_pk_bf16(swiglu1(g0[2], u0[2]), swiglu1(g0[3], u0[3]));
                w.z = cvt_pk_bf16(swiglu1(g1[0], u1[0]), swiglu1(g1[1], u1[1])); w.w = cvt_pk_bf16(swiglu1(g1[2], u1[2]), swiglu1(g1[3], u1[3]));
                *(u32x4*)rowp = w; }
    }
};

struct PanelSS {
    unsigned* xbuf;
    unsigned* cnt;
    float inv_n, eps;
    __device__ __forceinline__ void run(const f32x4 (&v)[2][2][4][2], const Unit& u, int wr, int wc, int fr, int fq, PG8_LAS unsigned char* lds, int wid, int lane) const {
        PG8_LAS float* P = (PG8_LAS float*)lds;
        PG8_LAS float* S = (PG8_LAS float*)(lds + 4096);
#pragma unroll
        for (int ai = 0; ai < 2; ++ai)
#pragma unroll
            for (int m = 0; m < 4; ++m) {
                float q = 0.f;
#pragma unroll
                for (int bj = 0; bj < 2; ++bj)
#pragma unroll
                    for (int n = 0; n < 2; ++n) { const f32x4 x = v[ai][bj][m][n]; q += (x[0] * x[0] + x[1] * x[1]) + (x[2] * x[2] + x[3] * x[3]); }
                q += __shfl_xor(q, 16); q += __shfl_xor(q, 32);
                if (fq == 0) P[(ai * HALF + wr * 64 + m * 16 + fr) * 4 + wc] = q;
            }
        asm volatile("s_waitcnt lgkmcnt(0)" ::: "memory"); __builtin_amdgcn_s_barrier(); asm volatile("" ::: "memory");
        const int row = wid * 32 + (lane & 31);
        unsigned* slot = xbuf + ((size_t)(u.pm * BM + row) * 8);
        if (lane < 32) { const float q = (P[row * 4 + 0] + P[row * 4 + 1]) + (P[row * 4 + 2] + P[row * 4 + 3]);
            __hip_atomic_store(slot + u.pn, __float_as_uint(q), __ATOMIC_RELAXED, __HIP_MEMORY_SCOPE_AGENT); }
        asm volatile("s_waitcnt vmcnt(0)" ::: "memory");
        if (lane == 0) __hip_atomic_fetch_add(cnt + 64 * u.pm, 1u, __ATOMIC_RELAXED, __HIP_MEMORY_SCOPE_AGENT);
        if (wid == 0) {
            unsigned sp = 0;
            while ((unsigned)__builtin_amdgcn_readfirstlane(__hip_atomic_load(cnt + 64 * u.pm, __ATOMIC_RELAXED, __HIP_MEMORY_SCOPE_AGENT)) < 64u) { __builtin_amdgcn_s_sleep(2); if (++sp > (1u << 22)) break; }
            __builtin_amdgcn_fence(__ATOMIC_ACQUIRE, "agent");
        }
        asm volatile("s_waitcnt vmcnt(0) lgkmcnt(0)" ::: "memory"); __builtin_amdgcn_s_barrier(); asm volatile("" ::: "memory");
        if (lane < 32) { float q = 0.f;
#pragma unroll
            for (int t = 0; t < 8; ++t) q += __uint_as_float(__hip_atomic_load(slot + t, __ATOMIC_RELAXED, __HIP_MEMORY_SCOPE_AGENT));
            S[row] = 1.0f / sqrtf(q * inv_n + eps); }
        asm volatile("s_waitcnt lgkmcnt(0)" ::: "memory"); __builtin_amdgcn_s_barrier(); asm volatile("" ::: "memory");
    }
};
struct EpiRmsResRms {
    static constexpr bool PERM = false, AFTER_DRAIN = true;
    const float* base; float* out; bf16_t* xn; int ldc; const float* g1; const float* g2; PanelSS st1, st2;
    __device__ __forceinline__ void operator()(const f32x4 (&)[2][2][4][2], const Unit&, int, int, int, int) const {}
    __device__ __forceinline__ void fused(f32x4 (&acc)[2][2][4][2], const Unit& u, int wr, int wc, int fr, int fq, PG8_LAS unsigned char* lds, int wid, int lane) const {
        typedef unsigned u32x2v __attribute__((ext_vector_type(2)));
        const PG8_LAS float* S = (const PG8_LAS float*)(lds + 4096);
        const int col0 = u.pn * BM + wc * 32 + 4 * fq;
        st1.run(acc, u, wr, wc, fr, fq, lds, wid, lane);
        {
            f32x4 gv[2][2];
#pragma unroll
            for (int bj = 0; bj < 2; ++bj)
#pragma unroll
                for (int n = 0; n < 2; ++n) gv[bj][n] = *(const f32x4*)(g1 + col0 + bj * HALF + n * 16);
#pragma unroll
            for (int ai = 0; ai < 2; ++ai)
#pragma unroll
                for (int m = 0; m < 4; ++m) { const int r = ai * HALF + wr * 64 + m * 16 + fr; const float sr = S[r]; const size_t off = (size_t)(u.pm * BM + r) * ldc + col0;
#pragma unroll
                    for (int bj = 0; bj < 2; ++bj)
#pragma unroll
                        for (int n = 0; n < 2; ++n) { const f32x4 bs = *(const f32x4*)(base + off + bj * HALF + n * 16); acc[ai][bj][m][n] = bs + acc[ai][bj][m][n] * sr * gv[bj][n]; }
                    asm volatile("" : "+v"(acc[ai][0][m][0]), "+v"(acc[ai][0][m][1]), "+v"(acc[ai][1][m][0]), "+v"(acc[ai][1][m][1]));
                    if (m & 1) asm volatile("" ::: "memory"); }
        }
        if (g2) {
            st2.run(acc, u, wr, wc, fr, fq, lds, wid, lane);
            f32x4 gv[2][2];
#pragma unroll
            for (int bj = 0; bj < 2; ++bj)
#pragma unroll
                for (int n = 0; n < 2; ++n) gv[bj][n] = *(const f32x4*)(g2 + col0 + bj * HALF + n * 16);
#pragma unroll
            for (int ai = 0; ai < 2; ++ai)
#pragma unroll
                for (int m = 0; m < 4; ++m) { const int r = ai * HALF + wr * 64 + m * 16 + fr; const float sr = S[r]; const size_t off = (size_t)(u.pm * BM + r) * ldc + col0;
#pragma unroll
                    for (int bj = 0; bj < 2; ++bj)
#pragma unroll
                        for (int n = 0; n < 2; ++n) { const f32x4 x1 = acc[ai][bj][m][n]; *(f32x4*)(out + off + bj * HALF + n * 16) = x1;
                            const f32x4 o = x1 * sr * gv[bj][n]; u32x2v w; w.x = cvt_pk_bf16(o[0], o[1]); w.y = cvt_pk_bf16(o[2], o[3]);
                            *(u32x2v*)(xn + off + bj * HALF + n * 16) = w; }
                    asm volatile("" ::: "memory"); }
        } else {
#pragma unroll
            for (int ai = 0; ai < 2; ++ai)
#pragma unroll
                for (int m = 0; m < 4; ++m) { const int r = ai * HALF + wr * 64 + m * 16 + fr; const size_t off = (size_t)(u.pm * BM + r) * ldc + col0;
#pragma unroll
                    for (int bj = 0; bj < 2; ++bj)
#pragma unroll
                        for (int n = 0; n < 2; ++n) *(f32x4*)(out + off + bj * HALF + n * 16) = acc[ai][bj][m][n]; }
        }
    }
};

__device__ __forceinline__ float bflo(unsigned w) { return __builtin_bit_cast(float, w << 16); }
__device__ __forceinline__ float bfhi(unsigned w) { return __builtin_bit_cast(float, w & 0xffff0000u); }
struct EpiRmsFused {
    static constexpr bool PERM = true, AFTER_DRAIN = true;
    const bf16_t* base_b;
    float* out_f; bf16_t* out_b;
    bf16_t* xn; const float* g1; const float* g2;
    unsigned long long* xbuf;
    unsigned* cnt;
    __device__ __forceinline__ void operator()(const f32x4 (&)[2][2][4][2], const Unit&, int, int, int, int) const {}
    __device__ __forceinline__ void fused(f32x4 (&acc)[2][2][4][2], const Unit& u, int wr, int wc, int fr, int fq, PG8_LAS unsigned char* lds, int wid, int lane) const {
        typedef unsigned u32x2v __attribute__((ext_vector_type(2)));
        constexpr int ldc = 2048; constexpr float inv_n = 1.0f / 2048.0f, eps = 1e-6f;
        PG8_LAS f32x4* P = (PG8_LAS f32x4*)(lds + 131072);
        PG8_LAS float* S = (PG8_LAS float*)(lds + 131072 + 16384);
        const int col0 = u.pn * BM + wc * 32 + 8 * fq;
        f32x4 gv[2][2];
#pragma unroll
        for (int bj = 0; bj < 2; ++bj)
#pragma unroll
            for (int n = 0; n < 2; ++n) gv[bj][n] = *(const f32x4*)(g1 + col0 + bj * HALF + n * 4);
        PG8_LAS u32x4* XL = (PG8_LAS u32x4*)lds + (wid * 64 + lane);
#pragma unroll
        for (int ai = 0; ai < 2; ++ai)
#pragma unroll
            for (int m = 0; m < 4; ++m) { const size_t off = (size_t)(u.pm * BM + ai * HALF + wr * 64 + m * 16 + fr) * ldc + col0;
#pragma unroll
                for (int bj = 0; bj < 2; ++bj) XL[((ai * 4 + m) * 2 + bj) * 512] = *(const u32x4*)(base_b + off + bj * HALF); }
#pragma unroll
        for (int ai = 0; ai < 2; ++ai)
#pragma unroll
            for (int m = 0; m < 4; ++m) {
                float saa = 0.f, sxx = 0.f, sxag = 0.f, sgg = 0.f;
#pragma unroll
                for (int bj = 0; bj < 2; ++bj) { const u32x4 w4 = XL[((ai * 4 + m) * 2 + bj) * 512];
#pragma unroll
                    for (int n = 0; n < 2; ++n) { const f32x4 a = acc[ai][bj][m][n]; const f32x4 ag = a * gv[bj][n]; const unsigned wx = n == 0 ? w4.x : w4.z, wy = n == 0 ? w4.y : w4.w;
                        const f32x4 x = (f32x4){bflo(wx), bfhi(wx), bflo(wy), bfhi(wy)};
                        saa += (a[0] * a[0] + a[1] * a[1]) + (a[2] * a[2] + a[3] * a[3]); sxx += (x[0] * x[0] + x[1] * x[1]) + (x[2] * x[2] + x[3] * x[3]);
                        sxag += (x[0] * ag[0] + x[1] * ag[1]) + (x[2] * ag[2] + x[3] * ag[3]); sgg += (ag[0] * ag[0] + ag[1] * ag[1]) + (ag[2] * ag[2] + ag[3] * ag[3]); } }
                asm volatile("" : "+v"(saa), "+v"(sxx), "+v"(sxag), "+v"(sgg));
                saa += __shfl_xor(saa, 16); sxx += __shfl_xor(sxx, 16); sxag += __shfl_xor(sxag, 16); sgg += __shfl_xor(sgg, 16);
                saa += __shfl_xor(saa, 32); sxx += __shfl_xor(sxx, 32); sxag += __shfl_xor(sxag, 32); sgg += __shfl_xor(sgg, 32);
                if (fq == 0) P[(ai * HALF + wr * 64 + m * 16 + fr) * 4 + wc] = (f32x4){saa, sxx, sxag, sgg};
                __builtin_amdgcn_sched_barrier(0);
            }
        asm volatile("s_waitcnt lgkmcnt(0)" ::: "memory"); __builtin_amdgcn_s_barrier(); asm volatile("" ::: "memory");
        const int row = wid * 32 + (lane & 31);
        unsigned long long* slot = xbuf + ((size_t)(u.pm * BM + row) * 8) * 2;
        if (lane < 32) { const f32x4 q = (P[row * 4 + 0] + P[row * 4 + 1]) + (P[row * 4 + 2] + P[row * 4 + 3]);
            __hip_atomic_store(slot + u.pn * 2, ((unsigned long long)__float_as_uint(q[1]) << 32) | __float_as_uint(q[0]), __ATOMIC_RELAXED, __HIP_MEMORY_SCOPE_AGENT);
            __hip_atomic_store(slot + u.pn * 2 + 1, ((unsigned long long)__float_as_uint(q[3]) << 32) | __float_as_uint(q[2]), __ATOMIC_RELAXED, __HIP_MEMORY_SCOPE_AGENT); }
        asm volatile("s_waitcnt vmcnt(0)" ::: "memory"); __builtin_amdgcn_s_barrier(); asm volatile("" ::: "memory");
        if (wid == 0) {
            if (lane == 0) __hip_atomic_fetch_add(cnt + 64 * u.pm, 1u, __ATOMIC_RELAXED, __HIP_MEMORY_SCOPE_AGENT);
            unsigned sp = 0;
            while ((unsigned)__builtin_amdgcn_readfirstlane(__hip_atomic_load(cnt + 64 * u.pm, __ATOMIC_RELAXED, __HIP_MEMORY_SCOPE_AGENT)) < 8u) { __builtin_amdgcn_s_sleep(1); if (++sp > (1u << 22)) break; }
            __builtin_amdgcn_fence(__ATOMIC_ACQUIRE, "agent");
        }
        asm volatile("s_waitcnt vmcnt(0) lgkmcnt(0)" ::: "memory"); __builtin_amdgcn_s_barrier(); asm volatile("" ::: "memory");
        if (lane < 32) { float saa = 0.f, sxx = 0.f, sxag = 0.f, sgg = 0.f;
#pragma unroll
            for (int t = 0; t < 8; ++t) { const unsigned long long w0 = __hip_atomic_load(slot + t * 2, __ATOMIC_RELAXED, __HIP_MEMORY_SCOPE_AGENT), w1 = __hip_atomic_load(slot + t * 2 + 1, __ATOMIC_RELAXED, __HIP_MEMORY_SCOPE_AGENT);
                saa += __uint_as_float((unsigned)w0); sxx += __uint_as_float((unsigned)(w0 >> 32)); sxag += __uint_as_float((unsigned)w1); sgg += __uint_as_float((unsigned)(w1 >> 32)); }
            const float r1 = 1.0f / sqrtf(saa * inv_n + eps);
            float s1 = sxx + 2.0f * r1 * sxag + r1 * r1 * sgg; s1 = s1 < 0.f ? 0.f : s1;
            S[row * 2] = r1; S[row * 2 + 1] = 1.0f / sqrtf(s1 * inv_n + eps); }
        asm volatile("s_waitcnt lgkmcnt(0)" ::: "memory"); __builtin_amdgcn_s_barrier(); asm volatile("" ::: "memory");
        int fr2 = fr, col2 = col0; asm volatile("" : "+v"(fr2), "+v"(col2));
        f32x4 g2v[2][2], g1v[2][2];
#pragma unroll
        for (int bj = 0; bj < 2; ++bj)
#pragma unroll
            for (int n = 0; n < 2; ++n) { g2v[bj][n] = g2 ? *(const f32x4*)(g2 + col2 + bj * HALF + n * 4) : (f32x4){0.f, 0.f, 0.f, 0.f}; g1v[bj][n] = *(const f32x4*)(g1 + col2 + bj * HALF + n * 4); }
#pragma unroll
        for (int ai = 0; ai < 2; ++ai)
#pragma unroll
            for (int m = 0; m < 4; ++m) { const int r = ai * HALF + wr * 64 + m * 16 + fr2; const float r1 = S[r * 2], r2 = S[r * 2 + 1]; const size_t off = (size_t)(u.pm * BM + r) * ldc + col2;
#pragma unroll
                for (int bj = 0; bj < 2; ++bj) { u32x4 w4 = XL[((ai * 4 + m) * 2 + bj) * 512]; asm volatile("" : "+v"(w4.x), "+v"(w4.y), "+v"(w4.z), "+v"(w4.w));
                    const f32x4 xa = (f32x4){bflo(w4.x), bfhi(w4.x), bflo(w4.y), bfhi(w4.y)}, xb = (f32x4){bflo(w4.z), bfhi(w4.z), bflo(w4.w), bfhi(w4.w)};
                    const f32x4 x1a = xa + acc[ai][bj][m][0] * r1 * g1v[bj][0], x1b = xb + acc[ai][bj][m][1] * r1 * g1v[bj][1];
                    if (out_f) { *(f32x4*)(out_f + off + bj * HALF) = x1a; *(f32x4*)(out_f + off + bj * HALF + 4) = x1b; }
                    else { u32x4 o; o.x = cvt_pk_bf16(x1a[0], x1a[1]); o.y = cvt_pk_bf16(x1a[2], x1a[3]); o.z = cvt_pk_bf16(x1b[0], x1b[1]); o.w = cvt_pk_bf16(x1b[2], x1b[3]); *(u32x4*)(out_b + off + bj * HALF) = o; }
                    if (g2) { const f32x4 ya = x1a * r2 * g2v[bj][0], yb = x1b * r2 * g2v[bj][1]; u32x4 o; o.x = cvt_pk_bf16(ya[0], ya[1]); o.y = cvt_pk_bf16(ya[2], ya[3]); o.z = cvt_pk_bf16(yb[0], yb[1]); o.w = cvt_pk_bf16(yb[2], yb[3]);
                        *(u32x4*)(xn + off + bj * HALF) = o; } }
                asm volatile("" ::: "memory"); __builtin_amdgcn_sched_barrier(0); }
    }
};

struct EpiProj {
    static constexpr bool PERM = true, AFTER_DRAIN = false;
    bf16_t* O; int ldc; const float* rope; const float* qn; const float* kn; PG8_LAS float* X;
    __device__ __forceinline__ void operator()(const f32x4 (&acc)[2][2][4][2], const Unit& u, int wr, int wc, int fr_, int fq_) const {
        int fr = fr_, fq = fq_; asm volatile("" : "+v"(fr), "+v"(fq));
        const int pn = u.pn, kind = pn < 4 ? 1 : ((pn >= 10 && pn <= 12) ? 2 : 0);
        if (kind == 0) {
            const int row0 = u.pm * BM + wr * 64 + fr, col0 = pn * BM + wc * 32 + 8 * fq;
#pragma unroll
            for (int ai = 0; ai < 2; ++ai)
#pragma unroll
                for (int m = 0; m < 4; ++m) { bf16_t* rowp = O + (size_t)(row0 + ai * HALF + m * 16) * ldc + col0;
#pragma unroll
                    for (int bj = 0; bj < 2; ++bj) { const f32x4 v0 = acc[ai][bj][m][0], v1 = acc[ai][bj][m][1];
                        u32x4 w; w.x = cvt_pk_bf16(v0[0], v0[1]); w.y = cvt_pk_bf16(v0[2], v0[3]); w.z = cvt_pk_bf16(v1[0], v1[1]); w.w = cvt_pk_bf16(v1[2], v1[3]);
                        *(u32x4*)(rowp + bj * HALF) = w; } }
            return;
        }
        const int i0 = 8 * fq, c1 = pn * BM + 64 * wc + i0;
        float frev[8];
#pragma unroll
        for (int k = 0; k < 8; ++k) { constexpr float FK[8] = {0.15915494309189535f, 0.11934937021124886f, 0.08949940160889104f, 0.06711508300522727f, 0.05032921210448705f, 0.037741584717419785f, 0.02830219583062341f, 0.02122365276477767f};
            frev[k] = FK[k] * (fq == 0 ? 1.0f : (fq == 1 ? 0.1f : (fq == 2 ? 0.01f : 0.001f))); }
        f32x4 ga[2], gb[2];
        if (kind == 2) { const float* gn = (pn == 12 ? kn : qn) + 64 * (wc & 1) + i0;
            ga[0] = *(const f32x4*)gn; ga[1] = *(const f32x4*)(gn + 4); gb[0] = *(const f32x4*)(gn + 32); gb[1] = *(const f32x4*)(gn + 36);
#pragma unroll
            for (int ai = 0; ai < 2; ++ai)
#pragma unroll
                for (int m = 0; m < 4; ++m) { float q = 0.f;
#pragma unroll
                    for (int bj = 0; bj < 2; ++bj)
#pragma unroll
                        for (int n = 0; n < 2; ++n) { const f32x4 x = acc[ai][bj][m][n]; q += (x[0] * x[0] + x[1] * x[1]) + (x[2] * x[2] + x[3] * x[3]); }
                    q += __shfl_xor(q, 16); q += __shfl_xor(q, 32);
                    if (fq == 0) X[(ai * HALF + wr * 64 + m * 16 + fr) * 4 + wc] = q; }
            asm volatile("s_waitcnt lgkmcnt(0)" ::: "memory"); __builtin_amdgcn_s_barrier(); asm volatile("" ::: "memory");
        } else { ga[0] = ga[1] = gb[0] = gb[1] = (f32x4){1.f, 1.f, 1.f, 1.f}; }
#pragma unroll
        for (int ai = 0; ai < 2; ++ai)
#pragma unroll
            for (int m = 0; m < 4; ++m) { const int r = ai * HALF + wr * 64 + m * 16 + fr, row = u.pm * BM + r, t = row & 4095;
                const int pos = kind == 1 ? t : ((wc & 1) ? (t & 63) : (t >> 6));
                const float fpos = (float)pos;
                float rs = 1.f;
                if (kind == 2) rs = 1.0f / sqrtf((X[r * 4 + wc] + X[r * 4 + (wc ^ 1)]) * (1.0f / 128.0f) + 1e-6f);
                u32x4 w1, w2;
#pragma unroll
                for (int n = 0; n < 2; ++n) {
                    f32x4 c, sn;
#pragma unroll
                    for (int j = 0; j < 4; ++j) { const float rev = __builtin_amdgcn_fractf(fpos * frev[4 * n + j]); c[j] = __builtin_amdgcn_cosf(rev); sn[j] = __builtin_amdgcn_sinf(rev); }
                    const f32x4 a = acc[ai][0][m][n] * rs * ga[n], b = acc[ai][1][m][n] * rs * gb[n];
                    const f32x4 o1 = a * c - b * sn, o2 = a * sn + b * c;
                    if (n == 0) { w1.x = cvt_pk_bf16(o1[0], o1[1]); w1.y = cvt_pk_bf16(o1[2], o1[3]); w2.x = cvt_pk_bf16(o2[0], o2[1]); w2.y = cvt_pk_bf16(o2[2], o2[3]); }
                    else { w1.z = cvt_pk_bf16(o1[0], o1[1]); w1.w = cvt_pk_bf16(o1[2], o1[3]); w2.z = cvt_pk_bf16(o2[0], o2[1]); w2.w = cvt_pk_bf16(o2[2], o2[3]); }
                }
                bf16_t* rowp = O + (size_t)row * ldc + c1;
                *(u32x4*)rowp = w1;
                *(u32x4*)(rowp + 32) = w2; __builtin_amdgcn_sched_barrier(0); }
    }
};
struct StrideOrder {
    int first, G, count, nN;
    __device__ bool next(int i, Unit& u) const { const int j = first + i * G; if (j >= count) return false; u.pm = j / nN; u.pn = j % nN; return true; }
    __device__ __forceinline__ void a_ready(const Unit&) const {}
    __device__ __forceinline__ void done(const Unit&) const {}
};
template <class Epi, class Sched, bool ALIGN_EPI = false, bool SP2 = false>
__device__ __forceinline__ void gemm_phase(PG8_LAS unsigned char* lds, const Gemm g, const Sched& S, const Epi& E) {
    const int tid = opaque_tid(), wid = __builtin_amdgcn_readfirstlane(tid >> 6), lane = tid & 63, wr = wid >> 2, wc = wid & 3, fr = lane & 15, fq = lane >> 4;
    const int K = g.K, nt = K / BK;
    unsigned voffA[2], voffB[2];
#pragma unroll
    for (int i = 0; i < 2; ++i) { int R, C; stage_rc(tid * 16 + i * 8192, R, C); const int Rb = Epi::PERM ? ((R & ~31) + perm32(R & 31)) : R;
        voffA[i] = (unsigned)(R * K + C) * 2u; voffB[i] = (unsigned)(Rb * K + C) * 2u; }
    const size_t kstep = (size_t)(BK * 2);
    const size_t hstep = (size_t)HALF * K * 2;
    const size_t tstep = 2 * hstep;
    const unsigned ldsw = (unsigned)wid * 1024u;
    const int aoff = lds_byte(wr * 64 + fr, fq * 8), boff = lds_byte(wc * 32 + fr, fq * 8);
#define PG8_SA(b, h) (((b) * 2 + (h)) * HTB)
#define PG8_SB(b, h) ((4 + (b) * 2 + (h)) * HTB)
#define PG8_STAGE(bufoff, gbase, voff) do { _Pragma("unroll") for (int _i = 0; _i < 2; ++_i) \
        __builtin_amdgcn_global_load_lds((const unsigned*)((const char*)(gbase) + (voff)[_i]), (PG8_LAS unsigned*)(lds + (bufoff) + ldsw + _i * 8192), 16, 0, 0); } while (0)
#define PG8_LDA(dst, b, h) do { _Pragma("unroll") for (int m = 0; m < 4; ++m) _Pragma("unroll") for (int k = 0; k < 2; ++k) dst[m][k] = *(const PG8_LAS bf16x8*)(lds + PG8_SA(b, h) + aoff + m * 2048 + k * 1024); } while (0)
#define PG8_LDB(dst, b, h) do { _Pragma("unroll") for (int n = 0; n < 2; ++n) _Pragma("unroll") for (int k = 0; k < 2; ++k) dst[n][k] = *(const PG8_LAS bf16x8*)(lds + PG8_SB(b, h) + boff + n * 2048 + k * 1024); } while (0)
#define PG8_MMA(ai, bj, At, Bt) do { __builtin_amdgcn_s_setprio(1); _Pragma("unroll") for (int m = 0; m < 4; ++m) _Pragma("unroll") for (int n = 0; n < 2; ++n) _Pragma("unroll") for (int k = 0; k < 2; ++k) \
        acc[ai][bj][m][n] = __builtin_amdgcn_mfma_f32_16x16x32_bf16(Bt[n][k], At[m][k], acc[ai][bj][m][n], 0, 0, 0); __builtin_amdgcn_s_setprio(0); } while (0)
#define PG8_WAIT_V(n) asm volatile("s_waitcnt vmcnt(" #n ")" ::: "memory")
#define PG8_WAIT_L(n) asm volatile("s_waitcnt lgkmcnt(" #n ")" ::: "memory")
#define PG8_BAR __builtin_amdgcn_s_barrier()
#define PG8_SCHED __builtin_amdgcn_sched_barrier(0)
    Unit cur, nxt; int ui = 0;
    if (!S.next(0, cur)) return;
    f32x4 acc[2][2][4][2];
#pragma unroll
    for (int a = 0; a < 2; ++a)
#pragma unroll
        for (int b = 0; b < 2; ++b)
#pragma unroll
            for (int m = 0; m < 4; ++m)
#pragma unroll
                for (int n = 0; n < 2; ++n) acc[a][b][m][n] = (f32x4){0.f, 0.f, 0.f, 0.f};
    bf16x8 At[4][2], B0[2][2], B1[2][2];
    const char* cA = (const char*)g.A + (size_t)cur.pm * tstep; const char* cB = (const char*)g.Bt + (size_t)cur.pn * tstep;
    S.a_ready(cur);
    if constexpr (SP2) {
        PG8_STAGE(PG8_SB(0, 0), cB, voffB); PG8_STAGE(PG8_SB(0, 1), cB + hstep, voffB); PG8_STAGE(PG8_SA(0, 0), cA, voffA); PG8_STAGE(PG8_SA(0, 1), cA + hstep, voffA);
        if (wr == 1) PG8_BAR;
        PG8_WAIT_V(2); PG8_BAR;
        PG8_STAGE(PG8_SB(1, 0), cB + kstep, voffB); PG8_STAGE(PG8_SA(1, 0), cA + kstep, voffA); PG8_STAGE(PG8_SB(1, 1), cB + hstep + kstep, voffB);
        PG8_WAIT_V(6); PG8_BAR;
    } else {
        PG8_STAGE(PG8_SB(0, 0), cB, voffB); PG8_STAGE(PG8_SA(0, 0), cA, voffA); PG8_STAGE(PG8_SB(0, 1), cB + hstep, voffB); PG8_STAGE(PG8_SA(0, 1), cA + hstep, voffA);
        if (wr == 1) PG8_BAR;
        PG8_WAIT_V(4); PG8_BAR;
        PG8_STAGE(PG8_SB(1, 0), cB + kstep, voffB); PG8_STAGE(PG8_SA(1, 0), cA + kstep, voffA); PG8_STAGE(PG8_SB(1, 1), cB + hstep + kstep, voffB);
        PG8_WAIT_V(6); PG8_BAR;
    }
    for (;;) {
        const bool has_next = S.next(ui + 1, nxt);
        const char* nA = has_next ? (const char*)g.A + (size_t)nxt.pm * tstep : cA; const char* nB = has_next ? (const char*)g.Bt + (size_t)nxt.pn * tstep : cB;
        for (int t = 0; t < nt; t += 2) {
            const bool last = (t == nt - 2);
            const char* a1 = cA + (size_t)(t + 1) * kstep;
            const char* a2 = last ? nA : cA + (size_t)(t + 2) * kstep; const char* b2 = last ? nB : cB + (size_t)(t + 2) * kstep;
            const char* a3 = a2 + kstep; const char* b3 = b2 + kstep;
            if (last && has_next) S.a_ready(nxt);
            if constexpr (SP2) {
            PG8_LDB(B0, 0, 0); PG8_LDB(B1, 0, 1); PG8_SCHED; PG8_LDA(At, 0, 0); PG8_STAGE(PG8_SA(1, 1), a1 + hstep, voffA);
            PG8_WAIT_V(8); PG8_WAIT_L(0); PG8_BAR; PG8_MMA(0, 0, At, B0); PG8_MMA(0, 1, At, B1); PG8_BAR; PG8_SCHED;
            PG8_LDA(At, 0, 1); PG8_STAGE(PG8_SB(0, 0), b2, voffB); PG8_STAGE(PG8_SB(0, 1), b2 + hstep, voffB); PG8_STAGE(PG8_SA(0, 0), a2, voffA);
            PG8_WAIT_V(8); PG8_WAIT_L(0); PG8_BAR; PG8_MMA(1, 0, At, B0); PG8_MMA(1, 1, At, B1); PG8_BAR; PG8_SCHED;
            PG8_LDB(B0, 1, 0); PG8_LDB(B1, 1, 1); PG8_SCHED; PG8_LDA(At, 1, 0); PG8_STAGE(PG8_SA(0, 1), a2 + hstep, voffA);
            PG8_WAIT_V(8); PG8_WAIT_L(0); PG8_BAR; PG8_MMA(0, 0, At, B0); PG8_MMA(0, 1, At, B1); PG8_BAR; PG8_SCHED;
            PG8_LDA(At, 1, 1); PG8_STAGE(PG8_SB(1, 0), b3, voffB); PG8_STAGE(PG8_SB(1, 1), b3 + hstep, voffB); PG8_STAGE(PG8_SA(1, 0), a3, voffA);
            PG8_WAIT_V(8); PG8_WAIT_L(0); PG8_BAR; PG8_MMA(1, 0, At, B0); PG8_MMA(1, 1, At, B1); PG8_BAR; PG8_SCHED;
            } else {
            PG8_LDB(B0, 0, 0); PG8_SCHED; PG8_LDA(At, 0, 0); PG8_STAGE(PG8_SA(1, 1), a1 + hstep, voffA);
            PG8_WAIT_L(8); PG8_BAR; PG8_WAIT_L(0); PG8_MMA(0, 0, At, B0); PG8_BAR; PG8_SCHED;
            PG8_LDB(B1, 0, 1); PG8_STAGE(PG8_SB(0, 0), b2, voffB);
            PG8_BAR; PG8_WAIT_L(0); PG8_MMA(0, 1, At, B1); PG8_BAR;
            PG8_LDA(At, 0, 1); PG8_STAGE(PG8_SA(0, 0), a2, voffA);
            PG8_BAR; PG8_WAIT_L(0); PG8_MMA(1, 0, At, B0); PG8_BAR; PG8_SCHED;
            PG8_STAGE(PG8_SB(0, 1), b2 + hstep, voffB);
            PG8_WAIT_V(6); PG8_BAR; PG8_MMA(1, 1, At, B1); PG8_BAR;
            PG8_LDB(B0, 1, 0); PG8_SCHED; PG8_LDA(At, 1, 0); PG8_STAGE(PG8_SA(0, 1), a2 + hstep, voffA);
            PG8_WAIT_L(8); PG8_BAR; PG8_WAIT_L(0); PG8_MMA(0, 0, At, B0); PG8_BAR; PG8_SCHED;
            PG8_LDB(B1, 1, 1); PG8_STAGE(PG8_SB(1, 0), b3, voffB);
            PG8_BAR; PG8_WAIT_L(0); PG8_MMA(0, 1, At, B1); PG8_BAR;
            PG8_LDA(At, 1, 1); PG8_STAGE(PG8_SA(1, 0), a3, voffA);
            PG8_BAR; PG8_WAIT_L(0); PG8_MMA(1, 0, At, B0); PG8_BAR; PG8_SCHED;
            PG8_STAGE(PG8_SB(1, 1), b3 + hstep, voffB);
            PG8_WAIT_V(6); PG8_BAR; PG8_MMA(1, 1, At, B1); PG8_BAR;
            }
        }
        if constexpr (ALIGN_EPI) { if (wr == 0) PG8_BAR; }
        if constexpr (!Epi::AFTER_DRAIN) { E(acc, cur, wr, wc, fr, fq); S.done(cur); }
        if (!has_next) break;
#pragma unroll
        for (int a = 0; a < 2; ++a)
#pragma unroll
            for (int b = 0; b < 2; ++b)
#pragma unroll
                for (int m = 0; m < 4; ++m)
#pragma unroll
                    for (int n = 0; n < 2; ++n) acc[a][b][m][n] = (f32x4){0.f, 0.f, 0.f, 0.f};
        cur = nxt; cA = nA; cB = nB; ++ui;
        if constexpr (ALIGN_EPI) { if (wr == 1) PG8_BAR; }
    }
    PG8_WAIT_V(0);
    if constexpr (!ALIGN_EPI) { if (wr == 0) PG8_BAR; }
    PG8_BAR;
    if constexpr (Epi::AFTER_DRAIN) { E.fused(acc, cur, wr, wc, fr, fq, lds, wid, lane); S.done(cur); }
#undef PG8_SA
#undef PG8_SB
#undef PG8_STAGE
#undef PG8_LDA
#undef PG8_LDB
#undef PG8_MMA
#undef PG8_WAIT_V
#undef PG8_WAIT_L
#undef PG8_BAR
#undef PG8_SCHED
}
}
namespace att {
using bf16 = unsigned short;
using bf16x8 = __attribute__((ext_vector_type(8))) short;
using s16x4  = __attribute__((ext_vector_type(4))) short;
using f32x16 = __attribute__((ext_vector_type(16))) float;
using u32x4  = __attribute__((ext_vector_type(4))) unsigned;
constexpr int KVBLK = 64, LDP = 5120;
constexpr float THR = 8.f;
constexpr int SHM_V = 16384, SHM_K = 16384, SHM_ATTN = 2 * SHM_V + 2 * SHM_K + 8 * 64 * 4;
constexpr int RPB_OFF = SHM_ATTN, Q_OFF = SHM_ATTN + 2048;
#define SBAR() __builtin_amdgcn_sched_barrier(0)
template <int DK> __device__ __forceinline__ int kswz(int row, int colB) { return DK == 128 ? row * 256 + (colB ^ ((row & 7) << 4)) : row * 128 + (colB ^ (((row >> 1) & 7) << 4)); }
__device__ __forceinline__ int crow(int r, int hi) { return (r & 3) + 8 * (r >> 2) + 4 * hi; }
__device__ __forceinline__ unsigned cvtpk(float lo, float hi) { unsigned r; asm volatile("v_cvt_pk_bf16_f32 %0, %1, %2" : "=v"(r) : "v"(lo), "v"(hi)); return r; }

__device__ __forceinline__ void partialSM(f32x16& p0, f32x16& p1, float& m_reg, float& mn, float& alpha, float C, float thrRaw) {
  float pmax = p0[0];
#pragma unroll
  for (int r = 1; r < 16; ++r) pmax = fmaxf(pmax, p0[r]);
#pragma unroll
  for (int r = 0; r < 16; ++r) pmax = fmaxf(pmax, p1[r]);
  { auto rr = __builtin_amdgcn_permlane32_swap(__float_as_uint(pmax), __float_as_uint(pmax), false, false);
    pmax = fmaxf(__uint_as_float(rr[0]), __uint_as_float(rr[1])); }
  if (__builtin_expect(__all(pmax - m_reg <= thrRaw), 1)) { mn = m_reg; alpha = 1.f; }
  else { mn = fmaxf(m_reg, pmax); alpha = __builtin_amdgcn_exp2f((m_reg - mn) * C); m_reg = mn; }
  float mnC = -mn * C;
#pragma unroll
  for (int r = 0; r < 16; ++r) p0[r] = fmaf(p0[r], C, mnC);
#pragma unroll
  for (int r = 0; r < 16; ++r) p1[r] = fmaf(p1[r], C, mnC);
#pragma unroll
  for (int r = 0; r < 16; ++r) p0[r] = __builtin_amdgcn_exp2f(p0[r]);
}
__device__ __forceinline__ void finishSM(f32x16& p0, f32x16& p1, float alpha, float& l_reg, bf16x8& pa0, bf16x8& pa1, bf16x8& pa2, bf16x8& pa3) {
#pragma unroll
  for (int r = 0; r < 16; ++r) p1[r] = __builtin_amdgcn_exp2f(p1[r]);
  float ps = 0;
#pragma unroll
  for (int r = 0; r < 16; ++r) ps += p0[r];
#pragma unroll
  for (int r = 0; r < 16; ++r) ps += p1[r];
  { auto rr = __builtin_amdgcn_permlane32_swap(__float_as_uint(ps), __float_as_uint(ps), false, false);
    ps = __uint_as_float(rr[0]) + __uint_as_float(rr[1]); }
  l_reg = l_reg * alpha + ps;
#define PK4(P, BASE, OUT) do { unsigned a0 = cvtpk(P[BASE + 0], P[BASE + 1]), a1 = cvtpk(P[BASE + 2], P[BASE + 3]);   \
    unsigned b0 = cvtpk(P[BASE + 4], P[BASE + 5]), b1 = cvtpk(P[BASE + 6], P[BASE + 7]);                              \
    auto r0 = __builtin_amdgcn_permlane32_swap(a0, b0, false, false); auto r1 = __builtin_amdgcn_permlane32_swap(a1, b1, false, false); \
    u32x4 w = {r0[0], r1[0], r0[1], r1[1]}; OUT = *reinterpret_cast<bf16x8*>(&w); } while (0)
  PK4(p0, 0, pa0); PK4(p0, 8, pa1); PK4(p1, 0, pa2); PK4(p1, 8, pa3);
#undef PK4
}
template <int DK, bool QL>
__device__ __forceinline__ void qkt(f32x16& p0, f32x16& p1, const bf16* Ks, const bf16x8* qr, const char* ql, int r32, int hi) {
  p0 = f32x16{}; p1 = f32x16{};
#pragma unroll
  for (int d0 = 0; d0 < DK / 16; ++d0) { int cb = (d0 * 16 + hi * 8) * 2;
    const bf16x8 qv = QL ? *reinterpret_cast<const bf16x8*>(ql + d0 * 1024) : qr[d0];
    bf16x8 b0 = *reinterpret_cast<const bf16x8*>((const char*)Ks + kswz<DK>(r32, cb));
    bf16x8 b1 = *reinterpret_cast<const bf16x8*>((const char*)Ks + kswz<DK>(32 + r32, cb));
    p0 = __builtin_amdgcn_mfma_f32_32x32x16_bf16(b0, qv, p0, 0, 0, 0);
    p1 = __builtin_amdgcn_mfma_f32_32x32x16_bf16(b1, qv, p1, 0, 0, 0); }
}
__device__ __forceinline__ void na_hook(f32x16& p0, f32x16& p1, int kr, int q_row, int q_col, int win_r, int win_c, const float* rpb, float inv_scale, int hi) {
  const bool rowok = (kr >= win_r) && (kr < win_r + 8);
  int ir = kr - q_row + 7; ir = ir < 0 ? 0 : (ir > 14 ? 14 : ir);
  const float* rp = rpb + ir * 31;
#pragma unroll
  for (int r = 0; r < 16; ++r) {
    const int kc = crow(r, hi);
    { const bool ok = rowok && kc >= win_c && kc < win_c + 16; int ic = kc - q_col + 15; ic = ic < 0 ? 0 : (ic > 30 ? 30 : ic);
      p0[r] = ok ? fmaf(rp[ic], inv_scale, p0[r]) : -1e30f; }
    { const int kc2 = kc + 32; const bool ok = rowok && kc2 >= win_c && kc2 < win_c + 16; int ic = kc2 - q_col + 15; ic = ic < 0 ? 0 : (ic > 30 ? 30 : ic);
      p1[r] = ok ? fmaf(rp[ic], inv_scale, p1[r]) : -1e30f; }
  }
}
__device__ __forceinline__ int v_st(int k, int c) { const int kk = (k & ~0xC) | ((k & 4) << 1) | ((k & 8) >> 1); return ((kk >> 3) * 4 + (c >> 5)) * 512 + ((kk & 7) * 32 + (c & 31)) * 2; }
__device__ __forceinline__ int v_rd_base(int lane) { return ((lane & 3) << 3) | (((lane >> 2) & 3) << 6) | (((lane >> 4) & 1) << 5) | (((lane >> 5) & 1) << 8); }
constexpr int v_rd_off(int d0, int ks, int half) { return d0 * 512 + ks * 4096 + half * 2048; }
template <int OFF> __device__ __forceinline__ s16x4 tr_read(int vb) {
  s16x4 r; asm volatile("ds_read_b64_tr_b16 %0, %1 offset:%2" : "=&v"(r) : "v"(vb), "i"(OFF) : "memory"); return r;
}
template <int D0> __device__ __forceinline__ void pv_one(f32x16& od, int vb, bf16x8 pa0, bf16x8 pa1, bf16x8 pa2, bf16x8 pa3) {
  const s16x4 l0 = tr_read<v_rd_off(D0, 0, 0)>(vb), h0 = tr_read<v_rd_off(D0, 0, 1)>(vb), l1 = tr_read<v_rd_off(D0, 1, 0)>(vb), h1 = tr_read<v_rd_off(D0, 1, 1)>(vb);
  const s16x4 l2 = tr_read<v_rd_off(D0, 2, 0)>(vb), h2 = tr_read<v_rd_off(D0, 2, 1)>(vb), l3 = tr_read<v_rd_off(D0, 3, 0)>(vb), h3 = tr_read<v_rd_off(D0, 3, 1)>(vb);
  asm volatile("s_waitcnt lgkmcnt(0)" ::: "memory"); SBAR();
#define PK(L, H) (bf16x8){L[0], L[1], L[2], L[3], H[0], H[1], H[2], H[3]}
  od = __builtin_amdgcn_mfma_f32_32x32x16_bf16(pa0, PK(l0, h0), od, 0, 0, 0);
  od = __builtin_amdgcn_mfma_f32_32x32x16_bf16(pa1, PK(l1, h1), od, 0, 0, 0);
  od = __builtin_amdgcn_mfma_f32_32x32x16_bf16(pa2, PK(l2, h2), od, 0, 0, 0);
  od = __builtin_amdgcn_mfma_f32_32x32x16_bf16(pa3, PK(l3, h3), od, 0, 0, 0);
#undef PK
}
__device__ __forceinline__ void pv_d0(f32x16* o, int vb, bf16x8 pa0, bf16x8 pa1, bf16x8 pa2, bf16x8 pa3) {
  pv_one<0>(o[0], vb, pa0, pa1, pa2, pa3); pv_one<1>(o[1], vb, pa0, pa1, pa2, pa3); pv_one<2>(o[2], vb, pa0, pa1, pa2, pa3); pv_one<3>(o[3], vb, pa0, pa1, pa2, pa3);
}
template <int DK, bool NA, bool QL, int SD>
__device__ __forceinline__ void attn_body(const bf16* __restrict__ Qb, const bf16* __restrict__ Kh, const bf16* __restrict__ Vh, int NT, char* lds,
                                          float C, float thrRaw, f32x16 (&o)[4], int krow0, int q_row, int q_col, float inv_scale) {
  const int tid = opaque_tid(), wid = tid >> 6, lane = tid & 63, r32 = lane & 31, hi = lane >> 5;
  bf16* V_lds = (bf16*)lds; bf16* K_lds = (bf16*)(lds + 2 * SHM_V);
  float* ws = (float*)(lds + 2 * SHM_V + 2 * SHM_K) + wid * 64; float* li_l = ws; float* al_l = ws + 32;
  const float* rpb = (const float*)(lds + RPB_OFF);
  int win_r = q_row - 4; win_r = win_r < 0 ? 0 : (win_r > 56 ? 56 : win_r);
  int win_c = q_col - 8; win_c = win_c < 0 ? 0 : (win_c > 48 ? 48 : win_c);
  float m_reg = -1e30f, l_reg = 0; bf16x8 qr[QL ? 1 : DK / 16];
  char* ql = lds + Q_OFF + (wid * (DK / 16) * 64 + lane) * 16;
#pragma unroll
  for (int d = 0; d < 4; ++d) o[d] = f32x16{};
  const bf16* Qw = Qb + (long)(wid * 32 + r32) * LDP + hi * 8;
#pragma unroll
  for (int d0 = 0; d0 < DK / 16; ++d0) { const bf16x8 qv = *reinterpret_cast<const bf16x8*>(Qw + d0 * 16); if (QL) *reinterpret_cast<bf16x8*>(ql + d0 * 1024) = qv; else qr[d0] = qv; }
  const int sr = tid >> 4, sc = (tid & 15) * 8, vst0 = v_st(sr, sc), vst1 = v_st(32 + sr, sc);
  const int ksr = DK == 128 ? sr : (tid >> 3), ksc = DK == 128 ? sc : (tid & 7) * 8;
  const int vb0 = (int)(uintptr_t)V_lds + v_rd_base(lane);
  struct { bf16x8 vs0, vs1, ks0, ks1; } sr_[SD];
#define SLOAD(i, k0) do { sr_[i].vs0 = *reinterpret_cast<const bf16x8*>(&Vh[(long)((k0) + sr) * LDP + sc]); sr_[i].vs1 = *reinterpret_cast<const bf16x8*>(&Vh[(long)((k0) + 32 + sr) * LDP + sc]); \
    sr_[i].ks0 = *reinterpret_cast<const bf16x8*>(&Kh[(long)((k0) + ksr) * LDP + ksc]); if (DK == 128) sr_[i].ks1 = *reinterpret_cast<const bf16x8*>(&Kh[(long)((k0) + 32 + ksr) * LDP + ksc]); } while (0)
#define SWRITE(b, i) do { *(bf16x8*)((char*)V_lds + (b) * SHM_V + vst0) = sr_[i].vs0;          \
    *(bf16x8*)((char*)V_lds + (b) * SHM_V + vst1) = sr_[i].vs1; int kc = ksc * 2;               \
    *(bf16x8*)((char*)K_lds + (b) * SHM_K + kswz<DK>(ksr, kc)) = sr_[i].ks0;                       \
    if (DK == 128) *(bf16x8*)((char*)K_lds + (b) * SHM_K + kswz<DK>(32 + ksr, kc)) = sr_[i].ks1; } while (0)
#define SWAIT() do { if (SD == 1) asm volatile("s_waitcnt vmcnt(0)" ::: "memory"); else if (DK == 128) asm volatile("s_waitcnt vmcnt(4)" ::: "memory"); else asm volatile("s_waitcnt vmcnt(3)" ::: "memory"); } while (0)
#define RESC(a) do { if (__any((a) < 1.f)) { if (hi == 0) al_l[r32] = (a); asm volatile("s_waitcnt lgkmcnt(0)" ::: "memory"); \
    _Pragma("unroll") for (int d = 0; d < 4; ++d) _Pragma("unroll") for (int r = 0; r < 16; ++r) o[d][r] *= al_l[crow(r, hi)]; } } while (0)
#define HOOK(P0, P1, j) do { if (NA) na_hook(P0, P1, krow0 + (j), q_row, q_col, win_r, win_c, rpb, inv_scale, hi); } while (0)
  f32x16 pA0, pA1, pB0, pB1; float mnA, mnB, alA, alB; bf16x8 pa0, pa1, pa2, pa3;
  constexpr int SE = 0, SO = SD - 1;
  SLOAD(SE, 0); asm volatile("s_waitcnt vmcnt(0)" ::: "memory"); SWRITE(0, SE); __syncthreads();
  qkt<DK, QL>(pA0, pA1, K_lds, qr, ql, r32, hi); HOOK(pA0, pA1, 0); partialSM(pA0, pA1, m_reg, mnA, alA, C, thrRaw);
  SLOAD(SO, KVBLK); if (SD == 2) { if (2 < NT) SLOAD(SE, 2 * KVBLK); }
  SWAIT(); SWRITE(1, SO); __syncthreads();
  for (int j = 1; j + 1 < NT; j += 2) {
    SBAR(); qkt<DK, QL>(pB0, pB1, (bf16*)((char*)K_lds + SHM_K), qr, ql, r32, hi); HOOK(pB0, pB1, j);
    finishSM(pA0, pA1, alA, l_reg, pa0, pa1, pa2, pa3); SBAR();
    SLOAD(SO, (j + SD) * KVBLK); SBAR();
    pv_d0(o, vb0, pa0, pa1, pa2, pa3); partialSM(pB0, pB1, m_reg, mnB, alB, C, thrRaw);
    __syncthreads(); SWAIT(); SWRITE(0, SE);
    RESC(alB); __syncthreads();
    SBAR(); qkt<DK, QL>(pA0, pA1, K_lds, qr, ql, r32, hi); HOOK(pA0, pA1, j + 1);
    finishSM(pB0, pB1, alB, l_reg, pa0, pa1, pa2, pa3); SBAR();
    if (SD == 1 || j + 3 < NT) SLOAD(SE, (j + 1 + SD) * KVBLK); SBAR();
    pv_d0(o, vb0 + (int)SHM_V, pa0, pa1, pa2, pa3); partialSM(pA0, pA1, m_reg, mnA, alA, C, thrRaw);
    __syncthreads(); SWAIT(); SWRITE(1, SO);
    RESC(alA); __syncthreads();
  }
  SBAR(); qkt<DK, QL>(pB0, pB1, (bf16*)((char*)K_lds + SHM_K), qr, ql, r32, hi); HOOK(pB0, pB1, NT - 1);
  finishSM(pA0, pA1, alA, l_reg, pa0, pa1, pa2, pa3); SBAR();
  pv_d0(o, vb0, pa0, pa1, pa2, pa3); partialSM(pB0, pB1, m_reg, mnB, alB, C, thrRaw);
  __syncthreads(); RESC(alB);
  finishSM(pB0, pB1, alB, l_reg, pa0, pa1, pa2, pa3); SBAR();
  pv_d0(o, vb0 + (int)SHM_V, pa0, pa1, pa2, pa3);
  if (hi == 0) li_l[r32] = l_reg; asm volatile("s_waitcnt vmcnt(0) lgkmcnt(0)" ::: "memory");
#pragma unroll
  for (int r = 0; r < 16; ++r) { const float rl = __builtin_amdgcn_rcpf(li_l[crow(r, hi)]);
#pragma unroll
    for (int d = 0; d < 4; ++d) o[d][r] *= rl; }
#undef SLOAD
#undef SWRITE
#undef SWAIT
#undef RESC
#undef HOOK
}
#undef SBAR
}
#define GAS __attribute__((address_space(1)))
#define LAS __attribute__((address_space(3)))
typedef unsigned short bf16;
typedef unsigned v4u __attribute__((ext_vector_type(4)));
typedef unsigned v2u __attribute__((ext_vector_type(2)));
typedef float f32x4 __attribute__((ext_vector_type(4)));
typedef float f32x2 __attribute__((ext_vector_type(2)));
constexpr int NWAVES = 8, NTHR = 512;
constexpr int SEQ = 4096, M = 8192, DM = 2048, NIN = 5120, FF = 5632, DEPTH = 2, CC = 512;
constexpr float EPS = 1e-6f;
constexpr int PA_Q = 0, PA_K = 512, PA_V = 1024, PB_A = 1536, PB_G = 2048, PC_Q = 2560, PC_K = 3072, PC_V = 3328, PD_Q = 3584, PD_K = 4096, PD_V = 4608;
constexpr size_t MiB = 1u << 20;
constexpr size_t WS_ROPE = 1 * MiB;
constexpr size_t WS_WIN = 2 * MiB;
constexpr size_t WS_WOUT = WS_WIN + 40 * MiB;
constexpr size_t WS_WGU = WS_WOUT + 16 * MiB;
constexpr size_t WS_WDN = WS_WGU + 88 * MiB;
constexpr size_t WS_WPW = WS_WDN + 44 * MiB;
constexpr size_t WS_XN = WS_WPW + 1 * MiB;
constexpr size_t WS_PROJ = WS_XN + 32 * MiB;
constexpr size_t WS_CAT = WS_PROJ + 80 * MiB;
constexpr size_t WS_H = WS_PROJ;
constexpr size_t WS_MIX = WS_CAT + 32 * MiB;
constexpr size_t WS_CV = WS_MIX + 64 * MiB;
constexpr size_t WS_END = WS_CV + 8 * MiB;
constexpr int LDS_BYTES = 163840;

__device__ __forceinline__ unsigned f2bf(float f) { unsigned u = __builtin_bit_cast(unsigned, f); return (u + 0x7fffu + ((u >> 16) & 1u)) >> 16; }
__device__ __forceinline__ unsigned pk2(float lo, float hi) { return f2bf(lo) | (f2bf(hi) << 16); }
__device__ __forceinline__ float bf2f(unsigned short b) { return __builtin_bit_cast(float, (unsigned)b << 16); }
__device__ __forceinline__ float wave_sum(float v) {
#pragma unroll
    for (int o = 1; o < 64; o <<= 1) v += __shfl_xor(v, o);
    return v;
}
#define LDS_WAIT() asm volatile("s_waitcnt lgkmcnt(0)" ::: "memory")

#define XB_TMO      128
#define XB_XCNT(j)  (256  + 64 * (j))
#define XB_XSUB(j)  (1280 + 64 * (j))
#define XB_XGEN(j)  (2304 + 64 * (j))
#define XB_TOP      3328
#define XB_TOPGEN   3392
#define XCD_BAR_WORDS 3456
#define XB_SPIN_CAP (1u << 18)

__device__ __forceinline__ unsigned xb_ld(unsigned* p)              { return __hip_atomic_load(p, __ATOMIC_RELAXED, __HIP_MEMORY_SCOPE_AGENT); }
__device__ __forceinline__ unsigned xb_add(unsigned* p, unsigned v) { return __hip_atomic_fetch_add(p, v, __ATOMIC_RELAXED, __HIP_MEMORY_SCOPE_AGENT); }
__device__ __forceinline__ unsigned xb_xcc_id() { return (unsigned)__builtin_amdgcn_s_getreg((3 << 11) | 20) & 0xFu; }
#define XB_SPIN(cond, bar) do { unsigned _sp = 0; while (cond) { __builtin_amdgcn_s_sleep(1); \
    if ((++_sp & 255u) == 0u) { if (xb_ld(&(bar)[XB_TMO])) break; if (_sp > XB_SPIN_CAP) { atomicAdd(&(bar)[XB_TMO], 1u); break; } } } } while (0)

struct XcdBarrier {
    unsigned* bar; unsigned x;
    volatile LAS unsigned* st;
};

__device__ __forceinline__ XcdBarrier xcd_barrier_post(unsigned* bar, volatile LAS unsigned* st) {
    XcdBarrier b; b.bar = bar; b.x = xb_xcc_id(); b.st = st;
    if (threadIdx.x == 0) (void)xb_add(&bar[XB_XCNT(b.x)], 1u);
    return b;
}
__device__ __forceinline__ void xcd_barrier_complete(unsigned* bar, unsigned x, unsigned& nloc, unsigned& nx) {
    const unsigned G = gridDim.x * gridDim.y * gridDim.z;
    unsigned sum, cnt, mine, sp = 0u;
    for (;;) {
        sum = 0u; cnt = 0u; mine = 0u;
#pragma unroll
        for (unsigned j = 0; j < 16; ++j) { const unsigned c = xb_ld(&bar[XB_XCNT(j)]); sum += c; cnt += (c > 0u) ? 1u : 0u; mine = (j == x) ? c : mine; }
        if (sum == G) break;
        __builtin_amdgcn_s_sleep(1);
        if ((++sp & 255u) == 0u) { if (xb_ld(&bar[XB_TMO])) break; if (sp > XB_SPIN_CAP) { atomicAdd(&bar[XB_TMO], 1u); break; } }
    }
    nloc = mine > 0u ? mine : 1u; nx = cnt > 0u ? cnt : 1u;
}

__device__ __forceinline__ void xcd_barrier(const XcdBarrier& b) {
    asm volatile("s_waitcnt vmcnt(0)" ::: "memory");
    __syncthreads();
    if (threadIdx.x == 0) {
        unsigned* bar = b.bar;
        __builtin_amdgcn_s_waitcnt(0);
        unsigned nloc = b.st[0], nx = b.st[1];
        if (nloc == 0u) { xcd_barrier_complete(bar, b.x, nloc, nx); b.st[0] = nloc; b.st[1] = nx; }
        const unsigned old = xb_add(&bar[XB_XSUB(b.x)], 1u);
        const unsigned gen = old / nloc;
        if (old + 1u == (gen + 1u) * nloc) {
            __builtin_amdgcn_fence(__ATOMIC_RELEASE, "agent");
            asm volatile("s_waitcnt vmcnt(0)" ::: "memory");
            const unsigned og = xb_add(&bar[XB_TOP], 1u);
            const unsigned tg = og / nx;
            if (og + 1u == (tg + 1u) * nx) xb_add(&bar[XB_TOPGEN], 1u);
            else XB_SPIN(xb_ld(&bar[XB_TOPGEN]) == tg, bar);
            __builtin_amdgcn_fence(__ATOMIC_ACQUIRE, "agent");
            xb_add(&bar[XB_XGEN(b.x)], 1u);
            asm volatile("s_waitcnt vmcnt(0)" ::: "memory");
        } else {
            XB_SPIN(xb_ld(&bar[XB_XGEN(b.x)]) == gen, bar);
            __builtin_amdgcn_fence(__ATOMIC_ACQUIRE, "agent");
            asm volatile("s_waitcnt vmcnt(0)" ::: "memory");
        }
    }
    __syncthreads();
}

struct Params {
    const float* x; const float* norm_mix_pre; const float* norm_mix_post; const float* norm_ffn_pre; const float* norm_ffn_post;
    const float* w_in; const float* w_out; const float* diff_lambda; const float* diff_subln; const float* conv_dw; const float* conv_dw_b;
    const float* conv_ln_g; const float* conv_ln_b; const float* conv_pw; const float* conv_pw_b; const float* gqa_q_norm; const float* gqa_k_norm;
    const float* na_rpb; const float* ffn_gate; const float* ffn_up; const float* ffn_down;
    float* out; unsigned char* ws;
};

__device__ __forceinline__ void transpose_item(const float* __restrict__ W, int K, int N, bf16* WT, int k0, int n0, int dst_row0, LAS float* scr, int lane) {
    const int r = lane >> 3, q = lane & 7;
    f32x4 v[8];
#pragma unroll
    for (int i = 0; i < 8; ++i) v[i] = __builtin_nontemporal_load((const f32x4*)(W + (size_t)(k0 + 8 * i + r) * N + n0 + 4 * q));
#pragma unroll
    for (int i = 0; i < 8; ++i) { LAS float* d = scr + (8 * i + r) * 33 + 4 * q; d[0] = v[i].x; d[1] = v[i].y; d[2] = v[i].z; d[3] = v[i].w; }
    LDS_WAIT(); asm volatile("" ::: "memory");
    const int c = lane & 7;
#pragma unroll
    for (int j = 0; j < 4; ++j) { const int n = (lane >> 3) + 8 * j; const LAS float* s = scr + (8 * c) * 33 + n;
        v4u o; o.x = pk2(s[0 * 33], s[1 * 33]); o.y = pk2(s[2 * 33], s[3 * 33]); o.z = pk2(s[4 * 33], s[5 * 33]); o.w = pk2(s[6 * 33], s[7 * 33]);
        __builtin_nontemporal_store(o, (v4u*)(WT + (size_t)(dst_row0 + n) * K + k0 + 8 * c)); }
    LDS_WAIT(); asm volatile("" ::: "memory");
}
__device__ __forceinline__ void norm_row_bf16(const f32x4* v, const float* __restrict__ g, bf16* orow, int lane) {
    float s = 0.f;
#pragma unroll
    for (int j = 0; j < 8; ++j) s += (v[j].x * v[j].x + v[j].y * v[j].y) + (v[j].z * v[j].z + v[j].w * v[j].w);
    const float rstd = 1.0f / sqrtf(wave_sum(s) * (1.0f / DM) + EPS);
#pragma unroll
    for (int j = 0; j < 8; ++j) { const f32x4 gv = *(const f32x4*)(g + 4 * (lane + 64 * j));
        v2u o; o.x = pk2(v[j].x * rstd * gv.x, v[j].y * rstd * gv.y); o.y = pk2(v[j].z * rstd * gv.z, v[j].w * rstd * gv.w);
        *(v2u*)(orow + 4 * (lane + 64 * j)) = o; }
}
__device__ __forceinline__ void rows_update(const float* xin, const float* mix, const float* __restrict__ g_post, float* xout, const float* __restrict__ g_next, bf16* XN, int gw, int ngw, int lane) {
    for (int m = gw; m < M; m += ngw) {
        f32x4 a[8], v[8]; float s = 0.f;
#pragma unroll
        for (int j = 0; j < 8; ++j) { a[j] = *(const f32x4*)(mix + (size_t)m * DM + 4 * (lane + 64 * j)); v[j] = *(const f32x4*)(xin + (size_t)m * DM + 4 * (lane + 64 * j));
            s += (a[j].x * a[j].x + a[j].y * a[j].y) + (a[j].z * a[j].z + a[j].w * a[j].w); }
        const float rstd = 1.0f / sqrtf(wave_sum(s) * (1.0f / DM) + EPS);
#pragma unroll
        for (int j = 0; j < 8; ++j) { const f32x4 gv = *(const f32x4*)(g_post + 4 * (lane + 64 * j)); v[j] = v[j] + a[j] * rstd * gv;
            *(f32x4*)(xout + (size_t)m * DM + 4 * (lane + 64 * j)) = v[j]; }
        if (g_next) norm_row_bf16(v, g_next, XN + (size_t)m * DM, lane);
    }
}

constexpr int I_IN = 32 * 160, I_OUT = 32 * 64, I_G = 32 * 176, I_D = 88 * 64, I_PW = 8 * 16;
constexpr int I_LAYER = I_IN + I_OUT + 2 * I_G + I_D + I_PW;
constexpr int TAIL_ITEMS = 7168;
__device__ __forceinline__ void convert_item(const Params& p, unsigned char* ws, int l, int r, LAS float* scr, int lane) {
    bf16* WIN = (bf16*)(ws + WS_WIN); bf16* WOUT = (bf16*)(ws + WS_WOUT); bf16* WGU = (bf16*)(ws + WS_WGU); bf16* WDN = (bf16*)(ws + WS_WDN); bf16* WPW = (bf16*)(ws + WS_WPW);
    if (r < I_IN) { const int kb = r / 160, nb = r % 160, n0 = 32 * nb, tile = n0 >> 8, lc = n0 & 255; const bool rt = tile < 4 || (tile >= 10 && tile <= 12);
        transpose_item(p.w_in + (size_t)l * DM * NIN, DM, NIN, WIN + (size_t)l * NIN * DM, 64 * kb, n0, rt ? tile * 256 + 128 * ((lc >> 5) & 1) + 32 * (lc >> 6) : n0, scr, lane); return; } r -= I_IN;
    if (r < I_OUT) { const int kb = r / 64, nb = r % 64; transpose_item(p.w_out + (size_t)l * DM * DM, DM, DM, WOUT + (size_t)l * DM * DM, 64 * kb, 32 * nb, 32 * nb, scr, lane); return; } r -= I_OUT;
    if (r < I_G) { const int kb = r / 176, nb = r % 176, n0 = 32 * nb; transpose_item(p.ffn_gate + (size_t)l * DM * FF, DM, FF, WGU + (size_t)l * 2 * FF * DM, 64 * kb, n0, (n0 >> 7) * 256 + (n0 & 127), scr, lane); return; } r -= I_G;
    if (r < I_G) { const int kb = r / 176, nb = r % 176, n0 = 32 * nb; transpose_item(p.ffn_up + (size_t)l * DM * FF, DM, FF, WGU + (size_t)l * 2 * FF * DM, 64 * kb, n0, (n0 >> 7) * 256 + 128 + (n0 & 127), scr, lane); return; } r -= I_G;
    if (r < I_D) { const int kb = r / 64, nb = r % 64; transpose_item(p.ffn_down + (size_t)l * FF * DM, FF, DM, WDN + (size_t)l * DM * FF, 64 * kb, 32 * nb, 32 * nb, scr, lane); return; } r -= I_D;
    { const int kb = r / 16, nb = r % 16; transpose_item(p.conv_pw + (size_t)l * CC * CC, CC, CC, WPW + (size_t)l * CC * CC, 64 * kb, 32 * nb, 32 * nb, scr, lane); }
}
__device__ __forceinline__ void slot_item(int slot, int idx, int& l, int& r) {
    if (slot == 0) { l = 0; r = 5120 + idx; }
    else if (slot == 1) { if (idx < 5632) { l = 0; r = 18432 + idx; } else { l = 1; r = idx - 5632; } }
    else if (slot == 2) { l = 1; r = 7168 + idx; }
    else { l = 1; r = 18432 + idx; }
}
__device__ __forceinline__ void p0_item(int it, int& l, int& r) {
    if (it < 5120) { l = 0; r = it; return; } it -= 5120;
    if (it < 128) { l = 0; r = 24064 + it; return; } it -= 128;
    l = 1; r = 24064 + it;
}
constexpr int P0_ITEMS = 5376;
__device__ __forceinline__ void tail_convert(const Params& p, unsigned char* ws, int slot, PG8_LAS unsigned char* ldsl, int bx) {
    if (bx < 128) return;
    const int tid = opaque_tid(), lane = tid & 63, wave = __builtin_amdgcn_readfirstlane(tid >> 6);
    LAS float* scr = (LAS float*)(ldsl + wave * 16384);
    const int gwt = (bx - 128) * NWAVES + wave, count = slot == 0 ? 13312 : (slot == 1 ? 12800 : (slot == 2 ? 11264 : 5632));
    for (int it = gwt; it < count; it += 1024) { int l, r; slot_item(slot, it, l, r); convert_item(p, ws, l, r, scr, lane); }
}

__device__ __forceinline__ float wave_reduce32(const float (&v)[32], int lane) {
    float a[16], b[8], c[4], d[2], e;
    { const bool h = lane & 32;
#pragma unroll
      for (int t = 0; t < 16; ++t) { const float keep = h ? v[t + 16] : v[t], send = h ? v[t] : v[t + 16]; a[t] = keep + __shfl_xor(send, 32); } }
    { const bool h = lane & 16;
#pragma unroll
      for (int t = 0; t < 8; ++t) { const float keep = h ? a[t + 8] : a[t], send = h ? a[t] : a[t + 8]; b[t] = keep + __shfl_xor(send, 16); } }
    { const bool h = lane & 8;
#pragma unroll
      for (int t = 0; t < 4; ++t) { const float keep = h ? b[t + 4] : b[t], send = h ? b[t] : b[t + 4]; c[t] = keep + __shfl_xor(send, 8); } }
    { const bool h = lane & 4;
#pragma unroll
      for (int t = 0; t < 2; ++t) { const float keep = h ? c[t + 2] : c[t], send = h ? c[t] : c[t + 2]; d[t] = keep + __shfl_xor(send, 4); } }
    { const bool h = lane & 2; const float keep = h ? d[1] : d[0], send = h ? d[0] : d[1]; e = keep + __shfl_xor(send, 2); }
    e += __shfl_xor(e, 1);
    return e;
}
__device__ __forceinline__ void conv_tile(const Params& p, int l, int item, const bf16* PROJ, bf16* CV, LAS float* sl) {
    const int tid = opaque_tid(), lane = tid & 63, wave = __builtin_amdgcn_readfirstlane(tid >> 6), c = tid;
    const int m0 = item * 32, b = m0 / SEQ, s0 = m0 % SEQ;
    LAS float* part = sl; LAS float* stat = sl + 512;
    float u[62];
#pragma unroll
    for (int rr = 0; rr < 62; ++rr) { const int sq = s0 - 15 + rr; const bool ok = sq >= 0 && sq < SEQ; const bf16* pr = PROJ + (size_t)(b * SEQ + (ok ? sq : s0)) * NIN;
        const float a = bf2f(pr[PB_A + c]), g = bf2f(pr[PB_G + c]); u[rr] = ok ? a / (1.0f + __expf(-g)) : 0.f; }
    float w[31];
#pragma unroll
    for (int j = 0; j < 31; ++j) w[j] = p.conv_dw[(size_t)(l * 31 + j) * CC + c];
    const float bias = p.conv_dw_b[l * CC + c];
    float y[32], y2[32];
#pragma unroll
    for (int t = 0; t < 32; ++t) { float acc = bias;
#pragma unroll
        for (int j = 0; j < 31; ++j) acc = fmaf(u[t + j], w[j], acc);
        y[t] = acc; y2[t] = acc * acc; }
    const float r1 = wave_reduce32(y, lane), r2 = wave_reduce32(y2, lane);
    const int tl = 16 * ((lane >> 5) & 1) + 8 * ((lane >> 4) & 1) + 4 * ((lane >> 3) & 1) + 2 * ((lane >> 2) & 1) + ((lane >> 1) & 1);
    __syncthreads();
    if ((lane & 1) == 0) { part[(tl * 8 + wave) * 2] = r1; part[(tl * 8 + wave) * 2 + 1] = r2; }
    __syncthreads();
    if (tid < 32) { float S1 = 0.f, S2 = 0.f;
#pragma unroll
        for (int w8 = 0; w8 < 8; ++w8) { S1 += part[(tid * 8 + w8) * 2]; S2 += part[(tid * 8 + w8) * 2 + 1]; }
        const float mean = S1 * (1.0f / CC); float var = S2 * (1.0f / CC) - mean * mean; var = var < 0.f ? 0.f : var;
        stat[tid * 2] = mean; stat[tid * 2 + 1] = 1.0f / sqrtf(var + EPS); }
    __syncthreads();
    const float lg = p.conv_ln_g[l * CC + c], lb = p.conv_ln_b[l * CC + c];
#pragma unroll
    for (int t = 0; t < 32; ++t) { float v = (y[t] - stat[t * 2]) * stat[t * 2 + 1] * lg + lb; v = v / (1.0f + __expf(-v)); CV[(size_t)(m0 + t) * CC + c] = (bf16)f2bf(v); }
}
#ifndef QL64
#define QL64 false
#endif
#ifndef QL128
#define QL128 true
#endif
#ifndef SD64
#define SD64 2
#endif
#ifndef SD128
#define SD128 2
#endif
#ifndef SDNA
#define SDNA 1
#endif
#ifndef USE_CG_SYNC
#define USE_CG_SYNC 0
#endif
#define GSYNC() do { if (USE_CG_SYNC) grid.sync(); else xcd_barrier(xbar); } while (0)
#ifndef ROPE_PROBE
#define ROPE_PROBE 0
#endif
#ifndef REP_CONV
#define REP_CONV 1
#endif
#ifndef EXTRA_SYNC
#define EXTRA_SYNC 0
#endif
#ifndef REP_S3
#define REP_S3 1
#endif
#ifndef REP_GEMM
#define REP_GEMM 1
#endif
#ifndef REP_P0
#define REP_P0 1
#endif
#ifndef ON_DIFF
#define ON_DIFF 1
#endif
#ifndef ON_GQA
#define ON_GQA 1
#endif
#ifndef ON_NA
#define ON_NA 1
#endif
#ifndef ON_CONV
#define ON_CONV 1
#endif
#ifndef ON_ROPE
#define ON_ROPE 1
#endif
#ifndef ON_P0
#define ON_P0 1
#endif
#ifndef ON_GEMM
#define ON_GEMM 1
#endif
__device__ __forceinline__ void store_o_bf16(const att::f32x16 (&o)[4], bf16* base  , unsigned char* lds) {
    const int tid = opaque_tid(), lane = tid & 63, wave = __builtin_amdgcn_readfirstlane(tid >> 6), r32 = lane & 31, hi = lane >> 5;
    __syncthreads();
    float* T = (float*)(lds + wave * 16896);
#pragma unroll
    for (int r = 0; r < 16; ++r) { float* tp = T + att::crow(r, hi) * 132 + r32;
#pragma unroll
        for (int d = 0; d < 4; ++d) tp[32 * d] = o[d][r]; }
#pragma unroll
    for (int k = 0; k < 8; ++k) { const int chunk = k * 64 + lane, row = chunk >> 4, c8 = chunk & 15;
        const f32x4 a = *(const f32x4*)(T + row * 132 + c8 * 8), b = *(const f32x4*)(T + row * 132 + c8 * 8 + 4);
        v4u w; w.x = att::cvtpk(a.x, a.y); w.y = att::cvtpk(a.z, a.w); w.z = att::cvtpk(b.x, b.y); w.w = att::cvtpk(b.z, b.w);
        *(v4u*)(base + (size_t)(wave * 32 + row) * DM + c8 * 8) = w; }
}

__global__ void __launch_bounds__(NTHR) mega_fwd(Params p) {
    extern __shared__ __attribute__((aligned(16))) unsigned char lds[];
    cg::grid_group grid = cg::this_grid();
    const int G = gridDim.x, bx = blockIdx.x, ngw = G * NWAVES;
    unsigned char* ws = p.ws;
    bf16* WIN = (bf16*)(ws + WS_WIN); bf16* WOUT = (bf16*)(ws + WS_WOUT); bf16* WGU = (bf16*)(ws + WS_WGU); bf16* WDN = (bf16*)(ws + WS_WDN); bf16* WPW = (bf16*)(ws + WS_WPW);
    bf16* XN = (bf16*)(ws + WS_XN); bf16* PROJ = (bf16*)(ws + WS_PROJ); bf16* CAT = (bf16*)(ws + WS_CAT); bf16* HB = (bf16*)(ws + WS_H); bf16* CV = (bf16*)(ws + WS_CV);
    float* MIX = (float*)(ws + WS_MIX); unsigned long long* XSLOT = (unsigned long long*)(ws + WS_MIX + 48 * MiB); bf16* XB = (bf16*)(ws + WS_MIX + 16 * MiB);
    unsigned* CTL = (unsigned*)ws; f32x2* ROPE = (f32x2*)(ws + WS_ROPE);
    PG8_LAS unsigned char* ldsl = (PG8_LAS unsigned char*)lds;
    volatile LAS unsigned* bst = (volatile LAS unsigned*)(ldsl + LDS_BYTES - 16);
    if (threadIdx.x < 4) bst[threadIdx.x] = 0u;
    __syncthreads();
    const XcdBarrier xbar = xcd_barrier_post((unsigned*)ws, bst);

    for (int rp0 = 0; rp0 < REP_P0; ++rp0) {
        const int tid = opaque_tid(), lane = tid & 63, wave = __builtin_amdgcn_readfirstlane(tid >> 6), gw = bx * NWAVES + wave; (void)tid; (void)lane; (void)gw;
        LAS float* scr = (LAS float*)(ldsl + wave * 16384);
        for (int it = gw; it < ON_P0 * P0_ITEMS; it += ngw) { int cl, cr; p0_item(it, cl, cr); convert_item(p, ws, cl, cr, scr, lane); }
        for (int m = gw; m < M; m += ngw) { f32x4 v[8];
#pragma unroll
            for (int j = 0; j < 8; ++j) v[j] = __builtin_nontemporal_load((const f32x4*)(p.x + (size_t)m * DM + 4 * (lane + 64 * j)));
#pragma unroll
            for (int j = 0; j < 8; ++j) { v2u o; o.x = pk2(v[j].x, v[j].y); o.y = pk2(v[j].z, v[j].w); *(v2u*)(XB + (size_t)m * DM + 4 * (lane + 64 * j)) = o; }
            norm_row_bf16(v, p.norm_mix_pre, XN + (size_t)m * DM, lane); }
    }
    if (G != 256) grid.sync(); else GSYNC();
    for (int es = 0; es < EXTRA_SYNC; ++es) GSYNC();

    for (int l = 0; l < DEPTH; ++l) {
        _Pragma("unroll") for (int rg = 0; rg < REP_GEMM; ++rg) { pg8::Gemm g{XN, WIN + (size_t)l * NIN * DM, M, NIN, DM}; pg8::StaticOrder S; S.init(M, NIN, G, bx);
          pg8::EpiProj E{PROJ, NIN, (const float*)ROPE, p.gqa_q_norm + l * 128, p.gqa_k_norm + l * 128, (PG8_LAS float*)(ldsl + 131072)};
          pg8::gemm_phase<pg8::EpiProj, pg8::StaticOrder, true, true>(ldsl, g, S, E); }
        tail_convert(p, ws, l == 0 ? 0 : 2, ldsl, bx);
        GSYNC();

        for (int rep3 = 0; rep3 < REP_S3; ++rep3) {
            const int tid = opaque_tid(), lane = tid & 63, wave = __builtin_amdgcn_readfirstlane(tid >> 6), gw = bx * NWAVES + wave; (void)tid; (void)lane; (void)gw;
            const float lam_init = l == 0 ? 0.2f : 0.35550906759096934f;
            float lam; { const float* lp = p.diff_lambda + l * 256; const float sa = wave_sum(lp[lane] * lp[64 + lane]), sb = wave_sum(lp[128 + lane] * lp[192 + lane]); lam = expf(sa) - expf(sb) + lam_init; }
            constexpr float C64 = 0.125f * 1.4426950408889634f, THR64 = att::THR / 0.125f;
            constexpr float SC128 = 0.08838834764831845f, C128 = SC128 * 1.4426950408889634f, THR128 = att::THR / SC128;
            const int r32 = lane & 31, hi = lane >> 5;
            unsigned* ccnt = CTL + 32768 + l * 2048;
            if (ON_CONV && bx >= 128) {
                for (int ci = 0; ci < 2; ++ci) { const int item = 2 * (bx - 128) + ci;
                    conv_tile(p, l, item, PROJ, CV, (LAS float*)(ldsl + 131072));
                    asm volatile("s_waitcnt vmcnt(0)" ::: "memory"); __syncthreads();
                    if (tid == 0) { __builtin_amdgcn_fence(__ATOMIC_RELEASE, "agent"); asm volatile("s_waitcnt vmcnt(0)" ::: "memory"); __hip_atomic_fetch_add(ccnt + 64 * (item >> 3), 1u, __ATOMIC_RELAXED, __HIP_MEMORY_SCOPE_AGENT); } }
            }
            for (int round = 0;; ++round) {
                const int pc = (round & 1) ? (round + 1) * G - 1 - bx : round * G + bx;
                if (pc >= 384) break;
                const int kind = pc >> 7, xq = bx & 7, b = xq >> 2, h = xq & 3, qb = (bx & 127) >> 3;
                const size_t rowq = (size_t)b * SEQ + qb * 256, rowk = (size_t)b * SEQ;
                att::f32x16 o[4];
                __syncthreads();
                if (ON_DIFF && kind == 0) {
                    att::attn_body<64, false, QL64, SD64>(PROJ + rowq * NIN + PA_Q + h * 128, PROJ + rowk * NIN + PA_K + h * 128, PROJ + rowk * NIN + PA_V + h * 128, SEQ / 64, (char*)lds, C64, THR64, o, 0, 0, 0, 0.f);
                    { const int t2 = opaque_tid(); v4u* STv = (v4u*)((char*)lds + 69632) + t2;
#pragma unroll
                      for (int k = 0; k < 8; ++k) { const int d = k >> 1, r0 = 8 * (k & 1); v4u w;
                          w.x = att::cvtpk(o[d][r0], o[d][r0 + 1]); w.y = att::cvtpk(o[d][r0 + 2], o[d][r0 + 3]); w.z = att::cvtpk(o[d][r0 + 4], o[d][r0 + 5]); w.w = att::cvtpk(o[d][r0 + 6], o[d][r0 + 7]);
                          STv[k * 512] = w; } }
                    att::attn_body<64, false, QL64, SD64>(PROJ + rowq * NIN + PA_Q + h * 128 + 64, PROJ + rowk * NIN + PA_K + h * 128 + 64, PROJ + rowk * NIN + PA_V + h * 128, SEQ / 64, (char*)lds, C64, THR64, o, 0, 0, 0, 0.f);
                    { const int t3 = opaque_tid(), l3 = t3 & 63, r32 = l3 & 31; const v4u* STv = (const v4u*)((char*)lds + 69632) + t3;
                      const float* sg = p.diff_subln + l * 128;
                      float gsub[4], ss[16];
#pragma unroll
                      for (int d = 0; d < 4; ++d) gsub[d] = sg[32 * d + r32] * (1.0f - lam_init);
#pragma unroll
                      for (int r = 0; r < 16; ++r) ss[r] = 0.f;
#pragma unroll
                      for (int k = 0; k < 8; ++k) { const int d = k >> 1, r0 = 8 * (k & 1); const v4u w = STv[k * 512];
#pragma unroll
                          for (int i = 0; i < 4; ++i) { const unsigned wi = i == 0 ? w.x : (i == 1 ? w.y : (i == 2 ? w.z : w.w));
                              const float va = bf2f((unsigned short)(wi & 0xffffu)) - lam * o[d][r0 + 2 * i], vb = bf2f((unsigned short)(wi >> 16)) - lam * o[d][r0 + 2 * i + 1];
                              o[d][r0 + 2 * i] = va; o[d][r0 + 2 * i + 1] = vb; ss[r0 + 2 * i] += va * va; ss[r0 + 2 * i + 1] += vb * vb; } }
#pragma unroll
                      for (int r = 0; r < 16; ++r) { float q = ss[r]; q += __shfl_xor(q, 1); q += __shfl_xor(q, 2); q += __shfl_xor(q, 4); q += __shfl_xor(q, 8); q += __shfl_xor(q, 16);
                          const float rstd = 1.0f / sqrtf(q * (1.0f / 128.0f) + EPS);
#pragma unroll
                          for (int d = 0; d < 4; ++d) o[d][r] *= rstd * gsub[d]; } }
                    store_o_bf16(o, CAT + rowq * DM + h * 128, lds);
                } else if (ON_GQA && kind == 1) {
                    att::attn_body<128, false, QL128, SD128>(PROJ + rowq * NIN + PC_Q + h * 128, PROJ + rowk * NIN + PC_K + (h >> 1) * 128, PROJ + rowk * NIN + PC_V + (h >> 1) * 128, SEQ / 64, (char*)lds, C128, THR128, o, 0, 0, 0, 0.f);
                    store_o_bf16(o, CAT + rowq * DM + 1024 + h * 128, lds);
                } else if (ON_NA) {
                    { const float* rsrc = p.na_rpb + (size_t)(l * 4 + h) * 465; float* rdst = (float*)((char*)lds + att::RPB_OFF); for (int e = tid; e < 465; e += NTHR) rdst[e] = rsrc[e]; }
                    int krow0 = 4 * qb - 4; krow0 = krow0 < 0 ? 0 : (krow0 > 52 ? 52 : krow0);
                    const size_t rowkn = rowk + (size_t)krow0 * 64;
                    att::attn_body<128, true, QL128, SDNA>(PROJ + rowq * NIN + PD_Q + h * 128, PROJ + rowkn * NIN + PD_K + h * 128, PROJ + rowkn * NIN + PD_V + h * 128, 12, (char*)lds, C128, THR128, o,
                                              krow0, 4 * qb + (wave >> 1), (wave & 1) * 32 + r32, 11.313708498984761f);
                    store_o_bf16(o, CAT + rowq * DM + 1536 + h * 128, lds);
                }
            }
            __syncthreads();
            if (G - 1 - bx < 64) {
                if (tid == 0) { unsigned sp = 0; while (__hip_atomic_load(ccnt + 64 * ((G - 1 - bx) >> 1), __ATOMIC_RELAXED, __HIP_MEMORY_SCOPE_AGENT) < 8u) { __builtin_amdgcn_s_sleep(2); if (++sp > (1u << 24)) break; }
                    __builtin_amdgcn_fence(__ATOMIC_ACQUIRE, "agent"); asm volatile("s_waitcnt vmcnt(0)" ::: "memory"); }
                __syncthreads();
            }
            { pg8::Gemm g{CV, WPW + (size_t)l * CC * CC, M, CC, CC}; pg8::StrideOrder S{G - 1 - bx, G, 64, 2};
              pg8::EpiBf16<0> E{CAT + 512, DM, p.conv_pw_b + l * CC, 0, 0, 1.f};
              pg8::gemm_phase<pg8::EpiBf16<0>, pg8::StrideOrder, true, true>(ldsl, g, S, E); }
        }
        GSYNC();

        { pg8::Gemm g{CAT, WOUT + (size_t)l * DM * DM, M, DM, DM}; pg8::StaticOrder S; S.init(M, DM, G, bx);
          pg8::EpiRmsFused E{XB, nullptr, XB, XN, p.norm_mix_post + l * DM, p.norm_ffn_pre + l * DM, XSLOT + (size_t)(l * 2 + 0) * 131072, CTL + 16384 + (l * 2 + 0) * 2048};
          pg8::gemm_phase<pg8::EpiRmsFused, pg8::StaticOrder, false, true>(ldsl, g, S, E); }
        GSYNC();
        _Pragma("unroll") for (int rg = 0; rg < REP_GEMM; ++rg) { pg8::Gemm g{XN, WGU + (size_t)l * 2 * FF * DM, M, 2 * FF, DM}; pg8::StaticOrder S; S.init(M, 2 * FF, G, bx);
          pg8::EpiSwiGLU E{HB, FF};
          pg8::gemm_phase<pg8::EpiSwiGLU, pg8::StaticOrder, true, true>(ldsl, g, S, E); }
        tail_convert(p, ws, l == 0 ? 1 : 3, ldsl, bx);
        GSYNC();
        { pg8::Gemm g{HB, WDN + (size_t)l * DM * FF, M, DM, FF}; pg8::StaticOrder S; S.init(M, DM, G, bx);
          pg8::EpiRmsFused E{XB, l + 1 < DEPTH ? nullptr : p.out, XB, XN, p.norm_ffn_post + l * DM, l + 1 < DEPTH ? p.norm_mix_pre + (l + 1) * DM : nullptr, XSLOT + (size_t)(l * 2 + 1) * 131072, CTL + 16384 + (l * 2 + 1) * 2048};
          pg8::gemm_phase<pg8::EpiRmsFused, pg8::StaticOrder, false, true>(ldsl, g, S, E); }
        if (l + 1 < DEPTH) GSYNC();
    }
}

extern "C" void kernel_launch(void* const* d_in, const int* in_sizes, int n_in, void* d_out, int out_size, void* d_ws, size_t ws_size, hipStream_t stream) {
    static int grid = 0;
    if (grid == 0) {
        if (n_in != 21 || out_size != M * DM || ws_size < WS_END) { fprintf(stderr, "kernel_launch: unexpected shapes: n_in %d out %d ws %zu (need %zu)\n", n_in, out_size, ws_size, (size_t)WS_END); grid = -1; return; }
        int dev = 0, cus = 0, per_cu = 0;
        if (hipGetDevice(&dev) != hipSuccess || hipDeviceGetAttribute(&cus, hipDeviceAttributeMultiprocessorCount, dev) != hipSuccess) { fprintf(stderr, "kernel_launch: device query failed\n"); grid = -1; return; }
        if (hipFuncSetAttribute((const void*)mega_fwd, hipFuncAttributeMaxDynamicSharedMemorySize, LDS_BYTES) != hipSuccess) { fprintf(stderr, "kernel_launch: hipFuncSetAttribute failed\n"); grid = -1; return; }
        if (hipOccupancyMaxActiveBlocksPerMultiprocessor(&per_cu, (const void*)mega_fwd, NTHR, LDS_BYTES) != hipSuccess || per_cu < 1) { fprintf(stderr, "kernel_launch: occupancy query says %d\n", per_cu); (void)hipGetLastError(); per_cu = 1; }
        grid = cus * per_cu;
        if (grid < 256) { fprintf(stderr, "kernel_launch: needs 256 co-resident workgroups, device offers %d\n", grid); grid = -1; return; }
        grid = 256;
    }
    if (grid < 0) return;
    if (hipMemsetAsync(d_ws, 0, 196608, stream) != hipSuccess) { fprintf(stderr, "kernel_launch: memset failed\n"); return; }
    Params p{};
    const float** pp = (const float**)&p;
    for (int i = 0; i < 21; ++i) pp[i] = (const float*)d_in[i];
    p.out = (float*)d_out; p.ws = (unsigned char*)d_ws;
    void* args[] = {&p};
    hipError_t e = hipLaunchCooperativeKernel((const void*)mega_fwd, dim3(grid), dim3(NTHR), args, LDS_BYTES, stream);
    if (e != hipSuccess) fprintf(stderr, "cooperative launch failed: %s (grid %d)\n", hipGetErrorString(e), grid);
}
```

```cpp
#include <hip/hip_runtime.h>
#include <hip/hip_cooperative_groups.h>
#include <cstdio>
#include <cstdint>
namespace cg = cooperative_groups;
__device__ __forceinline__ int opaque_tid() { int t = threadIdx.x; asm volatile("" : "+v"(t)); return t; }
namespace pg8 {
#define PG8_LAS __attribute__((address_space(3)))
typedef unsigned short bf16_t;
typedef short bf16x8 __attribute__((ext_vector_type(8)));
typedef float f32x4 __attribute__((ext_vector_type(4)));
typedef unsigned u32x4 __attribute__((ext_vector_type(4)));
constexpr int BM = 256, BK = 64, HALF = 128, HTB = HALF * BK * 2  , STAGE_BYTES = 8 * HTB, NXCD = 8, WGM = 8;

__host__ __device__ __forceinline__ int lds_byte(int r, int c) { const int st = (r >> 4) * 2 + (c >> 5), rr = r & 15, cc = c & 31, ob = rr * 64 + cc * 2; return st * 1024 + (ob ^ (((ob >> 9) & 1) << 5)); }
__host__ __device__ __forceinline__ void stage_rc(int b, int& R, int& C) { const int st = b / 1024, sb = b % 1024, swz = sb ^ (((sb >> 9) & 1) << 5); R = (st >> 1) * 16 + swz / 64; C = (st & 1) * 32 + (swz % 64) / 2; }
__host__ __device__ __forceinline__ int perm32(int rho) { const int n = rho >> 4, i = rho & 15; return 8 * (i >> 2) + 4 * n + (i & 3); }

struct Unit { int pm, pn; };
struct Gemm { const bf16_t* A; const bf16_t* Bt; int M, N, K; };

struct StaticOrder {
    int nM, nN, nwg, G, c;
    __host__ __device__ void init(int M, int N, int G_, int c_) { nM = M / BM; nN = N / BM; nwg = nM * nN; G = G_; c = c_; }
    __host__ __device__ bool next(int i, Unit& u) const {
        const long L = (long)i * G + c; if (L >= nwg) return false;
        int wgid = (int)L; { const int q = nwg / NXCD, r = nwg % NXCD, xcd = wgid % NXCD, off = wgid / NXCD; wgid = (xcd < r ? xcd * (q + 1) : r * (q + 1) + (xcd - r) * q) + off; }
        const int nig = WGM * nN, gid = wgid / nig, fm = gid * WGM, gsz = (nM - fm) < WGM ? (nM - fm) : WGM;
        u.pm = fm + ((wgid % nig) % gsz); u.pn = (wgid % nig) / gsz; return true;
    }
    __device__ __forceinline__ void a_ready(const Unit&) const {}
    __device__ __forceinline__ void done(const Unit&) const {}
};

__device__ __forceinline__ unsigned cvt_pk_bf16(float lo, float hi) { unsigned r; asm volatile("v_cvt_pk_bf16_f32 %0, %1, %2" : "=v"(r) : "v"(lo), "v"(hi)); return r; }
typedef float f32x2 __attribute__((ext_vector_type(2)));
__device__ __forceinline__ f32x2 gelu_pk(f32x2 v) {
    const f32x2 av = __builtin_elementwise_abs(v), d = av * 0.2316418882f + 1.0f;
    f32x2 t; t.x = __builtin_amdgcn_rcpf(d.x); t.y = __builtin_amdgcn_rcpf(d.y);
    f32x2 q = t * 0.5307027145f + (-0.7265760135f); q = q * t + 0.7107068705f; q = q * t + (-0.142248368f); q = q * t + 0.127414796f; q = q * t;
    const f32x2 s = (v * v) * (-0.72134752044f);
    f32x2 e; e.x = __builtin_amdgcn_exp2f(s.x); e.y = __builtin_amdgcn_exp2f(s.y);
    const f32x2 m = v * (q * e), r = v - m;
    f32x2 o; o.x = v.x < 0.f ? m.x : r.x; o.y = v.y < 0.f ? m.y : r.y; return o;
}

template <int ACT  > struct EpiBf16 {
    static constexpr bool PERM = true, AFTER_DRAIN = false; static_assert(ACT == 0 || ACT == 1, "EpiBf16: ACT is 0 (none) or 1 (gelu_pk)");
    bf16_t* O; int ldc; const float* bias; int split_cols; size_t split_stride; float scale0;
    __device__ __forceinline__ void operator()(const f32x4 (&acc)[2][2][4][2], const Unit& u, int wr, int wc, int fr, int fq) const {
        const int row0 = u.pm * BM + wr * 64 + fr; int colt = u.pn * BM; bf16_t* base = O;
        float sc = 1.f; if (split_cols) { const int t = colt / split_cols; base += (size_t)t * split_stride; colt -= t * split_cols; if (t == 0) sc = scale0; }
        const int col0 = colt + wc * 32 + 8 * fq, bcol0 = u.pn * BM + wc * 32 + 8 * fq;
        f32x4 bv[2][2];
#pragma unroll
        for (int bj = 0; bj < 2; ++bj)
#pragma unroll
            for (int n = 0; n < 2; ++n) bv[bj][n] = bias ? *(const f32x4*)(bias + bcol0 + bj * HALF + 4 * n) : (f32x4){0.f, 0.f, 0.f, 0.f};
#pragma unroll
        for (int ai = 0; ai < 2; ++ai)
#pragma unroll
            for (int m = 0; m < 4; ++m) { bf16_t* rowp = base + (size_t)(row0 + ai * HALF + m * 16) * ldc + col0;
#pragma unroll
                for (int bj = 0; bj < 2; ++bj) { f32x4 v0 = acc[ai][bj][m][0] + bv[bj][0], v1 = acc[ai][bj][m][1] + bv[bj][1];
                    if (ACT == 1) { f32x2 a = gelu_pk((f32x2){v0[0], v0[1]}), b = gelu_pk((f32x2){v0[2], v0[3]}), c = gelu_pk((f32x2){v1[0], v1[1]}), d = gelu_pk((f32x2){v1[2], v1[3]});
                        v0 = (f32x4){a.x, a.y, b.x, b.y}; v1 = (f32x4){c.x, c.y, d.x, d.y}; }
                    v0 = v0 * sc; v1 = v1 * sc; u32x4 w; w.x = cvt_pk_bf16(v0[0], v0[1]); w.y = cvt_pk_bf16(v0[2], v0[3]); w.z = cvt_pk_bf16(v1[0], v1[1]); w.w = cvt_pk_bf16(v1[2], v1[3]);
                    *(u32x4*)(rowp + bj * HALF) = w; } }
    }
};
struct EpiF32 {
    static constexpr bool PERM = false, AFTER_DRAIN = false;
    float* O; int ldc;
    __device__ __forceinline__ void operator()(const f32x4 (&acc)[2][2][4][2], const Unit& u, int wr, int wc, int fr, int fq) const {
        const int row0 = u.pm * BM + wr * 64 + fr, col0 = u.pn * BM + wc * 32 + 4 * fq;
#pragma unroll
        for (int ai = 0; ai < 2; ++ai)
#pragma unroll
            for (int m = 0; m < 4; ++m) { float* rowp = O + (size_t)(row0 + ai * HALF + m * 16) * ldc + col0;
#pragma unroll
                for (int bj = 0; bj < 2; ++bj)
#pragma unroll
                    for (int n = 0; n < 2; ++n) *(f32x4*)(rowp + bj * HALF + n * 16) = acc[ai][bj][m][n]; }
    }
};
__device__ __forceinline__ float swiglu1(float g, float u) { return g * u * __builtin_amdgcn_rcpf(1.0f + __expf(-g)); }
struct EpiSwiGLU {
    static constexpr bool PERM = true, AFTER_DRAIN = false;
    bf16_t* O; int ldc;
    __device__ __forceinline__ void operator()(const f32x4 (&acc)[2][2][4][2], const Unit& u, int wr, int wc, int fr, int fq) const {
        const int row0 = u.pm * BM + wr * 64 + fr, col0 = u.pn * HALF + wc * 32 + 8 * fq;
#pragma unroll
        for (int ai = 0; ai < 2; ++ai)
#pragma unroll
            for (int m = 0; m < 4; ++m) { bf16_t* rowp = O + (size_t)(row0 + ai * HALF + m * 16) * ldc + col0;
                const f32x4 g0 = acc[ai][0][m][0], g1 = acc[ai][0][m][1], u0 = acc[ai][1][m][0], u1 = acc[ai][1][m][1];
                u32x4 w; w.x = cvt_pk_bf16(swiglu1(g0[0], u0[0]), swiglu1(g0[1], u0[1])); w.y = cvt_pk_bf16(swiglu1(g0[2], u0[2]), swiglu1(g0[3], u0[3]));
                w.z = cvt_pk_bf16(swiglu1(g1[0], u1[0]), swiglu1(g1[1], u1[1])); w.w = cvt_pk_bf16(swiglu1(g1[2], u1[2]), swiglu1(g1[3], u1[3]));
                *(u32x4*)rowp = w; }
    }
};

struct PanelSS {
    unsigned* xbuf;
    unsigned* cnt;
    float inv_n, eps;
    __device__ __forceinline__ void run(const f32x4 (&v)[2][2][4][2], const Unit& u, int wr, int wc, int fr, int fq, PG8_LAS unsigned char* lds, int wid, int lane) const {
        PG8_LAS float* P = (PG8_LAS float*)lds;
        PG8_LAS float* S = (PG8_LAS float*)(lds + 4096);
#pragma unroll
        for (int ai = 0; ai < 2; ++ai)
#pragma unroll
            for (int m = 0; m < 4; ++m) {
                float q = 0.f;
#pragma unroll
                for (int bj = 0; bj < 2; ++bj)
#pragma unroll
                    for (int n = 0; n < 2; ++n) { const f32x4 x = v[ai][bj][m][n]; q += (x[0] * x[0] + x[1] * x[1]) + (x[2] * x[2] + x[3] * x[3]); }
                q += __shfl_xor(q, 16); q += __shfl_xor(q, 32);
                if (fq == 0) P[(ai * HALF + wr * 64 + m * 16 + fr) * 4 + wc] = q;
            }
        asm volatile("s_waitcnt lgkmcnt(0)" ::: "memory"); __builtin_amdgcn_s_barrier(); asm volatile("" ::: "memory");
        const int row = wid * 32 + (lane & 31);
        unsigned* slot = xbuf + ((size_t)(u.pm * BM + row) * 8);
        if (lane < 32) { const float q = (P[row * 4 + 0] + P[row * 4 + 1]) + (P[row * 4 + 2] + P[row * 4 + 3]);
            __hip_atomic_store(slot + u.pn, __float_as_uint(q), __ATOMIC_RELAXED, __HIP_MEMORY_SCOPE_AGENT); }
        asm volatile("s_waitcnt vmcnt(0)" ::: "memory");
        if (lane == 0) __hip_atomic_fetch_add(cnt + 64 * u.pm, 1u, __ATOMIC_RELAXED, __HIP_MEMORY_SCOPE_AGENT);
        if (wid == 0) {
            unsigned sp = 0;
            while ((unsigned)__builtin_amdgcn_readfirstlane(__hip_atomic_load(cnt + 64 * u.pm, __ATOMIC_RELAXED, __HIP_MEMORY_SCOPE_AGENT)) < 64u) { __builtin_amdgcn_s_sleep(2); if (++sp > (1u << 22)) break; }
            __builtin_amdgcn_fence(__ATOMIC_ACQUIRE, "agent");
        }
        asm volatile("s_waitcnt vmcnt(0) lgkmcnt(0)" ::: "memory"); __builtin_amdgcn_s_barrier(); asm volatile("" ::: "memory");
        if (lane < 32) { float q = 0.f;
#pragma unroll
            for (int t = 0; t < 8; ++t) q += __uint_as_float(__hip_atomic_load(slot + t, __ATOMIC_RELAXED, __HIP_MEMORY_SCOPE_AGENT));
            S[row] = 1.0f / sqrtf(q * inv_n + eps); }
        asm volatile("s_waitcnt lgkmcnt(0)" ::: "memory"); __builtin_amdgcn_s_barrier(); asm volatile("" ::: "memory");
    }
};
struct EpiRmsResRms {
    static constexpr bool PERM = false, AFTER_DRAIN = true;
    const float* base; float* out; bf16_t* xn; int ldc; const float* g1; const float* g2; PanelSS st1, st2;
    __device__ __forceinline__ void operator()(const f32x4 (&)[2][2][4][2], const Unit&, int, int, int, int) const {}
    __device__ __forceinline__ void fused(f32x4 (&acc)[2][2][4][2], const Unit& u, int wr, int wc, int fr, int fq, PG8_LAS unsigned char* lds, int wid, int lane) const {
        typedef unsigned u32x2v __attribute__((ext_vector_type(2)));
        const PG8_LAS float* S = (const PG8_LAS float*)(lds + 4096);
        const int col0 = u.pn * BM + wc * 32 + 4 * fq;
        st1.run(acc, u, wr, wc, fr, fq, lds, wid, lane);
        {
            f32x4 gv[2][2];
#pragma unroll
            for (int bj = 0; bj < 2; ++bj)
#pragma unroll
                for (int n = 0; n < 2; ++n) gv[bj][n] = *(const f32x4*)(g1 + col0 + bj * HALF + n * 16);
#pragma unroll
            for (int ai = 0; ai < 2; ++ai)
#pragma unroll
                for (int m = 0; m < 4; ++m) { const int r = ai * HALF + wr * 64 + m * 16 + fr; const float sr = S[r]; const size_t off = (size_t)(u.pm * BM + r) * ldc + col0;
#pragma unroll
                    for (int bj = 0; bj < 2; ++bj)
#pragma unroll
                        for (int n = 0; n < 2; ++n) { const f32x4 bs = *(const f32x4*)(base + off + bj * HALF + n * 16); acc[ai][bj][m][n] = bs + acc[ai][bj][m][n] * sr * gv[bj][n]; }
                    asm volatile("" : "+v"(acc[ai][0][m][0]), "+v"(acc[ai][0][m][1]), "+v"(acc[ai][1][m][0]), "+v"(acc[ai][1][m][1]));
                    if (m & 1) asm volatile("" ::: "memory"); }
        }
        if (g2) {
            st2.run(acc, u, wr, wc, fr, fq, lds, wid, lane);
            f32x4 gv[2][2];
#pragma unroll
            for (int bj = 0; bj < 2; ++bj)
#pragma unroll
                for (int n = 0; n < 2; ++n) gv[bj][n] = *(const f32x4*)(g2 + col0 + bj * HALF + n * 16);
#pragma unroll
            for (int ai = 0; ai < 2; ++ai)
#pragma unroll
                for (int m = 0; m < 4; ++m) { const int r = ai * HALF + wr * 64 + m * 16 + fr; const float sr = S[r]; const size_t off = (size_t)(u.pm * BM + r) * ldc + col0;
#pragma unroll
                    for (int bj = 0; bj < 2; ++bj)
#pragma unroll
                        for (int n = 0; n < 2; ++n) { const f32x4 x1 = acc[ai][bj][m][n]; *(f32x4*)(out + off + bj * HALF + n * 16) = x1;
                            const f32x4 o = x1 * sr * gv[bj][n]; u32x2v w; w.x = cvt_pk_bf16(o[0], o[1]); w.y = cvt_pk_bf16(o[2], o[3]);
                            *(u32x2v*)(xn + off + bj * HALF + n * 16) = w; }
                    asm volatile("" ::: "memory"); }
        } else {
#pragma unroll
            for (int ai = 0; ai < 2; ++ai)
#pragma unroll
                for (int m = 0; m < 4; ++m) { const int r = ai * HALF + wr * 64 + m * 16 + fr; const size_t off = (size_t)(u.pm * BM + r) * ldc + col0;
#pragma unroll
                    for (int bj = 0; bj < 2; ++bj)
#pragma unroll
                        for (int n = 0; n < 2; ++n) *(f32x4*)(out + off + bj * HALF + n * 16) = acc[ai][bj][m][n]; }
        }
    }
};

__device__ __forceinline__ float bflo(unsigned w) { return __builtin_bit_cast(float, w << 16); }
__device__ __forceinline__ float bfhi(unsigned w) { return __builtin_bit_cast(float, w & 0xffff0000u); }
struct EpiRmsFused {
    static constexpr bool PERM = true, AFTER_DRAIN = true;
    const bf16_t* base_b;
    float* out_f; bf16_t* out_b;
    bf16_t* xn; const float* g1; const float* g2;
    unsigned long long* xbuf;
    unsigned* cnt;
    __device__ __forceinline__ void operator()(const f32x4 (&)[2][2][4][2], const Unit&, int, int, int, int) const {}
    __device__ __forceinline__ void fused(f32x4 (&acc)[2][2][4][2], const Unit& u, int wr, int wc, int fr, int fq, PG8_LAS unsigned char* lds, int wid, int lane) const {
        typedef unsigned u32x2v __attribute__((ext_vector_type(2)));
        constexpr int ldc = 2048; constexpr float inv_n = 1.0f / 2048.0f, eps = 1e-6f;
        PG8_LAS f32x4* P = (PG8_LAS f32x4*)(lds + 131072);
        PG8_LAS float* S = (PG8_LAS float*)(lds + 131072 + 16384);
        const int col0 = u.pn * BM + wc * 32 + 8 * fq;
        f32x4 gv[2][2];
#pragma unroll
        for (int bj = 0; bj < 2; ++bj)
#pragma unroll
            for (int n = 0; n < 2; ++n) gv[bj][n] = *(const f32x4*)(g1 + col0 + bj * HALF + n * 4);
        PG8_LAS u32x4* XL = (PG8_LAS u32x4*)lds + (wid * 64 + lane);
#pragma unroll
        for (int ai = 0; ai < 2; ++ai)
#pragma unroll
            for (int m = 0; m < 4; ++m) { const size_t off = (size_t)(u.pm * BM + ai * HALF + wr * 64 + m * 16 + fr) * ldc + col0;
#pragma unroll
                for (int bj = 0; bj < 2; ++bj) XL[((ai * 4 + m) * 2 + bj) * 512] = *(const u32x4*)(base_b + off + bj * HALF); }
#pragma unroll
        for (int ai = 0; ai < 2; ++ai)
#pragma unroll
            for (int m = 0; m < 4; ++m) {
                float saa = 0.f, sxx = 0.f, sxag = 0.f, sgg = 0.f;
#pragma unroll
                for (int bj = 0; bj < 2; ++bj) { const u32x4 w4 = XL[((ai * 4 + m) * 2 + bj) * 512];
#pragma unroll
                    for (int n = 0; n < 2; ++n) { const f32x4 a = acc[ai][bj][m][n]; const f32x4 ag = a * gv[bj][n]; const unsigned wx = n == 0 ? w4.x : w4.z, wy = n == 0 ? w4.y : w4.w;
                        const f32x4 x = (f32x4){bflo(wx), bfhi(wx), bflo(wy), bfhi(wy)};
                        saa += (a[0] * a[0] + a[1] * a[1]) + (a[2] * a[2] + a[3] * a[3]); sxx += (x[0] * x[0] + x[1] * x[1]) + (x[2] * x[2] + x[3] * x[3]);
                        sxag += (x[0] * ag[0] + x[1] * ag[1]) + (x[2] * ag[2] + x[3] * ag[3]); sgg += (ag[0] * ag[0] + ag[1] * ag[1]) + (ag[2] * ag[2] + ag[3] * ag[3]); } }
                asm volatile("" : "+v"(saa), "+v"(sxx), "+v"(sxag), "+v"(sgg));
                saa += __shfl_xor(saa, 16); sxx += __shfl_xor(sxx, 16); sxag += __shfl_xor(sxag, 16); sgg += __shfl_xor(sgg, 16);
                saa += __shfl_xor(saa, 32); sxx += __shfl_xor(sxx, 32); sxag += __shfl_xor(sxag, 32); sgg += __shfl_xor(sgg, 32);
                if (fq == 0) P[(ai * HALF + wr * 64 + m * 16 + fr) * 4 + wc] = (f32x4){saa, sxx, sxag, sgg};
                __builtin_amdgcn_sched_barrier(0);
            }
        asm volatile("s_waitcnt lgkmcnt(0)" ::: "memory"); __builtin_amdgcn_s_barrier(); asm volatile("" ::: "memory");
        const int row = wid * 32 + (lane & 31);
        unsigned long long* slot = xbuf + ((size_t)(u.pm * BM + row) * 8) * 2;
        if (lane < 32) { const f32x4 q = (P[row * 4 + 0] + P[row * 4 + 1]) + (P[row * 4 + 2] + P[row * 4 + 3]);
            __hip_atomic_store(slot + u.pn * 2, ((unsigned long long)__float_as_uint(q[1]) << 32) | __float_as_uint(q[0]), __ATOMIC_RELAXED, __HIP_MEMORY_SCOPE_AGENT);
            __hip_atomic_store(slot + u.pn * 2 + 1, ((unsigned long long)__float_as_uint(q[3]) << 32) | __float_as_uint(q[2]), __ATOMIC_RELAXED, __HIP_MEMORY_SCOPE_AGENT); }
        asm volatile("s_waitcnt vmcnt(0)" ::: "memory"); __builtin_amdgcn_s_barrier(); asm volatile("" ::: "memory");
        if (wid == 0) {
            if (lane == 0) __hip_atomic_fetch_add(cnt + 64 * u.pm, 1u, __ATOMIC_RELAXED, __HIP_MEMORY_SCOPE_AGENT);
            unsigned sp = 0;
            while ((unsigned)__builtin_amdgcn_readfirstlane(__hip_atomic_load(cnt + 64 * u.pm, __ATOMIC_RELAXED, __HIP_MEMORY_SCOPE_AGENT)) < 8u) { __builtin_amdgcn_s_sleep(1); if (++sp > (1u << 22)) break; }
            __builtin_amdgcn_fence(__ATOMIC_ACQUIRE, "agent");
        }
        asm volatile("s_waitcnt vmcnt(0) lgkmcnt(0)" ::: "memory"); __builtin_amdgcn_s_barrier(); asm volatile("" ::: "memory");
        if (lane < 32) { float saa = 0.f, sxx = 0.f, sxag = 0.f, sgg = 0.f;
#pragma unroll
            for (int t = 0; t < 8; ++t) { const unsigned long long w0 = __hip_atomic_load(slot + t * 2, __ATOMIC_RELAXED, __HIP_MEMORY_SCOPE_AGENT), w1 = __hip_atomic_load(slot + t * 2 + 1, __ATOMIC_RELAXED, __HIP_MEMORY_SCOPE_AGENT);
                saa += __uint_as_float((unsigned)w0); sxx += __uint_as_float((unsigned)(w0 >> 32)); sxag += __uint_as_float((unsigned)w1); sgg += __uint_as_float((unsigned)(w1 >> 32)); }
            const float r1 = 1.0f / sqrtf(saa * inv_n + eps);
            float s1 = sxx + 2.0f * r1 * sxag + r1 * r1 * sgg; s1 = s1 < 0.f ? 0.f : s1;
            S[row * 2] = r1; S[row * 2 + 1] = 1.0f / sqrtf(s1 * inv_n + eps); }
        asm volatile("s_waitcnt lgkmcnt(0)" ::: "memory"); __builtin_amdgcn_s_barrier(); asm volatile("" ::: "memory");
        int fr2 = fr, col2 = col0; asm volatile("" : "+v"(fr2), "+v"(col2));
        f32x4 g2v[2][2], g1v[2][2];
#pragma unroll
        for (int bj = 0; bj < 2; ++bj)
#pragma unroll
            for (int n = 0; n < 2; ++n) { g2v[bj][n] = g2 ? *(const f32x4*)(g2 + col2 + bj * HALF + n * 4) : (f32x4){0.f, 0.f, 0.f, 0.f}; g1v[bj][n] = *(const f32x4*)(g1 + col2 + bj * HALF + n * 4); }
#pragma unroll
        for (int ai = 0; ai < 2; ++ai)
#pragma unroll
            for (int m = 0; m < 4; ++m) { const int r = ai * HALF + wr * 64 + m * 16 + fr2; const float r1 = S[r * 2], r2 = S[r * 2 + 1]; const size_t off = (size_t)(u.pm * BM + r) * ldc + col2;
#pragma unroll
                for (int bj = 0; bj < 2; ++bj) { u32x4 w4 = XL[((ai * 4 + m) * 2 + bj) * 512]; asm volatile("" : "+v"(w4.x), "+v"(w4.y), "+v"(w4.z), "+v"(w4.w));
                    const f32x4 xa = (f32x4){bflo(w4.x), bfhi(w4.x), bflo(w4.y), bfhi(w4.y)}, xb = (f32x4){bflo(w4.z), bfhi(w4.z), bflo(w4.w), bfhi(w4.w)};
                    const f32x4 x1a = xa + acc[ai][bj][m][0] * r1 * g1v[bj][0], x1b = xb + acc[ai][bj][m][1] * r1 * g1v[bj][1];
                    if (out_f) { *(f32x4*)(out_f + off + bj * HALF) = x1a; *(f32x4*)(out_f + off + bj * HALF + 4) = x1b; }
                    else { u32x4 o; o.x = cvt_pk_bf16(x1a[0], x1a[1]); o.y = cvt_pk_bf16(x1a[2], x1a[3]); o.z = cvt_pk_bf16(x1b[0], x1b[1]); o.w = cvt_pk_bf16(x1b[2], x1b[3]); *(u32x4*)(out_b + off + bj * HALF) = o; }
                    if (g2) { const f32x4 ya = x1a * r2 * g2v[bj][0], yb = x1b * r2 * g2v[bj][1]; u32x4 o; o.x = cvt_pk_bf16(ya[0], ya[1]); o.y = cvt_pk_bf16(ya[2], ya[3]); o.z = cvt_pk_bf16(yb[0], yb[1]); o.w = cvt_pk_bf16(yb[2], yb[3]);
                        *(u32x4*)(xn + off + bj * HALF) = o; } }
                asm volatile("" ::: "memory"); __builtin_amdgcn_sched_barrier(0); }
    }
};

struct EpiProj {
    static constexpr bool PERM = true, AFTER_DRAIN = false;
    bf16_t* O; int ldc; const float* rope; const float* qn; const float* kn; PG8_LAS float* X;
    __device__ __forceinline__ void operator()(const f32x4 (&acc)[2][2][4][2], const Unit& u, int wr, int wc, int fr_, int fq_) const {
        int fr = fr_, fq = fq_; asm volatile("" : "+v"(fr), "+v"(fq));
        const int pn = u.pn, kind = pn < 4 ? 1 : ((pn >= 10 && pn <= 12) ? 2 : 0);
        if (kind == 0) {
            const int row0 = u.pm * BM + wr * 64 + fr, col0 = pn * BM + wc * 32 + 8 * fq;
#pragma unroll
            for (int ai = 0; ai < 2; ++ai)
#pragma unroll
                for (int m = 0; m < 4; ++m) { bf16_t* rowp = O + (size_t)(row0 + ai * HALF + m * 16) * ldc + col0;
#pragma unroll
                    for (int bj = 0; bj < 2; ++bj) { const f32x4 v0 = acc[ai][bj][m][0], v1 = acc[ai][bj][m][1];
                        u32x4 w; w.x = cvt_pk_bf16(v0[0], v0[1]); w.y = cvt_pk_bf16(v0[2], v0[3]); w.z = cvt_pk_bf16(v1[0], v1[1]); w.w = cvt_pk_bf16(v1[2], v1[3]);
                        *(u32x4*)(rowp + bj * HALF) = w; } }
            return;
        }
        const int i0 = 8 * fq, c1 = pn * BM + 64 * wc + i0;
        float frev[8];
#pragma unroll
        for (int k = 0; k < 8; ++k) { constexpr float FK[8] = {0.15915494309189535f, 0.11934937021124886f, 0.08949940160889104f, 0.06711508300522727f, 0.05032921210448705f, 0.037741584717419785f, 0.02830219583062341f, 0.02122365276477767f};
            frev[k] = FK[k] * (fq == 0 ? 1.0f : (fq == 1 ? 0.1f : (fq == 2 ? 0.01f : 0.001f))); }
        f32x4 ga[2], gb[2];
        if (kind == 2) { const float* gn = (pn == 12 ? kn : qn) + 64 * (wc & 1) + i0;
            ga[0] = *(const f32x4*)gn; ga[1] = *(const f32x4*)(gn + 4); gb[0] = *(const f32x4*)(gn + 32); gb[1] = *(const f32x4*)(gn + 36);
#pragma unroll
            for (int ai = 0; ai < 2; ++ai)
#pragma unroll
                for (int m = 0; m < 4; ++m) { float q = 0.f;
#pragma unroll
                    for (int bj = 0; bj < 2; ++bj)
#pragma unroll
                        for (int n = 0; n < 2; ++n) { const f32x4 x = acc[ai][bj][m][n]; q += (x[0] * x[0] + x[1] * x[1]) + (x[2] * x[2] + x[3] * x[3]); }
                    q += __shfl_xor(q, 16); q += __shfl_xor(q, 32);
                    if (fq == 0) X[(ai * HALF + wr * 64 + m * 16 + fr) * 4 + wc] = q; }
            asm volatile("s_waitcnt lgkmcnt(0)" ::: "memory"); __builtin_amdgcn_s_barrier(); asm volatile("" ::: "memory");
        } else { ga[0] = ga[1] = gb[0] = gb[1] = (f32x4){1.f, 1.f, 1.f, 1.f}; }
#pragma unroll
        for (int ai = 0; ai < 2; ++ai)
#pragma unroll
            for (int m = 0; m < 4; ++m) { const int r = ai * HALF + wr * 64 + m * 16 + fr, row = u.pm * BM + r, t = row & 4095;
                const int pos = kind == 1 ? t : ((wc & 1) ? (t & 63) : (t >> 6));
                const float fpos = (float)pos;
                float rs = 1.f;
                if (kind == 2) rs = 1.0f / sqrtf((X[r * 4 + wc] + X[r * 4 + (wc ^ 1)]) * (1.0f / 128.0f) + 1e-6f);
                u32x4 w1, w2;
#pragma unroll
                for (int n = 0; n < 2; ++n) {
                    f32x4 c, sn;
#pragma unroll
                    for (int j = 0; j < 4; ++j) { const float rev = __builtin_amdgcn_fractf(fpos * frev[4 * n + j]); c[j] = __builtin_amdgcn_cosf(rev); sn[j] = __builtin_amdgcn_sinf(rev); }
                    const f32x4 a = acc[ai][0][m][n] * rs * ga[n], b = acc[ai][1][m][n] * rs * gb[n];
                    const f32x4 o1 = a * c - b * sn, o2 = a * sn + b * c;
                    if (n == 0) { w1.x = cvt_pk_bf16(o1[0], o1[1]); w1.y = cvt_pk_bf16(o1[2], o1[3]); w2.x = cvt_pk_bf16(o2[0], o2[1]); w2.y = cvt_pk_bf16(o2[2], o2[3]); }
                    else { w1.z = cvt_pk_bf16(o1[0], o1[1]); w1.w = cvt_pk_bf16(o1[2], o1[3]); w2.z = cvt_pk_bf16(o2[0], o2[1]); w2.w = cvt_pk_bf16(o2[2], o2[3]); }
                }
                bf16_t* rowp = O + (size_t)row * ldc + c1;
                *(u32x4*)rowp = w1;
                *(u32x4*)(rowp + 32) = w2; __builtin_amdgcn_sched_barrier(0); }
    }
};
struct StrideOrder {
    int first, G, count, nN;
    __device__ bool next(int i, Unit& u) const { const int j = first + i * G; if (j >= count) return false; u.pm = j / nN; u.pn = j % nN; return true; }
    __device__ __forceinline__ void a_ready(const Unit&) const {}
    __device__ __forceinline__ void done(const Unit&) const {}
};
template <class Epi, class Sched, bool ALIGN_EPI = false, bool SP2 = false>
__device__ __forceinline__ void gemm_phase(PG8_LAS unsigned char* lds, const Gemm g, const Sched& S, const Epi& E) {
    const int tid = opaque_tid(), wid = __builtin_amdgcn_readfirstlane(tid >> 6), lane = tid & 63, wr = wid >> 2, wc = wid & 3, fr = lane & 15, fq = lane >> 4;
    const int K = g.K, nt = K / BK;
    unsigned voffA[2], voffB[2];
#pragma unroll
    for (int i = 0; i < 2; ++i) { int R, C; stage_rc(tid * 16 + i * 8192, R, C); const int Rb = Epi::PERM ? ((R & ~31) + perm32(R & 31)) : R;
        voffA[i] = (unsigned)(R * K + C) * 2u; voffB[i] = (unsigned)(Rb * K + C) * 2u; }
    const size_t kstep = (size_t)(BK * 2);
    const size_t hstep = (size_t)HALF * K * 2;
    const size_t tstep = 2 * hstep;
    const unsigned ldsw = (unsigned)wid * 1024u;
    const int aoff = lds_byte(wr * 64 + fr, fq * 8), boff = lds_byte(wc * 32 + fr, fq * 8);
#define PG8_SA(b, h) (((b) * 2 + (h)) * HTB)
#define PG8_SB(b, h) ((4 + (b) * 2 + (h)) * HTB)
#define PG8_STAGE(bufoff, gbase, voff) do { _Pragma("unroll") for (int _i = 0; _i < 2; ++_i) \
        __builtin_amdgcn_global_load_lds((const unsigned*)((const char*)(gbase) + (voff)[_i]), (PG8_LAS unsigned*)(lds + (bufoff) + ldsw + _i * 8192), 16, 0, 0); } while (0)
#define PG8_LDA(dst, b, h) do { _Pragma("unroll") for (int m = 0; m < 4; ++m) _Pragma("unroll") for (int k = 0; k < 2; ++k) dst[m][k] = *(const PG8_LAS bf16x8*)(lds + PG8_SA(b, h) + aoff + m * 2048 + k * 1024); } while (0)
#define PG8_LDB(dst, b, h) do { _Pragma("unroll") for (int n = 0; n < 2; ++n) _Pragma("unroll") for (int k = 0; k < 2; ++k) dst[n][k] = *(const PG8_LAS bf16x8*)(lds + PG8_SB(b, h) + boff + n * 2048 + k * 1024); } while (0)
#define PG8_MMA(ai, bj, At, Bt) do { __builtin_amdgcn_s_setprio(1); _Pragma("unroll") for (int m = 0; m < 4; ++m) _Pragma("unroll") for (int n = 0; n < 2; ++n) _Pragma("unroll") for (int k = 0; k < 2; ++k) \
        acc[ai][bj][m][n] = __builtin_amdgcn_mfma_f32_16x16x32_bf16(Bt[n][k], At[m][k], acc[ai][bj][m][n], 0, 0, 0); __builtin_amdgcn_s_setprio(0); } while (0)
#define PG8_WAIT_V(n) asm volatile("s_waitcnt vmcnt(" #n ")" ::: "memory")
#define PG8_WAIT_L(n) asm volatile("s_waitcnt lgkmcnt(" #n ")" ::: "memory")
#define PG8_BAR __builtin_amdgcn_s_barrier()
#define PG8_SCHED __builtin_amdgcn_sched_barrier(0)
    Unit cur, nxt; int ui = 0;
    if (!S.next(0, cur)) return;
    f32x4 acc[2][2][4][2];
#pragma unroll
    for (int a = 0; a < 2; ++a)
#pragma unroll
        for (int b = 0; b < 2; ++b)
#pragma unroll
            for (int m = 0; m < 4; ++m)
#pragma unroll
                for (int n = 0; n < 2; ++n) acc[a][b][m][n] = (f32x4){0.f, 0.f, 0.f, 0.f};
    bf16x8 At[4][2], B0[2][2], B1[2][2];
    const char* cA = (const char*)g.A + (size_t)cur.pm * tstep; const char* cB = (const char*)g.Bt + (size_t)cur.pn * tstep;
    S.a_ready(cur);
    if constexpr (SP2) {
        PG8_STAGE(PG8_SB(0, 0), cB, voffB); PG8_STAGE(PG8_SB(0, 1), cB + hstep, voffB); PG8_STAGE(PG8_SA(0, 0), cA, voffA); PG8_STAGE(PG8_SA(0, 1), cA + hstep, voffA);
        if (wr == 1) PG8_BAR;
        PG8_WAIT_V(2); PG8_BAR;
        PG8_STAGE(PG8_SB(1, 0), cB + kstep, voffB); PG8_STAGE(PG8_SA(1, 0), cA + kstep, voffA); PG8_STAGE(PG8_SB(1, 1), cB + hstep + kstep, voffB);
        PG8_WAIT_V(6); PG8_BAR;
    } else {
        PG8_STAGE(PG8_SB(0, 0), cB, voffB); PG8_STAGE(PG8_SA(0, 0), cA, voffA); PG8_STAGE(PG8_SB(0, 1), cB + hstep, voffB); PG8_STAGE(PG8_SA(0, 1), cA + hstep, voffA);
        if (wr == 1) PG8_BAR;
        PG8_WAIT_V(4); PG8_BAR;
        PG8_STAGE(PG8_SB(1, 0), cB + kstep, voffB); PG8_STAGE(PG8_SA(1, 0), cA + kstep, voffA); PG8_STAGE(PG8_SB(1, 1), cB + hstep + kstep, voffB);
        PG8_WAIT_V(6); PG8_BAR;
    }
    for (;;) {
        const bool has_next = S.next(ui + 1, nxt);
        const char* nA = has_next ? (const char*)g.A + (size_t)nxt.pm * tstep : cA; const char* nB = has_next ? (const char*)g.Bt + (size_t)nxt.pn * tstep : cB;
        for (int t = 0; t < nt; t += 2) {
            const bool last = (t == nt - 2);
            const char* a1 = cA + (size_t)(t + 1) * kstep;
            const char* a2 = last ? nA : cA + (size_t)(t + 2) * kstep; const char* b2 = last ? nB : cB + (size_t)(t + 2) * kstep;
            const char* a3 = a2 + kstep; const char* b3 = b2 + kstep;
            if (last && has_next) S.a_ready(nxt);
            if constexpr (SP2) {
            PG8_LDB(B0, 0, 0); PG8_LDB(B1, 0, 1); PG8_SCHED; PG8_LDA(At, 0, 0); PG8_STAGE(PG8_SA(1, 1), a1 + hstep, voffA);
            PG8_WAIT_V(8); PG8_WAIT_L(0); PG8_BAR; PG8_MMA(0, 0, At, B0); PG8_MMA(0, 1, At, B1); PG8_BAR; PG8_SCHED;
            PG8_LDA(At, 0, 1); PG8_STAGE(PG8_SB(0, 0), b2, voffB); PG8_STAGE(PG8_SB(0, 1), b2 + hstep, voffB); PG8_STAGE(PG8_SA(0, 0), a2, voffA);
            PG8_WAIT_V(8); PG8_WAIT_L(0); PG8_BAR; PG8_MMA(1, 0, At, B0); PG8_MMA(1, 1, At, B1); PG8_BAR; PG8_SCHED;
            PG8_LDB(B0, 1, 0); PG8_LDB(B1, 1, 1); PG8_SCHED; PG8_LDA(At, 1, 0); PG8_STAGE(PG8_SA(0, 1), a2 + hstep, voffA);
            PG8_WAIT_V(8); PG8_WAIT_L(0); PG8_BAR; PG8_MMA(0, 0, At, B0); PG8_MMA(0, 1, At, B1); PG8_BAR; PG8_SCHED;
            PG8_LDA(At, 1, 1); PG8_STAGE(PG8_SB(1, 0), b3, voffB); PG8_STAGE(PG8_SB(1, 1), b3 + hstep, voffB); PG8_STAGE(PG8_SA(1, 0), a3, voffA);
            PG8_WAIT_V(8); PG8_WAIT_L(0); PG8_BAR; PG8_MMA(1, 0, At, B0); PG8_MMA(1, 1, At, B1); PG8_BAR; PG8_SCHED;
            } else {
            PG8_LDB(B0, 0, 0); PG8_SCHED; PG8_LDA(At, 0, 0); PG8_STAGE(PG8_SA(1, 1), a1 + hstep, voffA);
            PG8_WAIT_L(8); PG8_BAR; PG8_WAIT_L(0); PG8_MMA(0, 0, At, B0); PG8_BAR; PG8_SCHED;
            PG8_LDB(B1, 0, 1); PG8_STAGE(PG8_SB(0, 0), b2, voffB);
            PG8_BAR; PG8_WAIT_L(0); PG8_MMA(0, 1, At, B1); PG8_BAR;
            PG8_LDA(At, 0, 1); PG8_STAGE(PG8_SA(0, 0), a2, voffA);
            PG8_BAR; PG8_WAIT_L(0); PG8_MMA(1, 0, At, B0); PG8_BAR; PG8_SCHED;
            PG8_STAGE(PG8_SB(0, 1), b2 + hstep, voffB);
            PG8_WAIT_V(6); PG8_BAR; PG8_MMA(1, 1, At, B1); PG8_BAR;
            PG8_LDB(B0, 1, 0); PG8_SCHED; PG8_LDA(At, 1, 0); PG8_STAGE(PG8_SA(0, 1), a2 + hstep, voffA);
            PG8_WAIT_L(8); PG8_BAR; PG8_WAIT_L(0); PG8_MMA(0, 0, At, B0); PG8_BAR; PG8_SCHED;
            PG8_LDB(B1, 1, 1); PG8_STAGE(PG8_SB(1, 0), b3, voffB);
            PG8_BAR; PG8_WAIT_L(0); PG8_MMA(0, 1, At, B1); PG8_BAR;
            PG8_LDA(At, 1, 1); PG8_STAGE(PG8_SA(1, 0), a3, voffA);
            PG8_BAR; PG8_WAIT_L(0); PG8_MMA(1, 0, At, B0); PG8_BAR; PG8_SCHED;
            PG8_STAGE(PG8_SB(1, 1), b3 + hstep, voffB);
            PG8_WAIT_V(6); PG8_BAR; PG8_MMA(1, 1, At, B1); PG8_BAR;
            }
        }
        if constexpr (ALIGN_EPI) { if (wr == 0) PG8_BAR; }
        if constexpr (!Epi::AFTER_DRAIN) { E(acc, cur, wr, wc, fr, fq); S.done(cur); }
        if (!has_next) break;
#pragma unroll
        for (int a = 0; a < 2; ++a)
#pragma unroll
            for (int b = 0; b < 2; ++b)
#pragma unroll
                for (int m = 0; m < 4; ++m)
#pragma unroll
                    for (int n = 0; n < 2; ++n) acc[a][b][m][n] = (f32x4){0.f, 0.f, 0.f, 0.f};
        cur = nxt; cA = nA; cB = nB; ++ui;
        if constexpr (ALIGN_EPI) { if (wr == 1) PG8_BAR; }
    }
    PG8_WAIT_V(0);
    if constexpr (!ALIGN_EPI) { if (wr == 0) PG8_BAR; }
    PG8_BAR;
    if constexpr (Epi::AFTER_DRAIN) { E.fused(acc, cur, wr, wc, fr, fq, lds, wid, lane); S.done(cur); }
#undef PG8_SA
#undef PG8_SB
#undef PG8_STAGE
#undef PG8_LDA
#undef PG8_LDB
#undef PG8_MMA
#undef PG8_WAIT_V
#undef PG8_WAIT_L
#undef PG8_BAR
#undef PG8_SCHED
}
}
namespace att {
using bf16 = unsigned short;
using bf16x8 = __attribute__((ext_vector_type(8))) short;
using s16x4  = __attribute__((ext_vector_type(4))) short;
using f32x16 = __attribute__((ext_vector_type(16))) float;
using u32x4  = __attribute__((ext_vector_type(4))) unsigned;
constexpr int KVBLK = 64, LDP = 5120;
constexpr float THR = 8.f;
constexpr int SHM_V = 16384, SHM_K = 16384, SHM_ATTN = 2 * SHM_V + 2 * SHM_K + 8 * 64 * 4;
constexpr int RPB_OFF = SHM_ATTN, Q_OFF = SHM_ATTN + 2048;
#define SBAR() __builtin_amdgcn_sched_barrier(0)
template <int DK> __device__ __forceinline__ int kswz(int row, int colB) { return DK == 128 ? row * 256 + (colB ^ ((row & 7) << 4)) : row * 128 + (colB ^ (((row >> 1) & 7) << 4)); }
__device__ __forceinline__ int crow(int r, int hi) { return (r & 3) + 8 * (r >> 2) + 4 * hi; }
__device__ __forceinline__ unsigned cvtpk(float lo, float hi) { unsigned r; asm volatile("v_cvt_pk_bf16_f32 %0, %1, %2" : "=v"(r) : "v"(lo), "v"(hi)); return r; }

__device__ __forceinline__ void partialSM(f32x16& p0, f32x16& p1, float& m_reg, float& mn, float& alpha, float C, float thrRaw) {
  float pmax = p0[0];
#pragma unroll
  for (int r = 1; r < 16; ++r) pmax = fmaxf(pmax, p0[r]);
#pragma unroll
  for (int r = 0; r < 16; ++r) pmax = fmaxf(pmax, p1[r]);
  { auto rr = __builtin_amdgcn_permlane32_swap(__float_as_uint(pmax), __float_as_uint(pmax), false, false);
    pmax = fmaxf(__uint_as_float(rr[0]), __uint_as_float(rr[1])); }
  if (__builtin_expect(__all(pmax - m_reg <= thrRaw), 1)) { mn = m_reg; alpha = 1.f; }
  else { mn = fmaxf(m_reg, pmax); alpha = __builtin_amdgcn_exp2f((m_reg - mn) * C); m_reg = mn; }
  float mnC = -mn * C;
#pragma unroll
  for (int r = 0; r < 16; ++r) p0[r] = fmaf(p0[r], C, mnC);
#pragma unroll
  for (int r = 0; r < 16; ++r) p1[r] = fmaf(p1[r], C, mnC);
#pragma unroll
  for (int r = 0; r < 16; ++r) p0[r] = __builtin_amdgcn_exp2f(p0[r]);
}
__device__ __forceinline__ void finishSM(f32x16& p0, f32x16& p1, float alpha, float& l_reg, bf16x8& pa0, bf16x8& pa1, bf16x8& pa2, bf16x8& pa3) {
#pragma unroll
  for (int r = 0; r < 16; ++r) p1[r] = __builtin_amdgcn_exp2f(p1[r]);
  float ps = 0;
#pragma unroll
  for (int r = 0; r < 16; ++r) ps += p0[r];
#pragma unroll
  for (int r = 0; r < 16; ++r) ps += p1[r];
  { auto rr = __builtin_amdgcn_permlane32_swap(__float_as_uint(ps), __float_as_uint(ps), false, false);
    ps = __uint_as_float(rr[0]) + __uint_as_float(rr[1]); }
  l_reg = l_reg * alpha + ps;
#define PK4(P, BASE, OUT) do { unsigned a0 = cvtpk(P[BASE + 0], P[BASE + 1]), a1 = cvtpk(P[BASE + 2], P[BASE + 3]);   \
    unsigned b0 = cvtpk(P[BASE + 4], P[BASE + 5]), b1 = cvtpk(P[BASE + 6], P[BASE + 7]);                              \
    auto r0 = __builtin_amdgcn_permlane32_swap(a0, b0, false, false); auto r1 = __builtin_amdgcn_permlane32_swap(a1, b1, false, false); \
    u32x4 w = {r0[0], r1[0], r0[1], r1[1]}; OUT = *reinterpret_cast<bf16x8*>(&w); } while (0)
  PK4(p0, 0, pa0); PK4(p0, 8, pa1); PK4(p1, 0, pa2); PK4(p1, 8, pa3);
#undef PK4
}
template <int DK, bool QL>
__device__ __forceinline__ void qkt(f32x16& p0, f32x16& p1, const bf16* Ks, const bf16x8* qr, const char* ql, int r32, int hi) {
  p0 = f32x16{}; p1 = f32x16{};
#pragma unroll
  for (int d0 = 0; d0 < DK / 16; ++d0) { int cb = (d0 * 16 + hi * 8) * 2;
    const bf16x8 qv = QL ? *reinterpret_cast<const bf16x8*>(ql + d0 * 1024) : qr[d0];
    bf16x8 b0 = *reinterpret_cast<const bf16x8*>((const char*)Ks + kswz<DK>(r32, cb));
    bf16x8 b1 = *reinterpret_cast<const bf16x8*>((const char*)Ks + kswz<DK>(32 + r32, cb));
    p0 = __builtin_amdgcn_mfma_f32_32x32x16_bf16(b0, qv, p0, 0, 0, 0);
    p1 = __builtin_amdgcn_mfma_f32_32x32x16_bf16(b1, qv, p1, 0, 0, 0); }
}
__device__ __forceinline__ void na_hook(f32x16& p0, f32x16& p1, int kr, int q_row, int q_col, int win_r, int win_c, const float* rpb, float inv_scale, int hi) {
  const bool rowok = (kr >= win_r) && (kr < win_r + 8);
  int ir = kr - q_row + 7; ir = ir < 0 ? 0 : (ir > 14 ? 14 : ir);
  const float* rp = rpb + ir * 31;
#pragma unroll
  for (int r = 0; r < 16; ++r) {
    const int kc = crow(r, hi);
    { const bool ok = rowok && kc >= win_c && kc < win_c + 16; int ic = kc - q_col + 15; ic = ic < 0 ? 0 : (ic > 30 ? 30 : ic);
      p0[r] = ok ? fmaf(rp[ic], inv_scale, p0[r]) : -1e30f; }
    { const int kc2 = kc + 32; const bool ok = rowok && kc2 >= win_c && kc2 < win_c + 16; int ic = kc2 - q_col + 15; ic = ic < 0 ? 0 : (ic > 30 ? 30 : ic);
      p1[r] = ok ? fmaf(rp[ic], inv_scale, p1[r]) : -1e30f; }
  }
}
__device__ __forceinline__ int v_st(int k, int c) { const int kk = (k & ~0xC) | ((k & 4) << 1) | ((k & 8) >> 1); return ((kk >> 3) * 4 + (c >> 5)) * 512 + ((kk & 7) * 32 + (c & 31)) * 2; }
__device__ __forceinline__ int v_rd_base(int lane) { return ((lane & 3) << 3) | (((lane >> 2) & 3) << 6) | (((lane >> 4) & 1) << 5) | (((lane >> 5) & 1) << 8); }
constexpr int v_rd_off(int d0, int ks, int half) { return d0 * 512 + ks * 4096 + half * 2048; }
template <int OFF> __device__ __forceinline__ s16x4 tr_read(int vb) {
  s16x4 r; asm volatile("ds_read_b64_tr_b16 %0, %1 offset:%2" : "=&v"(r) : "v"(vb), "i"(OFF) : "memory"); return r;
}
template <int D0> __device__ __forceinline__ void pv_one(f32x16& od, int vb, bf16x8 pa0, bf16x8 pa1, bf16x8 pa2, bf16x8 pa3) {
  const s16x4 l0 = tr_read<v_rd_off(D0, 0, 0)>(vb), h0 = tr_read<v_rd_off(D0, 0, 1)>(vb), l1 = tr_read<v_rd_off(D0, 1, 0)>(vb), h1 = tr_read<v_rd_off(D0, 1, 1)>(vb);
  const s16x4 l2 = tr_read<v_rd_off(D0, 2, 0)>(vb), h2 = tr_read<v_rd_off(D0, 2, 1)>(vb), l3 = tr_read<v_rd_off(D0, 3, 0)>(vb), h3 = tr_read<v_rd_off(D0, 3, 1)>(vb);
  asm volatile("s_waitcnt lgkmcnt(0)" ::: "memory"); SBAR();
#define PK(L, H) (bf16x8){L[0], L[1], L[2], L[3], H[0], H[1], H[2], H[3]}
  od = __builtin_amdgcn_mfma_f32_32x32x16_bf16(pa0, PK(l0, h0), od, 0, 0, 0);
  od = __builtin_amdgcn_mfma_f32_32x32x16_bf16(pa1, PK(l1, h1), od, 0, 0, 0);
  od = __builtin_amdgcn_mfma_f32_32x32x16_bf16(pa2, PK(l2, h2), od, 0, 0, 0);
  od = __builtin_amdgcn_mfma_f32_32x32x16_bf16(pa3, PK(l3, h3), od, 0, 0, 0);
#undef PK
}
__device__ __forceinline__ void pv_d0(f32x16* o, int vb, bf16x8 pa0, bf16x8 pa1, bf16x8 pa2, bf16x8 pa3) {
  pv_one<0>(o[0], vb, pa0, pa1, pa2, pa3); pv_one<1>(o[1], vb, pa0, pa1, pa2, pa3); pv_one<2>(o[2], vb, pa0, pa1, pa2, pa3); pv_one<3>(o[3], vb, pa0, pa1, pa2, pa3);
}
template <int DK, bool NA, bool QL, int SD>
__device__ __forceinline__ void attn_body(const bf16* __restrict__ Qb, const bf16* __restrict__ Kh, const bf16* __restrict__ Vh, int NT, char* lds,
                                          float C, float thrRaw, f32x16 (&o)[4], int krow0, int q_row, int q_col, float inv_scale) {
  const int tid = opaque_tid(), wid = tid >> 6, lane = tid & 63, r32 = lane & 31, hi = lane >> 5;
  bf16* V_lds = (bf16*)lds; bf16* K_lds = (bf16*)(lds + 2 * SHM_V);
  float* ws = (float*)(lds + 2 * SHM_V + 2 * SHM_K) + wid * 64; float* li_l = ws; float* al_l = ws + 32;
  const float* rpb = (const float*)(lds + RPB_OFF);
  int win_r = q_row - 4; win_r = win_r < 0 ? 0 : (win_r > 56 ? 56 : win_r);
  int win_c = q_col - 8; win_c = win_c < 0 ? 0 : (win_c > 48 ? 48 : win_c);
  float m_reg = -1e30f, l_reg = 0; bf16x8 qr[QL ? 1 : DK / 16];
  char* ql = lds + Q_OFF + (wid * (DK / 16) * 64 + lane) * 16;
#pragma unroll
  for (int d = 0; d < 4; ++d) o[d] = f32x16{};
  const bf16* Qw = Qb + (long)(wid * 32 + r32) * LDP + hi * 8;
#pragma unroll
  for (int d0 = 0; d0 < DK / 16; ++d0) { const bf16x8 qv = *reinterpret_cast<const bf16x8*>(Qw + d0 * 16); if (QL) *reinterpret_cast<bf16x8*>(ql + d0 * 1024) = qv; else qr[d0] = qv; }
  const int sr = tid >> 4, sc = (tid & 15) * 8, vst0 = v_st(sr, sc), vst1 = v_st(32 + sr, sc);
  const int ksr = DK == 128 ? sr : (tid >> 3), ksc = DK == 128 ? sc : (tid & 7) * 8;
  const int vb0 = (int)(uintptr_t)V_lds + v_rd_base(lane);
  struct { bf16x8 vs0, vs1, ks0, ks1; } sr_[SD];
#define SLOAD(i, k0) do { sr_[i].vs0 = *reinterpret_cast<const bf16x8*>(&Vh[(long)((k0) + sr) * LDP + sc]); sr_[i].vs1 = *reinterpret_cast<const bf16x8*>(&Vh[(long)((k0) + 32 + sr) * LDP + sc]); \
    sr_[i].ks0 = *reinterpret_cast<const bf16x8*>(&Kh[(long)((k0) + ksr) * LDP + ksc]); if (DK == 128) sr_[i].ks1 = *reinterpret_cast<const bf16x8*>(&Kh[(long)((k0) + 32 + ksr) * LDP + ksc]); } while (0)
#define SWRITE(b, i) do { *(bf16x8*)((char*)V_lds + (b) * SHM_V + vst0) = sr_[i].vs0;          \
    *(bf16x8*)((char*)V_lds + (b) * SHM_V + vst1) = sr_[i].vs1; int kc = ksc * 2;               \
    *(bf16x8*)((char*)K_lds + (b) * SHM_K + kswz<DK>(ksr, kc)) = sr_[i].ks0;                       \
    if (DK == 128) *(bf16x8*)((char*)K_lds + (b) * SHM_K + kswz<DK>(32 + ksr, kc)) = sr_[i].ks1; } while (0)
#define SWAIT() do { if (SD == 1) asm volatile("s_waitcnt vmcnt(0)" ::: "memory"); else if (DK == 128) asm volatile("s_waitcnt vmcnt(4)" ::: "memory"); else asm volatile("s_waitcnt vmcnt(3)" ::: "memory"); } while (0)
#define RESC(a) do { if (__any((a) < 1.f)) { if (hi == 0) al_l[r32] = (a); asm volatile("s_waitcnt lgkmcnt(0)" ::: "memory"); \
    _Pragma("unroll") for (int d = 0; d < 4; ++d) _Pragma("unroll") for (int r = 0; r < 16; ++r) o[d][r] *= al_l[crow(r, hi)]; } } while (0)
#define HOOK(P0, P1, j) do { if (NA) na_hook(P0, P1, krow0 + (j), q_row, q_col, win_r, win_c, rpb, inv_scale, hi); } while (0)
  f32x16 pA0, pA1, pB0, pB1; float mnA, mnB, alA, alB; bf16x8 pa0, pa1, pa2, pa3;
  constexpr int SE = 0, SO = SD - 1;
  SLOAD(SE, 0); asm volatile("s_waitcnt vmcnt(0)" ::: "memory"); SWRITE(0, SE); __syncthreads();
  qkt<DK, QL>(pA0, pA1, K_lds, qr, ql, r32, hi); HOOK(pA0, pA1, 0); partialSM(pA0, pA1, m_reg, mnA, alA, C, thrRaw);
  SLOAD(SO, KVBLK); if (SD == 2) { if (2 < NT) SLOAD(SE, 2 * KVBLK); }
  SWAIT(); SWRITE(1, SO); __syncthreads();
  for (int j = 1; j + 1 < NT; j += 2) {
    SBAR(); qkt<DK, QL>(pB0, pB1, (bf16*)((char*)K_lds + SHM_K), qr, ql, r32, hi); HOOK(pB0, pB1, j);
    finishSM(pA0, pA1, alA, l_reg, pa0, pa1, pa2, pa3); SBAR();
    SLOAD(SO, (j + SD) * KVBLK); SBAR();
    pv_d0(o, vb0, pa0, pa1, pa2, pa3); partialSM(pB0, pB1, m_reg, mnB, alB, C, thrRaw);
    __syncthreads(); SWAIT(); SWRITE(0, SE);
    RESC(alB); __syncthreads();
    SBAR(); qkt<DK, QL>(pA0, pA1, K_lds, qr, ql, r32, hi); HOOK(pA0, pA1, j + 1);
    finishSM(pB0, pB1, alB, l_reg, pa0, pa1, pa2, pa3); SBAR();
    if (SD == 1 || j + 3 < NT) SLOAD(SE, (j + 1 + SD) * KVBLK); SBAR();
    pv_d0(o, vb0 + (int)SHM_V, pa0, pa1, pa2, pa3); partialSM(pA0, pA1, m_reg, mnA, alA, C, thrRaw);
    __syncthreads(); SWAIT(); SWRITE(1, SO);
    RESC(alA); __syncthreads();
  }
  SBAR(); qkt<DK, QL>(pB0, pB1, (bf16*)((char*)K_lds + SHM_K), qr, ql, r32, hi); HOOK(pB0, pB1, NT - 1);
  finishSM(pA0, pA1, alA, l_reg, pa0, pa1, pa2, pa3); SBAR();
  pv_d0(o, vb0, pa0, pa1, pa2, pa3); partialSM(pB0, pB1, m_reg, mnB, alB, C, thrRaw);
  __syncthreads(); RESC(alB);
  finishSM(pB0, pB1, alB, l_reg, pa0, pa1, pa2, pa3); SBAR();
  pv_d0(o, vb0 + (int)SHM_V, pa0, pa1, pa2, pa3);
  if (hi == 0) li_l[r32] = l_reg; asm volatile("s_waitcnt vmcnt(0) lgkmcnt(0)" ::: "memory");
#pragma unroll
  for (int r = 0; r < 16; ++r) { const float rl = __builtin_amdgcn_rcpf(li_l[crow(r, hi)]);
#pragma unroll
    for (int d = 0; d < 4; ++d) o[d][r] *= rl; }
#undef SLOAD
#undef SWRITE
#undef SWAIT
#undef RESC
#undef HOOK
}
#undef SBAR
}
#define GAS __attribute__((address_space(1)))
#define LAS __attribute__((address_space(3)))
typedef unsigned short bf16;
typedef unsigned v4u __attribute__((ext_vector_type(4)));
typedef unsigned v2u __attribute__((ext_vector_type(2)));
typedef float f32x4 __attribute__((ext_vector_type(4)));
typedef float f32x2 __attribute__((ext_vector_type(2)));
constexpr int NWAVES = 8, NTHR = 512;
constexpr int SEQ = 4096, M = 8192, DM = 2048, NIN = 5120, FF = 5632, DEPTH = 2, CC = 512;
constexpr float EPS = 1e-6f;
constexpr int PA_Q = 0, PA_K = 512, PA_V = 1024, PB_A = 1536, PB_G = 2048, PC_Q = 2560, PC_K = 3072, PC_V = 3328, PD_Q = 3584, PD_K = 4096, PD_V = 4608;
constexpr size_t MiB = 1u << 20;
constexpr size_t WS_ROPE = 1 * MiB;
constexpr size_t WS_WIN = 2 * MiB;
constexpr size_t WS_WOUT = WS_WIN + 40 * MiB;
constexpr size_t WS_WGU = WS_WOUT + 16 * MiB;
constexpr size_t WS_WDN = WS_WGU + 88 * MiB;
constexpr size_t WS_WPW = WS_WDN + 44 * MiB;
constexpr size_t WS_XN = WS_WPW + 1 * MiB;
constexpr size_t WS_PROJ = WS_XN + 32 * MiB;
constexpr size_t WS_CAT = WS_PROJ + 80 * MiB;
constexpr size_t WS_H = WS_PROJ;
constexpr size_t WS_MIX = WS_CAT + 32 * MiB;
constexpr size_t WS_CV = WS_MIX + 64 * MiB;
constexpr size_t WS_END = WS_CV + 8 * MiB;
constexpr int LDS_BYTES = 163840;

__device__ __forceinline__ unsigned f2bf(float f) { unsigned u = __builtin_bit_cast(unsigned, f); return (u + 0x7fffu + ((u >> 16) & 1u)) >> 16; }
__device__ __forceinline__ unsigned pk2(float lo, float hi) { return f2bf(lo) | (f2bf(hi) << 16); }
__device__ __forceinline__ float bf2f(unsigned short b) { return __builtin_bit_cast(float, (unsigned)b << 16); }
__device__ __forceinline__ float wave_sum(float v) {
#pragma unroll
    for (int o = 1; o < 64; o <<= 1) v += __shfl_xor(v, o);
    return v;
}
#define LDS_WAIT() asm volatile("s_waitcnt lgkmcnt(0)" ::: "memory")

#define XB_TMO      128
#define XB_XCNT(j)  (256  + 64 * (j))
#define XB_XSUB(j)  (1280 + 64 * (j))
#define XB_XGEN(j)  (2304 + 64 * (j))
#define XB_TOP      3328
#define XB_TOPGEN   3392
#define XCD_BAR_WORDS 3456
#define XB_SPIN_CAP (1u << 18)

__device__ __forceinline__ unsigned xb_ld(unsigned* p)              { return __hip_atomic_load(p, __ATOMIC_RELAXED, __HIP_MEMORY_SCOPE_AGENT); }
__device__ __forceinline__ unsigned xb_add(unsigned* p, unsigned v) { return __hip_atomic_fetch_add(p, v, __ATOMIC_RELAXED, __HIP_MEMORY_SCOPE_AGENT); }
__device__ __forceinline__ unsigned xb_xcc_id() { return (unsigned)__builtin_amdgcn_s_getreg((3 << 11) | 20) & 0xFu; }
#define XB_SPIN(cond, bar) do { unsigned _sp = 0; while (cond) { __builtin_amdgcn_s_sleep(1); \
    if ((++_sp & 255u) == 0u) { if (xb_ld(&(bar)[XB_TMO])) break; if (_sp > XB_SPIN_CAP) { atomicAdd(&(bar)[XB_TMO], 1u); break; } } } } while (0)

struct XcdBarrier {
    unsigned* bar; unsigned x;
    volatile LAS unsigned* st;
};

__device__ __forceinline__ XcdBarrier xcd_barrier_post(unsigned* bar, volatile LAS unsigned* st) {
    XcdBarrier b; b.bar = bar; b.x = xb_xcc_id(); b.st = st;
    if (threadIdx.x == 0) (void)xb_add(&bar[XB_XCNT(b.x)], 1u);
    return b;
}
__device__ __forceinline__ void xcd_barrier_complete(unsigned* bar, unsigned x, unsigned& nloc, unsigned& nx) {
    const unsigned G = gridDim.x * gridDim.y * gridDim.z;
    unsigned sum, cnt, mine, sp = 0u;
    for (;;) {
        sum = 0u; cnt = 0u; mine = 0u;
#pragma unroll
        for (unsigned j = 0; j < 16; ++j) { const unsigned c = xb_ld(&bar[XB_XCNT(j)]); sum += c; cnt += (c > 0u) ? 1u : 0u; mine = (j == x) ? c : mine; }
        if (sum == G) break;
        __builtin_amdgcn_s_sleep(1);
        if ((++sp & 255u) == 0u) { if (xb_ld(&bar[XB_TMO])) break; if (sp > XB_SPIN_CAP) { atomicAdd(&bar[XB_TMO], 1u); break; } }
    }
    nloc = mine > 0u ? mine : 1u; nx = cnt > 0u ? cnt : 1u;
}

__device__ __forceinline__ void xcd_barrier(const XcdBarrier& b) {
    asm volatile("s_waitcnt vmcnt(0)" ::: "memory");
    __syncthreads();
    if (threadIdx.x == 0) {
        unsigned* bar = b.bar;
        __builtin_amdgcn_s_waitcnt(0);
        unsigned nloc = b.st[0], nx = b.st[1];
        if (nloc == 0u) { xcd_barrier_complete(bar, b.x, nloc, nx); b.st[0] = nloc; b.st[1] = nx; }
        const unsigned old = xb_add(&bar[XB_XSUB(b.x)], 1u);
        const unsigned gen = old / nloc;
        if (old + 1u == (gen + 1u) * nloc) {
            __builtin_amdgcn_fence(__ATOMIC_RELEASE, "agent");
            asm volatile("s_waitcnt vmcnt(0)" ::: "memory");
            const unsigned og = xb_add(&bar[XB_TOP], 1u);
            const unsigned tg = og / nx;
            if (og + 1u == (tg + 1u) * nx) xb_add(&bar[XB_TOPGEN], 1u);
            else XB_SPIN(xb_ld(&bar[XB_TOPGEN]) == tg, bar);
            __builtin_amdgcn_fence(__ATOMIC_ACQUIRE, "agent");
            xb_add(&bar[XB_XGEN(b.x)], 1u);
            asm volatile("s_waitcnt vmcnt(0)" ::: "memory");
        } else {
            XB_SPIN(xb_ld(&bar[XB_XGEN(b.x)]) == gen, bar);
            __builtin_amdgcn_fence(__ATOMIC_ACQUIRE, "agent");
            asm volatile("s_waitcnt vmcnt(0)" ::: "memory");
        }
    }
    __syncthreads();
}

struct Params {
    const float* x; const float* norm_mix_pre; const float* norm_mix_post; const float* norm_ffn_pre; const float* norm_ffn_post;
    const float* w_in; const float* w_out; const float* diff_lambda; const float* diff_subln; const float* conv_dw; const float* conv_dw_b;
    const float* conv_ln_g; const float* conv_ln_b; const float* conv_pw; const float* conv_pw_b; const float* gqa_q_norm; const float* gqa_k_norm;
    const float* na_rpb; const float* ffn_gate; const float* ffn_up; const float* ffn_down;
    float* out; unsigned char* ws;
};

__device__ __forceinline__ void transpose_item(const float* __restrict__ W, int K, int N, bf16* WT, int k0, int n0, int dst_row0, LAS float* scr, int lane) {
    const int r = lane >> 3, q = lane & 7;
    f32x4 v[8];
#pragma unroll
    for (int i = 0; i < 8; ++i) v[i] = __builtin_nontemporal_load((const f32x4*)(W + (size_t)(k0 + 8 * i + r) * N + n0 + 4 * q));
#pragma unroll
    for (int i = 0; i < 8; ++i) { LAS float* d = scr + (8 * i + r) * 33 + 4 * q; d[0] = v[i].x; d[1] = v[i].y; d[2] = v[i].z; d[3] = v[i].w; }
    LDS_WAIT(); asm volatile("" ::: "memory");
    const int c = lane & 7;
#pragma unroll
    for (int j = 0; j < 4; ++j) { const int n = (lane >> 3) + 8 * j; const LAS float* s = scr + (8 * c) * 33 + n;
        v4u o; o.x = pk2(s[0 * 33], s[1 * 33]); o.y = pk2(s[2 * 33], s[3 * 33]); o.z = pk2(s[4 * 33], s[5 * 33]); o.w = pk2(s[6 * 33], s[7 * 33]);
        __builtin_nontemporal_store(o, (v4u*)(WT + (size_t)(dst_row0 + n) * K + k0 + 8 * c)); }
    LDS_WAIT(); asm volatile("" ::: "memory");
}
__device__ __forceinline__ void norm_row_bf16(const f32x4* v, const float* __restrict__ g, bf16* orow, int lane) {
    float s = 0.f;
#pragma unroll
    for (int j = 0; j < 8; ++j) s += (v[j].x * v[j].x + v[j].y * v[j].y) + (v[j].z * v[j].z + v[j].w * v[j].w);
    const float rstd = 1.0f / sqrtf(wave_sum(s) * (1.0f / DM) + EPS);
#pragma unroll
    for (int j = 0; j < 8; ++j) { const f32x4 gv = *(const f32x4*)(g + 4 * (lane + 64 * j));
        v2u o; o.x = pk2(v[j].x * rstd * gv.x, v[j].y * rstd * gv.y); o.y = pk2(v[j].z * rstd * gv.z, v[j].w * rstd * gv.w);
        *(v2u*)(orow + 4 * (lane + 64 * j)) = o; }
}
__device__ __forceinline__ void rows_update(const float* xin, const float* mix, const float* __restrict__ g_post, float* xout, const float* __restrict__ g_next, bf16* XN, int gw, int ngw, int lane) {
    for (int m = gw; m < M; m += ngw) {
        f32x4 a[8], v[8]; float s = 0.f;
#pragma unroll
        for (int j = 0; j < 8; ++j) { a[j] = *(const f32x4*)(mix + (size_t)m * DM + 4 * (lane + 64 * j)); v[j] = *(const f32x4*)(xin + (size_t)m * DM + 4 * (lane + 64 * j));
            s += (a[j].x * a[j].x + a[j].y * a[j].y) + (a[j].z * a[j].z + a[j].w * a[j].w); }
        const float rstd = 1.0f / sqrtf(wave_sum(s) * (1.0f / DM) + EPS);
#pragma unroll
        for (int j = 0; j < 8; ++j) { const f32x4 gv = *(const f32x4*)(g_post + 4 * (lane + 64 * j)); v[j] = v[j] + a[j] * rstd * gv;
            *(f32x4*)(xout + (size_t)m * DM + 4 * (lane + 64 * j)) = v[j]; }
        if (g_next) norm_row_bf16(v, g_next, XN + (size_t)m * DM, lane);
    }
}

constexpr int I_IN = 32 * 160, I_OUT = 32 * 64, I_G = 32 * 176, I_D = 88 * 64, I_PW = 8 * 16;
constexpr int I_LAYER = I_IN + I_OUT + 2 * I_G + I_D + I_PW;
constexpr int TAIL_ITEMS = 7168;
__device__ __forceinline__ void convert_item(const Params& p, unsigned char* ws, int l, int r, LAS float* scr, int lane) {
    bf16* WIN = (bf16*)(ws + WS_WIN); bf16* WOUT = (bf16*)(ws + WS_WOUT); bf16* WGU = (bf16*)(ws + WS_WGU); bf16* WDN = (bf16*)(ws + WS_WDN); bf16* WPW = (bf16*)(ws + WS_WPW);
    if (r < I_IN) { const int kb = r / 160, nb = r % 160, n0 = 32 * nb, tile = n0 >> 8, lc = n0 & 255; const bool rt = tile < 4 || (tile >= 10 && tile <= 12);
        transpose_item(p.w_in + (size_t)l * DM * NIN, DM, NIN, WIN + (size_t)l * NIN * DM, 64 * kb, n0, rt ? tile * 256 + 128 * ((lc >> 5) & 1) + 32 * (lc >> 6) : n0, scr, lane); return; } r -= I_IN;
    if (r < I_OUT) { const int kb = r / 64, nb = r % 64; transpose_item(p.w_out + (size_t)l * DM * DM, DM, DM, WOUT + (size_t)l * DM * DM, 64 * kb, 32 * nb, 32 * nb, scr, lane); return; } r -= I_OUT;
    if (r < I_G) { const int kb = r / 176, nb = r % 176, n0 = 32 * nb; transpose_item(p.ffn_gate + (size_t)l * DM * FF, DM, FF, WGU + (size_t)l * 2 * FF * DM, 64 * kb, n0, (n0 >> 7) * 256 + (n0 & 127), scr, lane); return; } r -= I_G;
    if (r < I_G) { const int kb = r / 176, nb = r % 176, n0 = 32 * nb; transpose_item(p.ffn_up + (size_t)l * DM * FF, DM, FF, WGU + (size_t)l * 2 * FF * DM, 64 * kb, n0, (n0 >> 7) * 256 + 128 + (n0 & 127), scr, lane); return; } r -= I_G;
    if (r < I_D) { const int kb = r / 64, nb = r % 64; transpose_item(p.ffn_down + (size_t)l * FF * DM, FF, DM, WDN + (size_t)l * DM * FF, 64 * kb, 32 * nb, 32 * nb, scr, lane); return; } r -= I_D;
    { const int kb = r / 16, nb = r % 16; transpose_item(p.conv_pw + (size_t)l * CC * CC, CC, CC, WPW + (size_t)l * CC * CC, 64 * kb, 32 * nb, 32 * nb, scr, lane); }
}
__device__ __forceinline__ void slot_item(int slot, int idx, int& l, int& r) {
    if (slot == 0) { l = 0; r = 5120 + idx; }
    else if (slot == 1) { if (idx < 5632) { l = 0; r = 18432 + idx; } else { l = 1; r = idx - 5632; } }
    else if (slot == 2) { l = 1; r = 7168 + idx; }
    else { l = 1; r = 18432 + idx; }
}
__device__ __forceinline__ void p0_item(int it, int& l, int& r) {
    if (it < 5120) { l = 0; r = it; return; } it -= 5120;
    if (it < 128) { l = 0; r = 24064 + it; return; } it -= 128;
    l = 1; r = 24064 + it;
}
constexpr int P0_ITEMS = 5376;
__device__ __forceinline__ void tail_convert(const Params& p, unsigned char* ws, int slot, PG8_LAS unsigned char* ldsl, int bx) {
    if (bx < 128) return;
    const int tid = opaque_tid(), lane = tid & 63, wave = __builtin_amdgcn_readfirstlane(tid >> 6);
    LAS float* scr = (LAS float*)(ldsl + wave * 16384);
    const int gwt = (bx - 128) * NWAVES + wave, count = slot == 0 ? 13312 : (slot == 1 ? 12800 : (slot == 2 ? 11264 : 5632));
    for (int it = gwt; it < count; it += 1024) { int l, r; slot_item(slot, it, l, r); convert_item(p, ws, l, r, scr, lane); }
}

__device__ __forceinline__ float wave_reduce32(const float (&v)[32], int lane) {
    float a[16], b[8], c[4], d[2], e;
    { const bool h = lane & 32;
#pragma unroll
      for (int t = 0; t < 16; ++t) { const float keep = h ? v[t + 16] : v[t], send = h ? v[t] : v[t + 16]; a[t] = keep + __shfl_xor(send, 32); } }
    { const bool h = lane & 16;
#pragma unroll
      for (int t = 0; t < 8; ++t) { const float keep = h ? a[t + 8] : a[t], send = h ? a[t] : a[t + 8]; b[t] = keep + __shfl_xor(send, 16); } }
    { const bool h = lane & 8;
#pragma unroll
      for (int t = 0; t < 4; ++t) { const float keep = h ? b[t + 4] : b[t], send = h ? b[t] : b[t + 4]; c[t] = keep + __shfl_xor(send, 8); } }
    { const bool h = lane & 4;
#pragma unroll
      for (int t = 0; t < 2; ++t) { const float keep = h ? c[t + 2] : c[t], send = h ? c[t] : c[t + 2]; d[t] = keep + __shfl_xor(send, 4); } }
    { const bool h = lane & 2; const float keep = h ? d[1] : d[0], send = h ? d[0] : d[1]; e = keep + __shfl_xor(send, 2); }
    e += __shfl_xor(e, 1);
    return e;
}
__device__ __forceinline__ void conv_tile(const Params& p, int l, int item, const bf16* PROJ, bf16* CV, LAS float* sl) {
    const int tid = opaque_tid(), lane = tid & 63, wave = __builtin_amdgcn_readfirstlane(tid >> 6), c = tid;
    const int m0 = item * 32, b = m0 / SEQ, s0 = m0 % SEQ;
    LAS float* part = sl; LAS float* stat = sl + 512;
    float u[62];
#pragma unroll
    for (int rr = 0; rr < 62; ++rr) { const int sq = s0 - 15 + rr; const bool ok = sq >= 0 && sq < SEQ; const bf16* pr = PROJ + (size_t)(b * SEQ + (ok ? sq : s0)) * NIN;
        const float a = bf2f(pr[PB_A + c]), g = bf2f(pr[PB_G + c]); u[rr] = ok ? a / (1.0f + __expf(-g)) : 0.f; }
    float w[31];
#pragma unroll
    for (int j = 0; j < 31; ++j) w[j] = p.conv_dw[(size_t)(l * 31 + j) * CC + c];
    const float bias = p.conv_dw_b[l * CC + c];
    float y[32], y2[32];
#pragma unroll
    for (int t = 0; t < 32; ++t) { float acc = bias;
#pragma unroll
        for (int j = 0; j < 31; ++j) acc = fmaf(u[t + j], w[j], acc);
        y[t] = acc; y2[t] = acc * acc; }
    const float r1 = wave_reduce32(y, lane), r2 = wave_reduce32(y2, lane);
    const int tl = 16 * ((lane >> 5) & 1) + 8 * ((lane >> 4) & 1) + 4 * ((lane >> 3) & 1) + 2 * ((lane >> 2) & 1) + ((lane >> 1) & 1);
    __syncthreads();
    if ((lane & 1) == 0) { part[(tl * 8 + wave) * 2] = r1; part[(tl * 8 + wave) * 2 + 1] = r2; }
    __syncthreads();
    if (tid < 32) { float S1 = 0.f, S2 = 0.f;
#pragma unroll
        for (int w8 = 0; w8 < 8; ++w8) { S1 += part[(tid * 8 + w8) * 2]; S2 += part[(tid * 8 + w8) * 2 + 1]; }
        const float mean = S1 * (1.0f / CC); float var = S2 * (1.0f / CC) - mean * mean; var = var < 0.f ? 0.f : var;
        stat[tid * 2] = mean; stat[tid * 2 + 1] = 1.0f / sqrtf(var + EPS); }
    __syncthreads();
    const float lg = p.conv_ln_g[l * CC + c], lb = p.conv_ln_b[l * CC + c];
#pragma unroll
    for (int t = 0; t < 32; ++t) { float v = (y[t] - stat[t * 2]) * stat[t * 2 + 1] * lg + lb; v = v / (1.0f + __expf(-v)); CV[(size_t)(m0 + t) * CC + c] = (bf16)f2bf(v); }
}
#ifndef QL64
#define QL64 false
#endif
#ifndef QL128
#define QL128 true
#endif
#ifndef SD64
#define SD64 2
#endif
#ifndef SD128
#define SD128 2
#endif
#ifndef SDNA
#define SDNA 1
#endif
#ifndef USE_CG_SYNC
#define USE_CG_SYNC 0
#endif
#define GSYNC() do { if (USE_CG_SYNC) grid.sync(); else xcd_barrier(xbar); } while (0)
#ifndef ROPE_PROBE
#define ROPE_PROBE 0
#endif
#ifndef REP_CONV
#define REP_CONV 1
#endif
#ifndef EXTRA_SYNC
#define EXTRA_SYNC 0
#endif
#ifndef REP_S3
#define REP_S3 1
#endif
#ifndef REP_GEMM
#define REP_GEMM 1
#endif
#ifndef REP_P0
#define REP_P0 1
#endif
#ifndef ON_DIFF
#define ON_DIFF 1
#endif
#ifndef ON_GQA
#define ON_GQA 1
#endif
#ifndef ON_NA
#define ON_NA 1
#endif
#ifndef ON_CONV
#define ON_CONV 1
#endif
#ifndef ON_ROPE
#define ON_ROPE 1
#endif
#ifndef ON_P0
#define ON_P0 1
#endif
#ifndef ON_GEMM
#define ON_GEMM 1
#endif
__device__ __forceinline__ void store_o_bf16(const att::f32x16 (&o)[4], bf16* base  , unsigned char* lds) {
    const int tid = opaque_tid(), lane = tid & 63, wave = __builtin_amdgcn_readfirstlane(tid >> 6), r32 = lane & 31, hi = lane >> 5;
    __syncthreads();
    float* T = (float*)(lds + wave * 16896);
#pragma unroll
    for (int r = 0; r < 16; ++r) { float* tp = T + att::crow(r, hi) * 132 + r32;
#pragma unroll
        for (int d = 0; d < 4; ++d) tp[32 * d] = o[d][r]; }
#pragma unroll
    for (int k = 0; k < 8; ++k) { const int chunk = k * 64 + lane, row = chunk >> 4, c8 = chunk & 15;
        const f32x4 a = *(const f32x4*)(T + row * 132 + c8 * 8), b = *(const f32x4*)(T + row * 132 + c8 * 8 + 4);
        v4u w; w.x = att::cvtpk(a.x, a.y); w.y = att::cvtpk(a.z, a.w); w.z = att::cvtpk(b.x, b.y); w.w = att::cvtpk(b.z, b.w);
        *(v4u*)(base + (size_t)(wave * 32 + row) * DM + c8 * 8) = w; }
}

__global__ void __launch_bounds__(NTHR) mega_fwd(Params p) {
    extern __shared__ __attribute__((aligned(16))) unsigned char lds[];
    cg::grid_group grid = cg::this_grid();
    const int G = gridDim.x, bx = blockIdx.x, ngw = G * NWAVES;
    unsigned char* ws = p.ws;
    bf16* WIN = (bf16*)(ws + WS_WIN); bf16* WOUT = (bf16*)(ws + WS_WOUT); bf16* WGU = (bf16*)(ws + WS_WGU); bf16* WDN = (bf16*)(ws + WS_WDN); bf16* WPW = (bf16*)(ws + WS_WPW);
    bf16* XN = (bf16*)(ws + WS_XN); bf16* PROJ = (bf16*)(ws + WS_PROJ); bf16* CAT = (bf16*)(ws + WS_CAT); bf16* HB = (bf16*)(ws + WS_H); bf16* CV = (bf16*)(ws + WS_CV);
    float* MIX = (float*)(ws + WS_MIX); unsigned long long* XSLOT = (unsigned long long*)(ws + WS_MIX + 48 * MiB); bf16* XB = (bf16*)(ws + WS_MIX + 16 * MiB);
    unsigned* CTL = (unsigned*)ws; f32x2* ROPE = (f32x2*)(ws + WS_ROPE);
    PG8_LAS unsigned char* ldsl = (PG8_LAS unsigned char*)lds;
    volatile LAS unsigned* bst = (volatile LAS unsigned*)(ldsl + LDS_BYTES - 16);
    if (threadIdx.x < 4) bst[threadIdx.x] = 0u;
    __syncthreads();
    const XcdBarrier xbar = xcd_barrier_post((unsigned*)ws, bst);

    for (int rp0 = 0; rp0 < REP_P0; ++rp0) {
        const int tid = opaque_tid(), lane = tid & 63, wave = __builtin_amdgcn_readfirstlane(tid >> 6), gw = bx * NWAVES + wave; (void)tid; (void)lane; (void)gw;
        LAS float* scr = (LAS float*)(ldsl + wave * 16384);
        for (int it = gw; it < ON_P0 * P0_ITEMS; it += ngw) { int cl, cr; p0_item(it, cl, cr); convert_item(p, ws, cl, cr, scr, lane); }
        for (int m = gw; m < M; m += ngw) { f32x4 v[8];
#pragma unroll
            for (int j = 0; j < 8; ++j) v[j] = __builtin_nontemporal_load((const f32x4*)(p.x + (size_t)m * DM + 4 * (lane + 64 * j)));
#pragma unroll
            for (int j = 0; j < 8; ++j) { v2u o; o.x = pk2(v[j].x, v[j].y); o.y = pk2(v[j].z, v[j].w); __builtin_nontemporal_store(o, (v2u*)(XB + (size_t)m * DM + 4 * (lane + 64 * j))); }
            norm_row_bf16(v, p.norm_mix_pre, XN + (size_t)m * DM, lane); }
    }
    if (G != 256) grid.sync(); else GSYNC();
    for (int es = 0; es < EXTRA_SYNC; ++es) GSYNC();

    for (int l = 0; l < DEPTH; ++l) {
        _Pragma("unroll") for (int rg = 0; rg < REP_GEMM; ++rg) { pg8::Gemm g{XN, WIN + (size_t)l * NIN * DM, M, NIN, DM}; pg8::StaticOrder S; S.init(M, NIN, G, bx);
          pg8::EpiProj E{PROJ, NIN, (const float*)ROPE, p.gqa_q_norm + l * 128, p.gqa_k_norm + l * 128, (PG8_LAS float*)(ldsl + 131072)};
          pg8::gemm_phase<pg8::EpiProj, pg8::StaticOrder, true, true>(ldsl, g, S, E); }
        tail_convert(p, ws, l == 0 ? 0 : 2, ldsl, bx);
        GSYNC();

        for (int rep3 = 0; rep3 < REP_S3; ++rep3) {
            const int tid = opaque_tid(), lane = tid & 63, wave = __builtin_amdgcn_readfirstlane(tid >> 6), gw = bx * NWAVES + wave; (void)tid; (void)lane; (void)gw;
            const float lam_init = l == 0 ? 0.2f : 0.35550906759096934f;
            float lam; { const float* lp = p.diff_lambda + l * 256; const float sa = wave_sum(lp[lane] * lp[64 + lane]), sb = wave_sum(lp[128 + lane] * lp[192 + lane]); lam = expf(sa) - expf(sb) + lam_init; }
            constexpr float C64 = 0.125f * 1.4426950408889634f, THR64 = att::THR / 0.125f;
            constexpr float SC128 = 0.08838834764831845f, C128 = SC128 * 1.4426950408889634f, THR128 = att::THR / SC128;
            const int r32 = lane & 31, hi = lane >> 5;
            unsigned* ccnt = CTL + 32768 + l * 2048;
            if (ON_CONV && bx >= 128) {
                for (int ci = 0; ci < 2; ++ci) { const int item = 2 * (bx - 128) + ci;
                    conv_tile(p, l, item, PROJ, CV, (LAS float*)(ldsl + 131072));
                    asm volatile("s_waitcnt vmcnt(0)" ::: "memory"); __syncthreads();
                    if (tid == 0) { __builtin_amdgcn_fence(__ATOMIC_RELEASE, "agent"); asm volatile("s_waitcnt vmcnt(0)" ::: "memory"); __hip_atomic_fetch_add(ccnt + 64 * (item >> 3), 1u, __ATOMIC_RELAXED, __HIP_MEMORY_SCOPE_AGENT); } }
            }
            for (int round = 0;; ++round) {
                const int pc = (round & 1) ? (round + 1) * G - 1 - bx : round * G + bx;
                if (pc >= 384) break;
                const int kind = pc >> 7, xq = bx & 7, b = xq >> 2, h = xq & 3, qb = (bx & 127) >> 3;
                const size_t rowq = (size_t)b * SEQ + qb * 256, rowk = (size_t)b * SEQ;
                att::f32x16 o[4];
                __syncthreads();
                if (ON_DIFF && kind == 0) {
                    att::attn_body<64, false, QL64, SD64>(PROJ + rowq * NIN + PA_Q + h * 128, PROJ + rowk * NIN + PA_K + h * 128, PROJ + rowk * NIN + PA_V + h * 128, SEQ / 64, (char*)lds, C64, THR64, o, 0, 0, 0, 0.f);
                    { const int t2 = opaque_tid(); v4u* STv = (v4u*)((char*)lds + 69632) + t2;
#pragma unroll
                      for (int k = 0; k < 8; ++k) { const int d = k >> 1, r0 = 8 * (k & 1); v4u w;
                          w.x = att::cvtpk(o[d][r0], o[d][r0 + 1]); w.y = att::cvtpk(o[d][r0 + 2], o[d][r0 + 3]); w.z = att::cvtpk(o[d][r0 + 4], o[d][r0 + 5]); w.w = att::cvtpk(o[d][r0 + 6], o[d][r0 + 7]);
                          STv[k * 512] = w; } }
                    att::attn_body<64, false, QL64, SD64>(PROJ + rowq * NIN + PA_Q + h * 128 + 64, PROJ + rowk * NIN + PA_K + h * 128 + 64, PROJ + rowk * NIN + PA_V + h * 128, SEQ / 64, (char*)lds, C64, THR64, o, 0, 0, 0, 0.f);
                    { const int t3 = opaque_tid(), l3 = t3 & 63, r32 = l3 & 31; const v4u* STv = (const v4u*)((char*)lds + 69632) + t3;
                      const float* sg = p.diff_subln + l * 128;
                      float gsub[4], ss[16];
#pragma unroll
                      for (int d = 0; d < 4; ++d) gsub[d] = sg[32 * d + r32] * (1.0f - lam_init);
#pragma unroll
                      for (int r = 0; r < 16; ++r) ss[r] = 0.f;
#pragma unroll
                      for (int k = 0; k < 8; ++k) { const int d = k >> 1, r0 = 8 * (k & 1); const v4u w = STv[k * 512];
#pragma unroll
                          for (int i = 0; i < 4; ++i) { const unsigned wi = i == 0 ? w.x : (i == 1 ? w.y : (i == 2 ? w.z : w.w));
                              const float va = bf2f((unsigned short)(wi & 0xffffu)) - lam * o[d][r0 + 2 * i], vb = bf2f((unsigned short)(wi >> 16)) - lam * o[d][r0 + 2 * i + 1];
                              o[d][r0 + 2 * i] = va; o[d][r0 + 2 * i + 1] = vb; ss[r0 + 2 * i] += va * va; ss[r0 + 2 * i + 1] += vb * vb; } }
#pragma unroll
                      for (int r = 0; r < 16; ++r) { float q = ss[r]; q += __shfl_xor(q, 1); q += __shfl_xor(q, 2); q += __shfl_xor(q, 4); q += __shfl_xor(q, 8); q += __shfl_xor(q, 16);
                          const float rstd = 1.0f / sqrtf(q * (1.0f / 128.0f) + EPS);
#pragma unroll
                          for (int d = 0; d < 4; ++d) o[d][r] *= rstd * gsub[d]; } }
                    store_o_bf16(o, CAT + rowq * DM + h * 128, lds);
                } else if (ON_GQA && kind == 1) {
                    att::attn_body<128, false, QL128, SD128>(PROJ + rowq * NIN + PC_Q + h * 128, PROJ + rowk * NIN + PC_K + (h >> 1) * 128, PROJ + rowk * NIN + PC_V + (h >> 1) * 128, SEQ / 64, (char*)lds, C128, THR128, o, 0, 0, 0, 0.f);
                    store_o_bf16(o, CAT + rowq * DM + 1024 + h * 128, lds);
                } else if (ON_NA) {
                    { const float* rsrc = p.na_rpb + (size_t)(l * 4 + h) * 465; float* rdst = (float*)((char*)lds + att::RPB_OFF); for (int e = tid; e < 465; e += NTHR) rdst[e] = rsrc[e]; }
                    int krow0 = 4 * qb - 4; krow0 = krow0 < 0 ? 0 : (krow0 > 52 ? 52 : krow0);
                    const size_t rowkn = rowk + (size_t)krow0 * 64;
                    att::attn_body<128, true, QL128, SDNA>(PROJ + rowq * NIN + PD_Q + h * 128, PROJ + rowkn * NIN + PD_K + h * 128, PROJ + rowkn * NIN + PD_V + h * 128, 12, (char*)lds, C128, THR128, o,
                                              krow0, 4 * qb + (wave >> 1), (wave & 1) * 32 + r32, 11.313708498984761f);
                    store_o_bf16(o, CAT + rowq * DM + 1536 + h * 128, lds);
                }
            }
            __syncthreads();
            if (G - 1 - bx < 64) {
                if (tid == 0) { unsigned sp = 0; while (__hip_atomic_load(ccnt + 64 * ((G - 1 - bx) >> 1), __ATOMIC_RELAXED, __HIP_MEMORY_SCOPE_AGENT) < 8u) { __builtin_amdgcn_s_sleep(2); if (++sp > (1u << 24)) break; }
                    __builtin_amdgcn_fence(__ATOMIC_ACQUIRE, "agent"); asm volatile("s_waitcnt vmcnt(0)" ::: "memory"); }
                __syncthreads();
            }
            { pg8::Gemm g{CV, WPW + (size_t)l * CC * CC, M, CC, CC}; pg8::StrideOrder S{G - 1 - bx, G, 64, 2};
              pg8::EpiBf16<0> E{CAT + 512, DM, p.conv_pw_b + l * CC, 0, 0, 1.f};
              pg8::gemm_phase<pg8::EpiBf16<0>, pg8::StrideOrder, true, true>(ldsl, g, S, E); }
        }
        GSYNC();

        { pg8::Gemm g{CAT, WOUT + (size_t)l * DM * DM, M, DM, DM}; pg8::StaticOrder S; S.init(M, DM, G, bx);
          pg8::EpiRmsFused E{XB, nullptr, XB, XN, p.norm_mix_post + l * DM, p.norm_ffn_pre + l * DM, XSLOT + (size_t)(l * 2 + 0) * 131072, CTL + 16384 + (l * 2 + 0) * 2048};
          pg8::gemm_phase<pg8::EpiRmsFused, pg8::StaticOrder, false, true>(ldsl, g, S, E); }
        GSYNC();
        _Pragma("unroll") for (int rg = 0; rg < REP_GEMM; ++rg) { pg8::Gemm g{XN, WGU + (size_t)l * 2 * FF * DM, M, 2 * FF, DM}; pg8::StaticOrder S; S.init(M, 2 * FF, G, bx);
          pg8::EpiSwiGLU E{HB, FF};
          pg8::gemm_phase<pg8::EpiSwiGLU, pg8::StaticOrder, true, true>(ldsl, g, S, E); }
        tail_convert(p, ws, l == 0 ? 1 : 3, ldsl, bx);
        GSYNC();
        { pg8::Gemm g{HB, WDN + (size_t)l * DM * FF, M, DM, FF}; pg8::StaticOrder S; S.init(M, DM, G, bx);
          pg8::EpiRmsFused E{XB, l + 1 < DEPTH ? nullptr : p.out, XB, XN, p.norm_ffn_post + l * DM, l + 1 < DEPTH ? p.norm_mix_pre + (l + 1) * DM : nullptr, XSLOT + (size_t)(l * 2 + 1) * 131072, CTL + 16384 + (l * 2 + 1) * 2048};
          pg8::gemm_phase<pg8::EpiRmsFused, pg8::StaticOrder, false, true>(ldsl, g, S, E); }
        if (l + 1 < DEPTH) GSYNC();
    }
}

extern "C" void kernel_launch(void* const* d_in, const int* in_sizes, int n_in, void* d_out, int out_size, void* d_ws, size_t ws_size, hipStream_t stream) {
    static int grid = 0;
    if (grid == 0) {
        if (n_in != 21 || out_size != M * DM || ws_size < WS_END) { fprintf(stderr, "kernel_launch: unexpected shapes: n_in %d out %d ws %zu (need %zu)\n", n_in, out_size, ws_size, (size_t)WS_END); grid = -1; return; }
        int dev = 0, cus = 0, per_cu = 0;
        if (hipGetDevice(&dev) != hipSuccess || hipDeviceGetAttribute(&cus, hipDeviceAttributeMultiprocessorCount, dev) != hipSuccess) { fprintf(stderr, "kernel_launch: device query failed\n"); grid = -1; return; }
        if (hipFuncSetAttribute((const void*)mega_fwd, hipFuncAttributeMaxDynamicSharedMemorySize, LDS_BYTES) != hipSuccess) { fprintf(stderr, "kernel_launch: hipFuncSetAttribute failed\n"); grid = -1; return; }
        if (hipOccupancyMaxActiveBlocksPerMultiprocessor(&per_cu, (const void*)mega_fwd, NTHR, LDS_BYTES) != hipSuccess || per_cu < 1) { fprintf(stderr, "kernel_launch: occupancy query says %d\n", per_cu); (void)hipGetLastError(); per_cu = 1; }
        grid = cus * per_cu;
        if (grid < 256) { fprintf(stderr, "kernel_launch: needs 256 co-resident workgroups, device offers %d\n", grid); grid = -1; return; }
        grid = 256;
    }
    if (grid < 0) return;
    if (hipMemsetAsync(d_ws, 0, 196608, stream) != hipSuccess) { fprintf(stderr, "kernel_launch: memset failed\n"); return; }
    Params p{};
    const float** pp = (const float**)&p;
    for (int i = 0; i < 21; ++i) pp[i] = (const float*)d_in[i];
    p.out = (float*)d_out; p.ws = (unsigned char*)d_ws;
    void* args[] = {&p};
    hipError_t e = hipLaunchCooperativeKernel((const void*)mega_fwd, dim3(grid), dim3(NTHR), args, LDS_BYTES, stream);
    if (e != hipSuccess) fprintf(stderr, "cooperative launch failed: %s (grid %d)\n", hipGetErrorString(e), grid);
}
```

```cpp
#include <hip/hip_runtime.h>
#include <hip/hip_cooperative_groups.h>
#include <cstdio>
#include <cstdint>
namespace cg = cooperative_groups;
__device__ __forceinline__ int opaque_tid() { int t = threadIdx.x; asm volatile("" : "+v"(t)); return t; }
namespace pg8 {
#define PG8_LAS __attribute__((address_space(3)))
typedef unsigned short bf16_t;
typedef short bf16x8 __attribute__((ext_vector_type(8)));
typedef float f32x4 __attribute__((ext_vector_type(4)));
typedef unsigned u32x4 __attribute__((ext_vector_type(4)));
constexpr int BM = 256, BK = 64, HALF = 128, HTB = HALF * BK * 2  , STAGE_BYTES = 8 * HTB, NXCD = 8, WGM = 8;

__host__ __device__ __forceinline__ int lds_byte(int r, int c) { const int st = (r >> 4) * 2 + (c >> 5), rr = r & 15, cc = c & 31, ob = rr * 64 + cc * 2; return st * 1024 + (ob ^ (((ob >> 9) & 1) << 5)); }
__host__ __device__ __forceinline__ void stage_rc(int b, int& R, int& C) { const int st = b / 1024, sb = b % 1024, swz = sb ^ (((sb >> 9) & 1) << 5); R = (st >> 1) * 16 + swz / 64; C = (st & 1) * 32 + (swz % 64) / 2; }
__host__ __device__ __forceinline__ int perm32(int rho) { const int n = rho >> 4, i = rho & 15; return 8 * (i >> 2) + 4 * n + (i & 3); }

struct Unit { int pm, pn; };
struct Gemm { const bf16_t* A; const bf16_t* Bt; int M, N, K; };

struct StaticOrder {
    int nM, nN, nwg, G, c;
    __host__ __device__ void init(int M, int N, int G_, int c_) { nM = M / BM; nN = N / BM; nwg = nM * nN; G = G_; c = c_; }
    __host__ __device__ bool next(int i, Unit& u) const {
        const long L = (long)i * G + c; if (L >= nwg) return false;
        int wgid = (int)L; { const int q = nwg / NXCD, r = nwg % NXCD, xcd = wgid % NXCD, off = wgid / NXCD; wgid = (xcd < r ? xcd * (q + 1) : r * (q + 1) + (xcd - r) * q) + off; }
        const int nig = WGM * nN, gid = wgid / nig, fm = gid * WGM, gsz = (nM - fm) < WGM ? (nM - fm) : WGM;
        u.pm = fm + ((wgid % nig) % gsz); u.pn = (wgid % nig) / gsz; return true;
    }
    __device__ __forceinline__ void a_ready(const Unit&) const {}
    __device__ __forceinline__ void done(const Unit&) const {}
};

__device__ __forceinline__ unsigned cvt_pk_bf16(float lo, float hi) { unsigned r; asm volatile("v_cvt_pk_bf16_f32 %0, %1, %2" : "=v"(r) : "v"(lo), "v"(hi)); return r; }
typedef float f32x2 __attribute__((ext_vector_type(2)));
__device__ __forceinline__ f32x2 gelu_pk(f32x2 v) {
    const f32x2 av = __builtin_elementwise_abs(v), d = av * 0.2316418882f + 1.0f;
    f32x2 t; t.x = __builtin_amdgcn_rcpf(d.x); t.y = __builtin_amdgcn_rcpf(d.y);
    f32x2 q = t * 0.5307027145f + (-0.7265760135f); q = q * t + 0.7107068705f; q = q * t + (-0.142248368f); q = q * t + 0.127414796f; q = q * t;
    const f32x2 s = (v * v) * (-0.72134752044f);
    f32x2 e; e.x = __builtin_amdgcn_exp2f(s.x); e.y = __builtin_amdgcn_exp2f(s.y);
    const f32x2 m = v * (q * e), r = v - m;
    f32x2 o; o.x = v.x < 0.f ? m.x : r.x; o.y = v.y < 0.f ? m.y : r.y; return o;
}

template <int ACT  > struct EpiBf16 {
    static constexpr bool PERM = true, AFTER_DRAIN = false; static_assert(ACT == 0 || ACT == 1, "EpiBf16: ACT is 0 (none) or 1 (gelu_pk)");
    bf16_t* O; int ldc; const float* bias; int split_cols; size_t split_stride; float scale0;
    __device__ __forceinline__ void operator()(const f32x4 (&acc)[2][2][4][2], const Unit& u, int wr, int wc, int fr, int fq) const {
        const int row0 = u.pm * BM + wr * 64 + fr; int colt = u.pn * BM; bf16_t* base = O;
        float sc = 1.f; if (split_cols) { const int t = colt / split_cols; base += (size_t)t * split_stride; colt -= t * split_cols; if (t == 0) sc = scale0; }
        const int col0 = colt + wc * 32 + 8 * fq, bcol0 = u.pn * BM + wc * 32 + 8 * fq;
        f32x4 bv[2][2];
#pragma unroll
        for (int bj = 0; bj < 2; ++bj)
#pragma unroll
            for (int n = 0; n < 2; ++n) bv[bj][n] = bias ? *(const f32x4*)(bias + bcol0 + bj * HALF + 4 * n) : (f32x4){0.f, 0.f, 0.f, 0.f};
#pragma unroll
        for (int ai = 0; ai < 2; ++ai)
#pragma unroll
            for (int m = 0; m < 4; ++m) { bf16_t* rowp = base + (size_t)(row0 + ai * HALF + m * 16) * ldc + col0;
#pragma unroll
                for (int bj = 0; bj < 2; ++bj) { f32x4 v0 = acc[ai][bj][m][0] + bv[bj][0], v1 = acc[ai][bj][m][1] + bv[bj][1];
                    if (ACT == 1) { f32x2 a = gelu_pk((f32x2){v0[0], v0[1]}), b = gelu_pk((f32x2){v0[2], v0[3]}), c = gelu_pk((f32x2){v1[0], v1[1]}), d = gelu_pk((f32x2){v1[2], v1[3]});
                        v0 = (f32x4){a.x, a.y, b.x, b.y}; v1 = (f32x4){c.x, c.y, d.x, d.y}; }
                    v0 = v0 * sc; v1 = v1 * sc; u32x4 w; w.x = cvt_pk_bf16(v0[0], v0[1]); w.y = cvt_pk_bf16(v0[2], v0[3]); w.z = cvt_pk_bf16(v1[0], v1[1]); w.w = cvt_pk_bf16(v1[2], v1[3]);
                    *(u32x4*)(rowp + bj * HALF) = w; } }
    }
};
struct EpiF32 {
    static constexpr bool PERM = false, AFTER_DRAIN = false;
    float* O; int ldc;
    __device__ __forceinline__ void operator()(const f32x4 (&acc)[2][2][4][2], const Unit& u, int wr, int wc, int fr, int fq) const {
        const int row0 = u.pm * BM + wr * 64 + fr, col0 = u.pn * BM + wc * 32 + 4 * fq;
#pragma unroll
        for (int ai = 0; ai < 2; ++ai)
#pragma unroll
            for (int m = 0; m < 4; ++m) { float* rowp = O + (size_t)(row0 + ai * HALF + m * 16) * ldc + col0;
#pragma unroll
                for (int bj = 0; bj < 2; ++bj)
#pragma unroll
                    for (int n = 0; n < 2; ++n) *(f32x4*)(rowp + bj * HALF + n * 16) = acc[ai][bj][m][n]; }
    }
};
__device__ __forceinline__ float swiglu1(float g, float u) { return g * u * __builtin_amdgcn_rcpf(1.0f + __expf(-g)); }
struct EpiSwiGLU {
    static constexpr bool PERM = true, AFTER_DRAIN = false;
    bf16_t* O; int ldc;
    __device__ __forceinline__ void operator()(const f32x4 (&acc)[2][2][4][2], const Unit& u, int wr, int wc, int fr, int fq) const {
        const int row0 = u.pm * BM + wr * 64 + fr, col0 = u.pn * HALF + wc * 32 + 8 * fq;
#pragma unroll
        for (int ai = 0; ai < 2; ++ai)
#pragma unroll
            for (int m = 0; m < 4; ++m) { bf16_t* rowp = O + (size_t)(row0 + ai * HALF + m * 16) * ldc + col0;
                const f32x4 g0 = acc[ai][0][m][0], g1 = acc[ai][0][m][1], u0 = acc[ai][1][m][0], u1 = acc[ai][1][m][1];
                u32x4 w; w.x = cvt_pk_bf16(swiglu1(g0[0], u0[0]), swiglu1(g0[1], u0[1])); w.y = cvt_pk_bf16(swiglu1(g0[2], u0[2]), swiglu1(g0[3], u0[3]));
                w.z = cvt_pk_bf16(swiglu1(g1[0], u1[0]), swiglu1(g1[1], u1[1])); w.w = cvt_pk_bf16(swiglu1(g1[2], u1[2]), swiglu1(g1[3], u1[3]));
                *(u32x4*)rowp = w; }
    }
};

struct PanelSS {
    unsigned* xbuf;
    unsigned* cnt;
    float inv_n, eps;
    __device__ __forceinline__ void run(const f32x4 (&v)[2][2][4][2], const Unit& u, int wr, int wc, int fr, int fq, PG8_LAS unsigned char* lds, int wid, int lane) const {
        PG8_LAS float* P = (PG8_LAS float*)lds;
        PG8_LAS float* S = (PG8_LAS float*)(lds + 4096);
#pragma unroll
        for (int ai = 0; ai < 2; ++ai)
#pragma unroll
            for (int m = 0; m < 4; ++m) {
                float q = 0.f;
#pragma unroll
                for (int bj = 0; bj < 2; ++bj)
#pragma unroll
                    for (int n = 0; n < 2; ++n) { const f32x4 x = v[ai][bj][m][n]; q += (x[0] * x[0] + x[1] * x[1]) + (x[2] * x[2] + x[3] * x[3]); }
                q += __shfl_xor(q, 16); q += __shfl_xor(q, 32);
                if (fq == 0) P[(ai * HALF + wr * 64 + m * 16 + fr) * 4 + wc] = q;
            }
        asm volatile("s_waitcnt lgkmcnt(0)" ::: "memory"); __builtin_amdgcn_s_barrier(); asm volatile("" ::: "memory");
        const int row = wid * 32 + (lane & 31);
        unsigned* slot = xbuf + ((size_t)(u.pm * BM + row) * 8);
        if (lane < 32) { const float q = (P[row * 4 + 0] + P[row * 4 + 1]) + (P[row * 4 + 2] + P[row * 4 + 3]);
            __hip_atomic_store(slot + u.pn, __float_as_uint(q), __ATOMIC_RELAXED, __HIP_MEMORY_SCOPE_AGENT); }
        asm volatile("s_waitcnt vmcnt(0)" ::: "memory");
        if (lane == 0) __hip_atomic_fetch_add(cnt + 64 * u.pm, 1u, __ATOMIC_RELAXED, __HIP_MEMORY_SCOPE_AGENT);
        if (wid == 0) {
            unsigned sp = 0;
            while ((unsigned)__builtin_amdgcn_readfirstlane(__hip_atomic_load(cnt + 64 * u.pm, __ATOMIC_RELAXED, __HIP_MEMORY_SCOPE_AGENT)) < 64u) { __builtin_amdgcn_s_sleep(2); if (++sp > (1u << 22)) break; }
            __builtin_amdgcn_fence(__ATOMIC_ACQUIRE, "agent");
        }
        asm volatile("s_waitcnt vmcnt(0) lgkmcnt(0)" ::: "memory"); __builtin_amdgcn_s_barrier(); asm volatile("" ::: "memory");
        if (lane < 32) { float q = 0.f;
#pragma unroll
            for (int t = 0; t < 8; ++t) q += __uint_as_float(__hip_atomic_load(slot + t, __ATOMIC_RELAXED, __HIP_MEMORY_SCOPE_AGENT));
            S[row] = 1.0f / sqrtf(q * inv_n + eps); }
        asm volatile("s_waitcnt lgkmcnt(0)" ::: "memory"); __builtin_amdgcn_s_barrier(); asm volatile("" ::: "memory");
    }
};
struct EpiRmsResRms {
    static constexpr bool PERM = false, AFTER_DRAIN = true;
    const float* base; float* out; bf16_t* xn; int ldc; const float* g1; const float* g2; PanelSS st1, st2;
    __device__ __forceinline__ void operator()(const f32x4 (&)[2][2][4][2], const Unit&, int, int, int, int) const {}
    __device__ __forceinline__ void fused(f32x4 (&acc)[2][2][4][2], const Unit& u, int wr, int wc, int fr, int fq, PG8_LAS unsigned char* lds, int wid, int lane) const {
        typedef unsigned u32x2v __attribute__((ext_vector_type(2)));
        const PG8_LAS float* S = (const PG8_LAS float*)(lds + 4096);
        const int col0 = u.pn * BM + wc * 32 + 4 * fq;
        st1.run(acc, u, wr, wc, fr, fq, lds, wid, lane);
        {
            f32x4 gv[2][2];
#pragma unroll
            for (int bj = 0; bj < 2; ++bj)
#pragma unroll
                for (int n = 0; n < 2; ++n) gv[bj][n] = *(const f32x4*)(g1 + col0 + bj * HALF + n * 16);
#pragma unroll
            for (int ai = 0; ai < 2; ++ai)
#pragma unroll
                for (int m = 0; m < 4; ++m) { const int r = ai * HALF + wr * 64 + m * 16 + fr; const float sr = S[r]; const size_t off = (size_t)(u.pm * BM + r) * ldc + col0;
#pragma unroll
                    for (int bj = 0; bj < 2; ++bj)
#pragma unroll
                        for (int n = 0; n < 2; ++n) { const f32x4 bs = *(const f32x4*)(base + off + bj * HALF + n * 16); acc[ai][bj][m][n] = bs + acc[ai][bj][m][n] * sr * gv[bj][n]; }
                    asm volatile("" : "+v"(acc[ai][0][m][0]), "+v"(acc[ai][0][m][1]), "+v"(acc[ai][1][m][0]), "+v"(acc[ai][1][m][1]));
                    if (m & 1) asm volatile("" ::: "memory"); }
        }
        if (g2) {
            st2.run(acc, u, wr, wc, fr, fq, lds, wid, lane);
            f32x4 gv[2][2];
#pragma unroll
            for (int bj = 0; bj < 2; ++bj)
#pragma unroll
                for (int n = 0; n < 2; ++n) gv[bj][n] = *(const f32x4*)(g2 + col0 + bj * HALF + n * 16);
#pragma unroll
            for (int ai = 0; ai < 2; ++ai)
#pragma unroll
                for (int m = 0; m < 4; ++m) { const int r = ai * HALF + wr * 64 + m * 16 + fr; const float sr = S[r]; const size_t off = (size_t)(u.pm * BM + r) * ldc + col0;
#pragma unroll
                    for (int bj = 0; bj < 2; ++bj)
#pragma unroll
                        for (int n = 0; n < 2; ++n) { const f32x4 x1 = acc[ai][bj][m][n]; *(f32x4*)(out + off + bj * HALF + n * 16) = x1;
                            const f32x4 o = x1 * sr * gv[bj][n]; u32x2v w; w.x = cvt_pk_bf16(o[0], o[1]); w.y = cvt_pk_bf16(o[2], o[3]);
                            *(u32x2v*)(xn + off + bj * HALF + n * 16) = w; }
                    asm volatile("" ::: "memory"); }
        } else {
#pragma unroll
            for (int ai = 0; ai < 2; ++ai)
#pragma unroll
                for (int m = 0; m < 4; ++m) { const int r = ai * HALF + wr * 64 + m * 16 + fr; const size_t off = (size_t)(u.pm * BM + r) * ldc + col0;
#pragma unroll
                    for (int bj = 0; bj < 2; ++bj)
#pragma unroll
                        for (int n = 0; n < 2; ++n) *(f32x4*)(out + off + bj * HALF + n * 16) = acc[ai][bj][m][n]; }
        }
    }
};

__device__ __forceinline__ float bflo(unsigned w) { return __builtin_bit_cast(float, w << 16); }
__device__ __forceinline__ float bfhi(unsigned w) { return __builtin_bit_cast(float, w & 0xffff0000u); }
struct EpiRmsFused {
    static constexpr bool PERM = true, AFTER_DRAIN = true;
    const bf16_t* base_b;
    float* out_f; bf16_t* out_b;
    bf16_t* xn; const float* g1; const float* g2;
    unsigned long long* xbuf;
    unsigned* cnt;
    __device__ __forceinline__ void operator()(const f32x4 (&)[2][2][4][2], const Unit&, int, int, int, int) const {}
    __device__ __forceinline__ void fused(f32x4 (&acc)[2][2][4][2], const Unit& u, int wr, int wc, int fr, int fq, PG8_LAS unsigned char* lds, int wid, int lane) const {
        typedef unsigned u32x2v __attribute__((ext_vector_type(2)));
        constexpr int ldc = 2048; constexpr float inv_n = 1.0f / 2048.0f, eps = 1e-6f;
        PG8_LAS f32x4* P = (PG8_LAS f32x4*)(lds + 131072);
        PG8_LAS float* S = (PG8_LAS float*)(lds + 131072 + 16384);
        const int col0 = u.pn * BM + wc * 32 + 8 * fq;
        f32x4 gv[2][2];
#pragma unroll
        for (int bj = 0; bj < 2; ++bj)
#pragma unroll
            for (int n = 0; n < 2; ++n) gv[bj][n] = *(const f32x4*)(g1 + col0 + bj * HALF + n * 4);
        PG8_LAS u32x4* XL = (PG8_LAS u32x4*)lds + (wid * 64 + lane);
#pragma unroll
        for (int ai = 0; ai < 2; ++ai)
#pragma unroll
            for (int m = 0; m < 4; ++m) { const size_t off = (size_t)(u.pm * BM + ai * HALF + wr * 64 + m * 16 + fr) * ldc + col0;
#pragma unroll
                for (int bj = 0; bj < 2; ++bj) XL[((ai * 4 + m) * 2 + bj) * 512] = *(const u32x4*)(base_b + off + bj * HALF); }
#pragma unroll
        for (int ai = 0; ai < 2; ++ai)
#pragma unroll
            for (int m = 0; m < 4; ++m) {
                float saa = 0.f, sxx = 0.f, sxag = 0.f, sgg = 0.f;
#pragma unroll
                for (int bj = 0; bj < 2; ++bj) { const u32x4 w4 = XL[((ai * 4 + m) * 2 + bj) * 512];
#pragma unroll
                    for (int n = 0; n < 2; ++n) { const f32x4 a = acc[ai][bj][m][n]; const f32x4 ag = a * gv[bj][n]; const unsigned wx = n == 0 ? w4.x : w4.z, wy = n == 0 ? w4.y : w4.w;
                        const f32x4 x = (f32x4){bflo(wx), bfhi(wx), bflo(wy), bfhi(wy)};
                        saa += (a[0] * a[0] + a[1] * a[1]) + (a[2] * a[2] + a[3] * a[3]); sxx += (x[0] * x[0] + x[1] * x[1]) + (x[2] * x[2] + x[3] * x[3]);
                        sxag += (x[0] * ag[0] + x[1] * ag[1]) + (x[2] * ag[2] + x[3] * ag[3]); sgg += (ag[0] * ag[0] + ag[1] * ag[1]) + (ag[2] * ag[2] + ag[3] * ag[3]); } }
                asm volatile("" : "+v"(saa), "+v"(sxx), "+v"(sxag), "+v"(sgg));
                saa += __shfl_xor(saa, 16); sxx += __shfl_xor(sxx, 16); sxag += __shfl_xor(sxag, 16); sgg += __shfl_xor(sgg, 16);
                saa += __shfl_xor(saa, 32); sxx += __shfl_xor(sxx, 32); sxag += __shfl_xor(sxag, 32); sgg += __shfl_xor(sgg, 32);
                if (fq == 0) P[(ai * HALF + wr * 64 + m * 16 + fr) * 4 + wc] = (f32x4){saa, sxx, sxag, sgg};
                __builtin_amdgcn_sched_barrier(0);
            }
        asm volatile("s_waitcnt lgkmcnt(0)" ::: "memory"); __builtin_amdgcn_s_barrier(); asm volatile("" ::: "memory");
        const int row = wid * 32 + (lane & 31);
        unsigned long long* slot = xbuf + ((size_t)(u.pm * BM + row) * 8) * 2;
        if (lane < 32) { const f32x4 q = (P[row * 4 + 0] + P[row * 4 + 1]) + (P[row * 4 + 2] + P[row * 4 + 3]);
            __hip_atomic_store(slot + u.pn * 2, ((unsigned long long)__float_as_uint(q[1]) << 32) | __float_as_uint(q[0]), __ATOMIC_RELAXED, __HIP_MEMORY_SCOPE_AGENT);
            __hip_atomic_store(slot + u.pn * 2 + 1, ((unsigned long long)__float_as_uint(q[3]) << 32) | __float_as_uint(q[2]), __ATOMIC_RELAXED, __HIP_MEMORY_SCOPE_AGENT); }
        asm volatile("s_waitcnt vmcnt(0)" ::: "memory"); __builtin_amdgcn_s_barrier(); asm volatile("" ::: "memory");
        if (wid == 0) {
            if (lane == 0) __hip_atomic_fetch_add(cnt + 64 * u.pm, 1u, __ATOMIC_RELAXED, __HIP_MEMORY_SCOPE_AGENT);
            unsigned sp = 0;
            while ((unsigned)__builtin_amdgcn_readfirstlane(__hip_atomic_load(cnt + 64 * u.pm, __ATOMIC_RELAXED, __HIP_MEMORY_SCOPE_AGENT)) < 8u) { __builtin_amdgcn_s_sleep(1); if (++sp > (1u << 22)) break; }
            __builtin_amdgcn_fence(__ATOMIC_ACQUIRE, "agent");
        }
        asm volatile("s_waitcnt vmcnt(0) lgkmcnt(0)" ::: "memory"); __builtin_amdgcn_s_barrier(); asm volatile("" ::: "memory");
        if (lane < 32) { float saa = 0.f, sxx = 0.f, sxag = 0.f, sgg = 0.f;
#pragma unroll
            for (int t = 0; t < 8; ++t) { const unsigned long long w0 = __hip_atomic_load(slot + t * 2, __ATOMIC_RELAXED, __HIP_MEMORY_SCOPE_AGENT), w1 = __hip_atomic_load(slot + t * 2 + 1, __ATOMIC_RELAXED, __HIP_MEMORY_SCOPE_AGENT);
                saa += __uint_as_float((unsigned)w0); sxx += __uint_as_float((unsigned)(w0 >> 32)); sxag += __uint_as_float((unsigned)w1); sgg += __uint_as_float((unsigned)(w1 >> 32)); }
            const float r1 = 1.0f / sqrtf(saa * inv_n + eps);
            float s1 = sxx + 2.0f * r1 * sxag + r1 * r1 * sgg; s1 = s1 < 0.f ? 0.f : s1;
            S[row * 2] = r1; S[row * 2 + 1] = 1.0f / sqrtf(s1 * inv_n + eps); }
        asm volatile("s_waitcnt lgkmcnt(0)" ::: "memory"); __builtin_amdgcn_s_barrier(); asm volatile("" ::: "memory");
        int fr2 = fr, col2 = col0; asm volatile("" : "+v"(fr2), "+v"(col2));
        f32x4 g2v[2][2], g1v[2][2];
#pragma unroll
        for (int bj = 0; bj < 2; ++bj)
#pragma unroll
            for (int n = 0; n < 2; ++n) { g2v[bj][n] = g2 ? *(const f32x4*)(g2 + col2 + bj * HALF + n * 4) : (f32x4){0.f, 0.f, 0.f, 0.f}; g1v[bj][n] = *(const f32x4*)(g1 + col2 + bj * HALF + n * 4); }
#pragma unroll
        for (int ai = 0; ai < 2; ++ai)
#pragma unroll
            for (int m = 0; m < 4; ++m) { const int r = ai * HALF + wr * 64 + m * 16 + fr2; const float r1 = S[r * 2], r2 = S[r * 2 + 1]; const size_t off = (size_t)(u.pm * BM + r) * ldc + col2;
#pragma unroll
                for (int bj = 0; bj < 2; ++bj) { u32x4 w4 = XL[((ai * 4 + m) * 2 + bj) * 512]; asm volatile("" : "+v"(w4.x), "+v"(w4.y), "+v"(w4.z), "+v"(w4.w));
                    const f32x4 xa = (f32x4){bflo(w4.x), bfhi(w4.x), bflo(w4.y), bfhi(w4.y)}, xb = (f32x4){bflo(w4.z), bfhi(w4.z), bflo(w4.w), bfhi(w4.w)};
                    const f32x4 x1a = xa + acc[ai][bj][m][0] * r1 * g1v[bj][0], x1b = xb + acc[ai][bj][m][1] * r1 * g1v[bj][1];
                    if (out_f) { __builtin_nontemporal_store(x1a, (f32x4*)(out_f + off + bj * HALF)); __builtin_nontemporal_store(x1b, (f32x4*)(out_f + off + bj * HALF + 4)); }
                    else { u32x4 o; o.x = cvt_pk_bf16(x1a[0], x1a[1]); o.y = cvt_pk_bf16(x1a[2], x1a[3]); o.z = cvt_pk_bf16(x1b[0], x1b[1]); o.w = cvt_pk_bf16(x1b[2], x1b[3]); *(u32x4*)(out_b + off + bj * HALF) = o; }
                    if (g2) { const f32x4 ya = x1a * r2 * g2v[bj][0], yb = x1b * r2 * g2v[bj][1]; u32x4 o; o.x = cvt_pk_bf16(ya[0], ya[1]); o.y = cvt_pk_bf16(ya[2], ya[3]); o.z = cvt_pk_bf16(yb[0], yb[1]); o.w = cvt_pk_bf16(yb[2], yb[3]);
                        *(u32x4*)(xn + off + bj * HALF) = o; } }
                asm volatile("" ::: "memory"); __builtin_amdgcn_sched_barrier(0); }
    }
};

struct EpiProj {
    static constexpr bool PERM = true, AFTER_DRAIN = false;
    bf16_t* O; int ldc; const float* rope; const float* qn; const float* kn; PG8_LAS float* X;
    __device__ __forceinline__ void operator()(const f32x4 (&acc)[2][2][4][2], const Unit& u, int wr, int wc, int fr_, int fq_) const {
        int fr = fr_, fq = fq_; asm volatile("" : "+v"(fr), "+v"(fq));
        const int pn = u.pn, kind = pn < 4 ? 1 : ((pn >= 10 && pn <= 12) ? 2 : 0);
        if (kind == 0) {
            const int row0 = u.pm * BM + wr * 64 + fr, col0 = pn * BM + wc * 32 + 8 * fq;
#pragma unroll
            for (int ai = 0; ai < 2; ++ai)
#pragma unroll
                for (int m = 0; m < 4; ++m) { bf16_t* rowp = O + (size_t)(row0 + ai * HALF + m * 16) * ldc + col0;
#pragma unroll
                    for (int bj = 0; bj < 2; ++bj) { const f32x4 v0 = acc[ai][bj][m][0], v1 = acc[ai][bj][m][1];
                        u32x4 w; w.x = cvt_pk_bf16(v0[0], v0[1]); w.y = cvt_pk_bf16(v0[2], v0[3]); w.z = cvt_pk_bf16(v1[0], v1[1]); w.w = cvt_pk_bf16(v1[2], v1[3]);
                        *(u32x4*)(rowp + bj * HALF) = w; } }
            return;
        }
        const int i0 = 8 * fq, c1 = pn * BM + 64 * wc + i0;
        float frev[8];
#pragma unroll
        for (int k = 0; k < 8; ++k) { constexpr float FK[8] = {0.15915494309189535f, 0.11934937021124886f, 0.08949940160889104f, 0.06711508300522727f, 0.05032921210448705f, 0.037741584717419785f, 0.02830219583062341f, 0.02122365276477767f};
            frev[k] = FK[k] * (fq == 0 ? 1.0f : (fq == 1 ? 0.1f : (fq == 2 ? 0.01f : 0.001f))); }
        f32x4 ga[2], gb[2];
        if (kind == 2) { const float* gn = (pn == 12 ? kn : qn) + 64 * (wc & 1) + i0;
            ga[0] = *(const f32x4*)gn; ga[1] = *(const f32x4*)(gn + 4); gb[0] = *(const f32x4*)(gn + 32); gb[1] = *(const f32x4*)(gn + 36);
#pragma unroll
            for (int ai = 0; ai < 2; ++ai)
#pragma unroll
                for (int m = 0; m < 4; ++m) { float q = 0.f;
#pragma unroll
                    for (int bj = 0; bj < 2; ++bj)
#pragma unroll
                        for (int n = 0; n < 2; ++n) { const f32x4 x = acc[ai][bj][m][n]; q += (x[0] * x[0] + x[1] * x[1]) + (x[2] * x[2] + x[3] * x[3]); }
                    q += __shfl_xor(q, 16); q += __shfl_xor(q, 32);
                    if (fq == 0) X[(ai * HALF + wr * 64 + m * 16 + fr) * 4 + wc] = q; }
            asm volatile("s_waitcnt lgkmcnt(0)" ::: "memory"); __builtin_amdgcn_s_barrier(); asm volatile("" ::: "memory");
        } else { ga[0] = ga[1] = gb[0] = gb[1] = (f32x4){1.f, 1.f, 1.f, 1.f}; }
#pragma unroll
        for (int ai = 0; ai < 2; ++ai)
#pragma unroll
            for (int m = 0; m < 4; ++m) { const int r = ai * HALF + wr * 64 + m * 16 + fr, row = u.pm * BM + r, t = row & 4095;
                const int pos = kind == 1 ? t : ((wc & 1) ? (t & 63) : (t >> 6));
                const float fpos = (float)pos;
                float rs = 1.f;
                if (kind == 2) rs = 1.0f / sqrtf((X[r * 4 + wc] + X[r * 4 + (wc ^ 1)]) * (1.0f / 128.0f) + 1e-6f);
                u32x4 w1, w2;
#pragma unroll
                for (int n = 0; n < 2; ++n) {
                    f32x4 c, sn;
#pragma unroll
                    for (int j = 0; j < 4; ++j) { const float rev = __builtin_amdgcn_fractf(fpos * frev[4 * n + j]); c[j] = __builtin_amdgcn_cosf(rev); sn[j] = __builtin_amdgcn_sinf(rev); }
                    const f32x4 a = acc[ai][0][m][n] * rs * ga[n], b = acc[ai][1][m][n] * rs * gb[n];
                    const f32x4 o1 = a * c - b * sn, o2 = a * sn + b * c;
                    if (n == 0) { w1.x = cvt_pk_bf16(o1[0], o1[1]); w1.y = cvt_pk_bf16(o1[2], o1[3]); w2.x = cvt_pk_bf16(o2[0], o2[1]); w2.y = cvt_pk_bf16(o2[2], o2[3]); }
                    else { w1.z = cvt_pk_bf16(o1[0], o1[1]); w1.w = cvt_pk_bf16(o1[2], o1[3]); w2.z = cvt_pk_bf16(o2[0], o2[1]); w2.w = cvt_pk_bf16(o2[2], o2[3]); }
                }
                bf16_t* rowp = O + (size_t)row * ldc + c1;
                *(u32x4*)rowp = w1;
                *(u32x4*)(rowp + 32) = w2; __builtin_amdgcn_sched_barrier(0); }
    }
};
struct StrideOrder {
    int first, G, count, nN;
    __device__ bool next(int i, Unit& u) const { const int j = first + i * G; if (j >= count) return false; u.pm = j / nN; u.pn = j % nN; return true; }
    __device__ __forceinline__ void a_ready(const Unit&) const {}
    __device__ __forceinline__ void done(const Unit&) const {}
};
template <class Epi, class Sched, bool ALIGN_EPI = false, bool SP2 = false>
__device__ __forceinline__ void gemm_phase(PG8_LAS unsigned char* lds, const Gemm g, const Sched& S, const Epi& E) {
    const int tid = opaque_tid(), wid = __builtin_amdgcn_readfirstlane(tid >> 6), lane = tid & 63, wr = wid >> 2, wc = wid & 3, fr = lane & 15, fq = lane >> 4;
    const int K = g.K, nt = K / BK;
    unsigned voffA[2], voffB[2];
#pragma unroll
    for (int i = 0; i < 2; ++i) { int R, C; stage_rc(tid * 16 + i * 8192, R, C); const int Rb = Epi::PERM ? ((R & ~31) + perm32(R & 31)) : R;
        voffA[i] = (unsigned)(R * K + C) * 2u; voffB[i] = (unsigned)(Rb * K + C) * 2u; }
    const size_t kstep = (size_t)(BK * 2);
    const size_t hstep = (size_t)HALF * K * 2;
    const size_t tstep = 2 * hstep;
    const unsigned ldsw = (unsigned)wid * 1024u;
    const int aoff = lds_byte(wr * 64 + fr, fq * 8), boff = lds_byte(wc * 32 + fr, fq * 8);
#define PG8_SA(b, h) (((b) * 2 + (h)) * HTB)
#define PG8_SB(b, h) ((4 + (b) * 2 + (h)) * HTB)
#define PG8_STAGE(bufoff, gbase, voff) do { _Pragma("unroll") for (int _i = 0; _i < 2; ++_i) \
        __builtin_amdgcn_global_load_lds((const unsigned*)((const char*)(gbase) + (voff)[_i]), (PG8_LAS unsigned*)(lds + (bufoff) + ldsw + _i * 8192), 16, 0, 0); } while (0)
#define PG8_LDA(dst, b, h) do { _Pragma("unroll") for (int m = 0; m < 4; ++m) _Pragma("unroll") for (int k = 0; k < 2; ++k) dst[m][k] = *(const PG8_LAS bf16x8*)(lds + PG8_SA(b, h) + aoff + m * 2048 + k * 1024); } while (0)
#define PG8_LDB(dst, b, h) do { _Pragma("unroll") for (int n = 0; n < 2; ++n) _Pragma("unroll") for (int k = 0; k < 2; ++k) dst[n][k] = *(const PG8_LAS bf16x8*)(lds + PG8_SB(b, h) + boff + n * 2048 + k * 1024); } while (0)
#define PG8_MMA(ai, bj, At, Bt) do { __builtin_amdgcn_s_setprio(1); _Pragma("unroll") for (int m = 0; m < 4; ++m) _Pragma("unroll") for (int n = 0; n < 2; ++n) _Pragma("unroll") for (int k = 0; k < 2; ++k) \
        acc[ai][bj][m][n] = __builtin_amdgcn_mfma_f32_16x16x32_bf16(Bt[n][k], At[m][k], acc[ai][bj][m][n], 0, 0, 0); __builtin_amdgcn_s_setprio(0); } while (0)
#define PG8_WAIT_V(n) asm volatile("s_waitcnt vmcnt(" #n ")" ::: "memory")
#define PG8_WAIT_L(n) asm volatile("s_waitcnt lgkmcnt(" #n ")" ::: "memory")
#define PG8_BAR __builtin_amdgcn_s_barrier()
#define PG8_SCHED __builtin_amdgcn_sched_barrier(0)
    Unit cur, nxt; int ui = 0;
    if (!S.next(0, cur)) return;
    f32x4 acc[2][2][4][2];
#pragma unroll
    for (int a = 0; a < 2; ++a)
#pragma unroll
        for (int b = 0; b < 2; ++b)
#pragma unroll
            for (int m = 0; m < 4; ++m)
#pragma unroll
                for (int n = 0; n < 2; ++n) acc[a][b][m][n] = (f32x4){0.f, 0.f, 0.f, 0.f};
    bf16x8 At[4][2], B0[2][2], B1[2][2];
    const char* cA = (const char*)g.A + (size_t)cur.pm * tstep; const char* cB = (const char*)g.Bt + (size_t)cur.pn * tstep;
    S.a_ready(cur);
    if constexpr (SP2) {
        PG8_STAGE(PG8_SB(0, 0), cB, voffB); PG8_STAGE(PG8_SB(0, 1), cB + hstep, voffB); PG8_STAGE(PG8_SA(0, 0), cA, voffA); PG8_STAGE(PG8_SA(0, 1), cA + hstep, voffA);
        if (wr == 1) PG8_BAR;
        PG8_WAIT_V(2); PG8_BAR;
        PG8_STAGE(PG8_SB(1, 0), cB + kstep, voffB); PG8_STAGE(PG8_SA(1, 0), cA + kstep, voffA); PG8_STAGE(PG8_SB(1, 1), cB + hstep + kstep, voffB);
        PG8_WAIT_V(6); PG8_BAR;
    } else {
        PG8_STAGE(PG8_SB(0, 0), cB, voffB); PG8_STAGE(PG8_SA(0, 0), cA, voffA); PG8_STAGE(PG8_SB(0, 1), cB + hstep, voffB); PG8_STAGE(PG8_SA(0, 1), cA + hstep, voffA);
        if (wr == 1) PG8_BAR;
        PG8_WAIT_V(4); PG8_BAR;
        PG8_STAGE(PG8_SB(1, 0), cB + kstep, voffB); PG8_STAGE(PG8_SA(1, 0), cA + kstep, voffA); PG8_STAGE(PG8_SB(1, 1), cB + hstep + kstep, voffB);
        PG8_WAIT_V(6); PG8_BAR;
    }
    for (;;) {
        const bool has_next = S.next(ui + 1, nxt);
        const char* nA = has_next ? (const char*)g.A + (size_t)nxt.pm * tstep : cA; const char* nB = has_next ? (const char*)g.Bt + (size_t)nxt.pn * tstep : cB;
        for (int t = 0; t < nt; t += 2) {
            const bool last = (t == nt - 2);
            const char* a1 = cA + (size_t)(t + 1) * kstep;
            const char* a2 = last ? nA : cA + (size_t)(t + 2) * kstep; const char* b2 = last ? nB : cB + (size_t)(t + 2) * kstep;
            const char* a3 = a2 + kstep; const char* b3 = b2 + kstep;
            if (last && has_next) S.a_ready(nxt);
            if constexpr (SP2) {
            PG8_LDB(B0, 0, 0); PG8_LDB(B1, 0, 1); PG8_SCHED; PG8_LDA(At, 0, 0); PG8_STAGE(PG8_SA(1, 1), a1 + hstep, voffA);
            PG8_WAIT_V(8); PG8_WAIT_L(0); PG8_BAR; PG8_MMA(0, 0, At, B0); PG8_MMA(0, 1, At, B1); PG8_BAR; PG8_SCHED;
            PG8_LDA(At, 0, 1); PG8_STAGE(PG8_SB(0, 0), b2, voffB); PG8_STAGE(PG8_SB(0, 1), b2 + hstep, voffB); PG8_STAGE(PG8_SA(0, 0), a2, voffA);
            PG8_WAIT_V(8); PG8_WAIT_L(0); PG8_BAR; PG8_MMA(1, 0, At, B0); PG8_MMA(1, 1, At, B1); PG8_BAR; PG8_SCHED;
            PG8_LDB(B0, 1, 0); PG8_LDB(B1, 1, 1); PG8_SCHED; PG8_LDA(At, 1, 0); PG8_STAGE(PG8_SA(0, 1), a2 + hstep, voffA);
            PG8_WAIT_V(8); PG8_WAIT_L(0); PG8_BAR; PG8_MMA(0, 0, At, B0); PG8_MMA(0, 1, At, B1); PG8_BAR; PG8_SCHED;
            PG8_LDA(At, 1, 1); PG8_STAGE(PG8_SB(1, 0), b3, voffB); PG8_STAGE(PG8_SB(1, 1), b3 + hstep, voffB); PG8_STAGE(PG8_SA(1, 0), a3, voffA);
            PG8_WAIT_V(8); PG8_WAIT_L(0); PG8_BAR; PG8_MMA(1, 0, At, B0); PG8_MMA(1, 1, At, B1); PG8_BAR; PG8_SCHED;
            } else {
            PG8_LDB(B0, 0, 0); PG8_SCHED; PG8_LDA(At, 0, 0); PG8_STAGE(PG8_SA(1, 1), a1 + hstep, voffA);
            PG8_WAIT_L(8); PG8_BAR; PG8_WAIT_L(0); PG8_MMA(0, 0, At, B0); PG8_BAR; PG8_SCHED;
            PG8_LDB(B1, 0, 1); PG8_STAGE(PG8_SB(0, 0), b2, voffB);
            PG8_BAR; PG8_WAIT_L(0); PG8_MMA(0, 1, At, B1); PG8_BAR;
            PG8_LDA(At, 0, 1); PG8_STAGE(PG8_SA(0, 0), a2, voffA);
            PG8_BAR; PG8_WAIT_L(0); PG8_MMA(1, 0, At, B0); PG8_BAR; PG8_SCHED;
            PG8_STAGE(PG8_SB(0, 1), b2 + hstep, voffB);
            PG8_WAIT_V(6); PG8_BAR; PG8_MMA(1, 1, At, B1); PG8_BAR;
            PG8_LDB(B0, 1, 0); PG8_SCHED; PG8_LDA(At, 1, 0); PG8_STAGE(PG8_SA(0, 1), a2 + hstep, voffA);
            PG8_WAIT_L(8); PG8_BAR; PG8_WAIT_L(0); PG8_MMA(0, 0, At, B0); PG8_BAR; PG8_SCHED;
            PG8_LDB(B1, 1, 1); PG8_STAGE(PG8_SB(1, 0), b3, voffB);
            PG8_BAR; PG8_WAIT_L(0); PG8_MMA(0, 1, At, B1); PG8_BAR;
            PG8_LDA(At, 1, 1); PG8_STAGE(PG8_SA(1, 0), a3, voffA);
            PG8_BAR; PG8_WAIT_L(0); PG8_MMA(1, 0, At, B0); PG8_BAR; PG8_SCHED;
            PG8_STAGE(PG8_SB(1, 1), b3 + hstep, voffB);
            PG8_WAIT_V(6); PG8_BAR; PG8_MMA(1, 1, At, B1); PG8_BAR;
            }
        }
        if constexpr (ALIGN_EPI) { if (wr == 0) PG8_BAR; }
        if constexpr (!Epi::AFTER_DRAIN) { E(acc, cur, wr, wc, fr, fq); S.done(cur); }
        if (!has_next) break;
#pragma unroll
        for (int a = 0; a < 2; ++a)
#pragma unroll
            for (int b = 0; b < 2; ++b)
#pragma unroll
                for (int m = 0; m < 4; ++m)
#pragma unroll
                    for (int n = 0; n < 2; ++n) acc[a][b][m][n] = (f32x4){0.f, 0.f, 0.f, 0.f};
        cur = nxt; cA = nA; cB = nB; ++ui;
        if constexpr (ALIGN_EPI) { if (wr == 1) PG8_BAR; }
    }
    PG8_WAIT_V(0);
    if constexpr (!ALIGN_EPI) { if (wr == 0) PG8_BAR; }
    PG8_BAR;
    if constexpr (Epi::AFTER_DRAIN) { E.fused(acc, cur, wr, wc, fr, fq, lds, wid, lane); S.done(cur); }
#undef PG8_SA
#undef PG8_SB
#undef PG8_STAGE
#undef PG8_LDA
#undef PG8_LDB
#undef PG8_MMA
#undef PG8_WAIT_V
#undef PG8_WAIT_L
#undef PG8_BAR
#undef PG8_SCHED
}
}
namespace att {
using bf16 = unsigned short;
using bf16x8 = __attribute__((ext_vector_type(8))) short;
using s16x4  = __attribute__((ext_vector_type(4))) short;
using f32x16 = __attribute__((ext_vector_type(16))) float;
using u32x4  = __attribute__((ext_vector_type(4))) unsigned;
constexpr int KVBLK = 64, LDP = 5120;
constexpr float THR = 8.f;
constexpr int SHM_V = 16384, SHM_K = 16384, SHM_ATTN = 2 * SHM_V + 2 * SHM_K + 8 * 64 * 4;
constexpr int RPB_OFF = SHM_ATTN, Q_OFF = SHM_ATTN + 2048;
#define SBAR() __builtin_amdgcn_sched_barrier(0)
template <int DK> __device__ __forceinline__ int kswz(int row, int colB) { return DK == 128 ? row * 256 + (colB ^ ((row & 7) << 4)) : row * 128 + (colB ^ (((row >> 1) & 7) << 4)); }
__device__ __forceinline__ int crow(int r, int hi) { return (r & 3) + 8 * (r >> 2) + 4 * hi; }
__device__ __forceinline__ unsigned cvtpk(float lo, float hi) { unsigned r; asm volatile("v_cvt_pk_bf16_f32 %0, %1, %2" : "=v"(r) : "v"(lo), "v"(hi)); return r; }

__device__ __forceinline__ void partialSM(f32x16& p0, f32x16& p1, float& m_reg, float& mn, float& alpha, float C, float thrRaw) {
  float pmax = p0[0];
#pragma unroll
  for (int r = 1; r < 16; ++r) pmax = fmaxf(pmax, p0[r]);
#pragma unroll
  for (int r = 0; r < 16; ++r) pmax = fmaxf(pmax, p1[r]);
  { auto rr = __builtin_amdgcn_permlane32_swap(__float_as_uint(pmax), __float_as_uint(pmax), false, false);
    pmax = fmaxf(__uint_as_float(rr[0]), __uint_as_float(rr[1])); }
  if (__builtin_expect(__all(pmax - m_reg <= thrRaw), 1)) { mn = m_reg; alpha = 1.f; }
  else { mn = fmaxf(m_reg, pmax); alpha = __builtin_amdgcn_exp2f((m_reg - mn) * C); m_reg = mn; }
  float mnC = -mn * C;
#pragma unroll
  for (int r = 0; r < 16; ++r) p0[r] = fmaf(p0[r], C, mnC);
#pragma unroll
  for (int r = 0; r < 16; ++r) p1[r] = fmaf(p1[r], C, mnC);
#pragma unroll
  for (int r = 0; r < 16; ++r) p0[r] = __builtin_amdgcn_exp2f(p0[r]);
}
__device__ __forceinline__ void finishSM(f32x16& p0, f32x16& p1, float alpha, float& l_reg, bf16x8& pa0, bf16x8& pa1, bf16x8& pa2, bf16x8& pa3) {
#pragma unroll
  for (int r = 0; r < 16; ++r) p1[r] = __builtin_amdgcn_exp2f(p1[r]);
  float ps = 0;
#pragma unroll
  for (int r = 0; r < 16; ++r) ps += p0[r];
#pragma unroll
  for (int r = 0; r < 16; ++r) ps += p1[r];
  { auto rr = __builtin_amdgcn_permlane32_swap(__float_as_uint(ps), __float_as_uint(ps), false, false);
    ps = __uint_as_float(rr[0]) + __uint_as_float(rr[1]); }
  l_reg = l_reg * alpha + ps;
#define PK4(P, BASE, OUT) do { unsigned a0 = cvtpk(P[BASE + 0], P[BASE + 1]), a1 = cvtpk(P[BASE + 2], P[BASE + 3]);   \
    unsigned b0 = cvtpk(P[BASE + 4], P[BASE + 5]), b1 = cvtpk(P[BASE + 6], P[BASE + 7]);                              \
    auto r0 = __builtin_amdgcn_permlane32_swap(a0, b0, false, false); auto r1 = __builtin_amdgcn_permlane32_swap(a1, b1, false, false); \
    u32x4 w = {r0[0], r1[0], r0[1], r1[1]}; OUT = *reinterpret_cast<bf16x8*>(&w); } while (0)
  PK4(p0, 0, pa0); PK4(p0, 8, pa1); PK4(p1, 0, pa2); PK4(p1, 8, pa3);
#undef PK4
}
template <int DK, bool QL>
__device__ __forceinline__ void qkt(f32x16& p0, f32x16& p1, const bf16* Ks, const bf16x8* qr, const char* ql, int r32, int hi) {
  p0 = f32x16{}; p1 = f32x16{};
#pragma unroll
  for (int d0 = 0; d0 < DK / 16; ++d0) { int cb = (d0 * 16 + hi * 8) * 2;
    const bf16x8 qv = QL ? *reinterpret_cast<const bf16x8*>(ql + d0 * 1024) : qr[d0];
    bf16x8 b0 = *reinterpret_cast<const bf16x8*>((const char*)Ks + kswz<DK>(r32, cb));
    bf16x8 b1 = *reinterpret_cast<const bf16x8*>((const char*)Ks + kswz<DK>(32 + r32, cb));
    p0 = __builtin_amdgcn_mfma_f32_32x32x16_bf16(b0, qv, p0, 0, 0, 0);
    p1 = __builtin_amdgcn_mfma_f32_32x32x16_bf16(b1, qv, p1, 0, 0, 0); }
}
__device__ __forceinline__ void na_hook(f32x16& p0, f32x16& p1, int kr, int q_row, int q_col, int win_r, int win_c, const float* rpb, float inv_scale, int hi) {
  const bool rowok = (kr >= win_r) && (kr < win_r + 8);
  int ir = kr - q_row + 7; ir = ir < 0 ? 0 : (ir > 14 ? 14 : ir);
  const float* rp = rpb + ir * 31;
#pragma unroll
  for (int r = 0; r < 16; ++r) {
    const int kc = crow(r, hi);
    { const bool ok = rowok && kc >= win_c && kc < win_c + 16; int ic = kc - q_col + 15; ic = ic < 0 ? 0 : (ic > 30 ? 30 : ic);
      p0[r] = ok ? fmaf(rp[ic], inv_scale, p0[r]) : -1e30f; }
    { const int kc2 = kc + 32; const bool ok = rowok && kc2 >= win_c && kc2 < win_c + 16; int ic = kc2 - q_col + 15; ic = ic < 0 ? 0 : (ic > 30 ? 30 : ic);
      p1[r] = ok ? fmaf(rp[ic], inv_scale, p1[r]) : -1e30f; }
  }
}
__device__ __forceinline__ int v_st(int k, int c) { const int kk = (k & ~0xC) | ((k & 4) << 1) | ((k & 8) >> 1); return ((kk >> 3) * 4 + (c >> 5)) * 512 + ((kk & 7) * 32 + (c & 31)) * 2; }
__device__ __forceinline__ int v_rd_base(int lane) { return ((lane & 3) << 3) | (((lane >> 2) & 3) << 6) | (((lane >> 4) & 1) << 5) | (((lane >> 5) & 1) << 8); }
constexpr int v_rd_off(int d0, int ks, int half) { return d0 * 512 + ks * 4096 + half * 2048; }
template <int OFF> __device__ __forceinline__ s16x4 tr_read(int vb) {
  s16x4 r; asm volatile("ds_read_b64_tr_b16 %0, %1 offset:%2" : "=&v"(r) : "v"(vb), "i"(OFF) : "memory"); return r;
}
template <int D0> __device__ __forceinline__ void pv_one(f32x16& od, int vb, bf16x8 pa0, bf16x8 pa1, bf16x8 pa2, bf16x8 pa3) {
  const s16x4 l0 = tr_read<v_rd_off(D0, 0, 0)>(vb), h0 = tr_read<v_rd_off(D0, 0, 1)>(vb), l1 = tr_read<v_rd_off(D0, 1, 0)>(vb), h1 = tr_read<v_rd_off(D0, 1, 1)>(vb);
  const s16x4 l2 = tr_read<v_rd_off(D0, 2, 0)>(vb), h2 = tr_read<v_rd_off(D0, 2, 1)>(vb), l3 = tr_read<v_rd_off(D0, 3, 0)>(vb), h3 = tr_read<v_rd_off(D0, 3, 1)>(vb);
  asm volatile("s_waitcnt lgkmcnt(0)" ::: "memory"); SBAR();
#define PK(L, H) (bf16x8){L[0], L[1], L[2], L[3], H[0], H[1], H[2], H[3]}
  od = __builtin_amdgcn_mfma_f32_32x32x16_bf16(pa0, PK(l0, h0), od, 0, 0, 0);
  od = __builtin_amdgcn_mfma_f32_32x32x16_bf16(pa1, PK(l1, h1), od, 0, 0, 0);
  od = __builtin_amdgcn_mfma_f32_32x32x16_bf16(pa2, PK(l2, h2), od, 0, 0, 0);
  od = __builtin_amdgcn_mfma_f32_32x32x16_bf16(pa3, PK(l3, h3), od, 0, 0, 0);
#undef PK
}
__device__ __forceinline__ void pv_d0(f32x16* o, int vb, bf16x8 pa0, bf16x8 pa1, bf16x8 pa2, bf16x8 pa3) {
  pv_one<0>(o[0], vb, pa0, pa1, pa2, pa3); pv_one<1>(o[1], vb, pa0, pa1, pa2, pa3); pv_one<2>(o[2], vb, pa0, pa1, pa2, pa3); pv_one<3>(o[3], vb, pa0, pa1, pa2, pa3);
}
template <int DK, bool NA, bool QL, int SD>
__device__ __forceinline__ void attn_body(const bf16* __restrict__ Qb, const bf16* __restrict__ Kh, const bf16* __restrict__ Vh, int NT, char* lds,
                                          float C, float thrRaw, f32x16 (&o)[4], int krow0, int q_row, int q_col, float inv_scale) {
  const int tid = opaque_tid(), wid = tid >> 6, lane = tid & 63, r32 = lane & 31, hi = lane >> 5;
  bf16* V_lds = (bf16*)lds; bf16* K_lds = (bf16*)(lds + 2 * SHM_V);
  float* ws = (float*)(lds + 2 * SHM_V + 2 * SHM_K) + wid * 64; float* li_l = ws; float* al_l = ws + 32;
  const float* rpb = (const float*)(lds + RPB_OFF);
  int win_r = q_row - 4; win_r = win_r < 0 ? 0 : (win_r > 56 ? 56 : win_r);
  int win_c = q_col - 8; win_c = win_c < 0 ? 0 : (win_c > 48 ? 48 : win_c);
  float m_reg = -1e30f, l_reg = 0; bf16x8 qr[QL ? 1 : DK / 16];
  char* ql = lds + Q_OFF + (wid * (DK / 16) * 64 + lane) * 16;
#pragma unroll
  for (int d = 0; d < 4; ++d) o[d] = f32x16{};
  const bf16* Qw = Qb + (long)(wid * 32 + r32) * LDP + hi * 8;
#pragma unroll
  for (int d0 = 0; d0 < DK / 16; ++d0) { const bf16x8 qv = *reinterpret_cast<const bf16x8*>(Qw + d0 * 16); if (QL) *reinterpret_cast<bf16x8*>(ql + d0 * 1024) = qv; else qr[d0] = qv; }
  const int sr = tid >> 4, sc = (tid & 15) * 8, vst0 = v_st(sr, sc), vst1 = v_st(32 + sr, sc);
  const int ksr = DK == 128 ? sr : (tid >> 3), ksc = DK == 128 ? sc : (tid & 7) * 8;
  const int vb0 = (int)(uintptr_t)V_lds + v_rd_base(lane);
  struct { bf16x8 vs0, vs1, ks0, ks1; } sr_[SD];
#define SLOAD(i, k0) do { sr_[i].vs0 = *reinterpret_cast<const bf16x8*>(&Vh[(long)((k0) + sr) * LDP + sc]); sr_[i].vs1 = *reinterpret_cast<const bf16x8*>(&Vh[(long)((k0) + 32 + sr) * LDP + sc]); \
    sr_[i].ks0 = *reinterpret_cast<const bf16x8*>(&Kh[(long)((k0) + ksr) * LDP + ksc]); if (DK == 128) sr_[i].ks1 = *reinterpret_cast<const bf16x8*>(&Kh[(long)((k0) + 32 + ksr) * LDP + ksc]); } while (0)
#define SWRITE(b, i) do { *(bf16x8*)((char*)V_lds + (b) * SHM_V + vst0) = sr_[i].vs0;          \
    *(bf16x8*)((char*)V_lds + (b) * SHM_V + vst1) = sr_[i].vs1; int kc = ksc * 2;               \
    *(bf16x8*)((char*)K_lds + (b) * SHM_K + kswz<DK>(ksr, kc)) = sr_[i].ks0;                       \
    if (DK == 128) *(bf16x8*)((char*)K_lds + (b) * SHM_K + kswz<DK>(32 + ksr, kc)) = sr_[i].ks1; } while (0)
#define SWAIT() do { if (SD == 1) asm volatile("s_waitcnt vmcnt(0)" ::: "memory"); else if (DK == 128) asm volatile("s_waitcnt vmcnt(4)" ::: "memory"); else asm volatile("s_waitcnt vmcnt(3)" ::: "memory"); } while (0)
#define RESC(a) do { if (__any((a) < 1.f)) { if (hi == 0) al_l[r32] = (a); asm volatile("s_waitcnt lgkmcnt(0)" ::: "memory"); \
    _Pragma("unroll") for (int d = 0; d < 4; ++d) _Pragma("unroll") for (int r = 0; r < 16; ++r) o[d][r] *= al_l[crow(r, hi)]; } } while (0)
#define HOOK(P0, P1, j) do { if (NA) na_hook(P0, P1, krow0 + (j), q_row, q_col, win_r, win_c, rpb, inv_scale, hi); } while (0)
  f32x16 pA0, pA1, pB0, pB1; float mnA, mnB, alA, alB; bf16x8 pa0, pa1, pa2, pa3;
  constexpr int SE = 0, SO = SD - 1;
  SLOAD(SE, 0); asm volatile("s_waitcnt vmcnt(0)" ::: "memory"); SWRITE(0, SE); __syncthreads();
  qkt<DK, QL>(pA0, pA1, K_lds, qr, ql, r32, hi); HOOK(pA0, pA1, 0); partialSM(pA0, pA1, m_reg, mnA, alA, C, thrRaw);
  SLOAD(SO, KVBLK); if (SD == 2) { if (2 < NT) SLOAD(SE, 2 * KVBLK); }
  SWAIT(); SWRITE(1, SO); __syncthreads();
  for (int j = 1; j + 1 < NT; j += 2) {
    SBAR(); qkt<DK, QL>(pB0, pB1, (bf16*)((char*)K_lds + SHM_K), qr, ql, r32, hi); HOOK(pB0, pB1, j);
    finishSM(pA0, pA1, alA, l_reg, pa0, pa1, pa2, pa3); SBAR();
    SLOAD(SO, (j + SD) * KVBLK); SBAR();
    pv_d0(o, vb0, pa0, pa1, pa2, pa3); partialSM(pB0, pB1, m_reg, mnB, alB, C, thrRaw);
    __syncthreads(); SWAIT(); SWRITE(0, SE);
    RESC(alB); __syncthreads();
    SBAR(); qkt<DK, QL>(pA0, pA1, K_lds, qr, ql, r32, hi); HOOK(pA0, pA1, j + 1);
    finishSM(pB0, pB1, alB, l_reg, pa0, pa1, pa2, pa3); SBAR();
    if (SD == 1 || j + 3 < NT) SLOAD(SE, (j + 1 + SD) * KVBLK); SBAR();
    pv_d0(o, vb0 + (int)SHM_V, pa0, pa1, pa2, pa3); partialSM(pA0, pA1, m_reg, mnA, alA, C, thrRaw);
    __syncthreads(); SWAIT(); SWRITE(1, SO);
    RESC(alA); __syncthreads();
  }
  SBAR(); qkt<DK, QL>(pB0, pB1, (bf16*)((char*)K_lds + SHM_K), qr, ql, r32, hi); HOOK(pB0, pB1, NT - 1);
  finishSM(pA0, pA1, alA, l_reg, pa0, pa1, pa2, pa3); SBAR();
  pv_d0(o, vb0, pa0, pa1, pa2, pa3); partialSM(pB0, pB1, m_reg, mnB, alB, C, thrRaw);
  __syncthreads(); RESC(alB);
  finishSM(pB0, pB1, alB, l_reg, pa0, pa1, pa2, pa3); SBAR();
  pv_d0(o, vb0 + (int)SHM_V, pa0, pa1, pa2, pa3);
  if (hi == 0) li_l[r32] = l_reg; asm volatile("s_waitcnt vmcnt(0) lgkmcnt(0)" ::: "memory");
#pragma unroll
  for (int r = 0; r < 16; ++r) { const float rl = __builtin_amdgcn_rcpf(li_l[crow(r, hi)]);
#pragma unroll
    for (int d = 0; d < 4; ++d) o[d][r] *= rl; }
#undef SLOAD
#undef SWRITE
#undef SWAIT
#undef RESC
#undef HOOK
}
#undef SBAR
}
#define GAS __attribute__((address_space(1)))
#define LAS __attribute__((address_space(3)))
typedef unsigned short bf16;
typedef unsigned v4u __attribute__((ext_vector_type(4)));
typedef unsigned v2u __attribute__((ext_vector_type(2)));
typedef float f32x4 __attribute__((ext_vector_type(4)));
typedef float f32x2 __attribute__((ext_vector_type(2)));
constexpr int NWAVES = 8, NTHR = 512;
constexpr int SEQ = 4096, M = 8192, DM = 2048, NIN = 5120, FF = 5632, DEPTH = 2, CC = 512;
constexpr float EPS = 1e-6f;
constexpr int PA_Q = 0, PA_K = 512, PA_V = 1024, PB_A = 1536, PB_G = 2048, PC_Q = 2560, PC_K = 3072, PC_V = 3328, PD_Q = 3584, PD_K = 4096, PD_V = 4608;
constexpr size_t MiB = 1u << 20;
constexpr size_t WS_ROPE = 1 * MiB;
constexpr size_t WS_WIN = 2 * MiB;
constexpr size_t WS_WOUT = WS_WIN + 40 * MiB;
constexpr size_t WS_WGU = WS_WOUT + 16 * MiB;
constexpr size_t WS_WDN = WS_WGU + 88 * MiB;
constexpr size_t WS_WPW = WS_WDN + 44 * MiB;
constexpr size_t WS_XN = WS_WPW + 1 * MiB;
constexpr size_t WS_PROJ = WS_XN + 32 * MiB;
constexpr size_t WS_CAT = WS_PROJ + 80 * MiB;
constexpr size_t WS_H = WS_PROJ;
constexpr size_t WS_MIX = WS_CAT + 32 * MiB;
constexpr size_t WS_CV = WS_MIX + 64 * MiB;
constexpr size_t WS_END = WS_CV + 8 * MiB;
constexpr int LDS_BYTES = 163840;

__device__ __forceinline__ unsigned f2bf(float f) { unsigned u = __builtin_bit_cast(unsigned, f); return (u + 0x7fffu + ((u >> 16) & 1u)) >> 16; }
__device__ __forceinline__ unsigned pk2(float lo, float hi) { return f2bf(lo) | (f2bf(hi) << 16); }
__device__ __forceinline__ float bf2f(unsigned short b) { return __builtin_bit_cast(float, (unsigned)b << 16); }
__device__ __forceinline__ float wave_sum(float v) {
#pragma unroll
    for (int o = 1; o < 64; o <<= 1) v += __shfl_xor(v, o);
    return v;
}
#define LDS_WAIT() asm volatile("s_waitcnt lgkmcnt(0)" ::: "memory")

#define XB_TMO      128
#define XB_XCNT(j)  (256  + 64 * (j))
#define XB_XSUB(j)  (1280 + 64 * (j))
#define XB_XGEN(j)  (2304 + 64 * (j))
#define XB_TOP      3328
#define XB_TOPGEN   3392
#define XCD_BAR_WORDS 3456
#define XB_SPIN_CAP (1u << 18)

__device__ __forceinline__ unsigned xb_ld(unsigned* p)              { return __hip_atomic_load(p, __ATOMIC_RELAXED, __HIP_MEMORY_SCOPE_AGENT); }
__device__ __forceinline__ unsigned xb_add(unsigned* p, unsigned v) { return __hip_atomic_fetch_add(p, v, __ATOMIC_RELAXED, __HIP_MEMORY_SCOPE_AGENT); }
__device__ __forceinline__ unsigned xb_xcc_id() { return (unsigned)__builtin_amdgcn_s_getreg((3 << 11) | 20) & 0xFu; }
#define XB_SPIN(cond, bar) do { unsigned _sp = 0; while (cond) { __builtin_amdgcn_s_sleep(1); \
    if ((++_sp & 255u) == 0u) { if (xb_ld(&(bar)[XB_TMO])) break; if (_sp > XB_SPIN_CAP) { atomicAdd(&(bar)[XB_TMO], 1u); break; } } } } while (0)

struct XcdBarrier {
    unsigned* bar; unsigned x;
    volatile LAS unsigned* st;
};

__device__ __forceinline__ XcdBarrier xcd_barrier_post(unsigned* bar, volatile LAS unsigned* st) {
    XcdBarrier b; b.bar = bar; b.x = xb_xcc_id(); b.st = st;
    if (threadIdx.x == 0) (void)xb_add(&bar[XB_XCNT(b.x)], 1u);
    return b;
}
__device__ __forceinline__ void xcd_barrier_complete(unsigned* bar, unsigned x, unsigned& nloc, unsigned& nx) {
    const unsigned G = gridDim.x * gridDim.y * gridDim.z;
    unsigned sum, cnt, mine, sp = 0u;
    for (;;) {
        sum = 0u; cnt = 0u; mine = 0u;
#pragma unroll
        for (unsigned j = 0; j < 16; ++j) { const unsigned c = xb_ld(&bar[XB_XCNT(j)]); sum += c; cnt += (c > 0u) ? 1u : 0u; mine = (j == x) ? c : mine; }
        if (sum == G) break;
        __builtin_amdgcn_s_sleep(1);
        if ((++sp & 255u) == 0u) { if (xb_ld(&bar[XB_TMO])) break; if (sp > XB_SPIN_CAP) { atomicAdd(&bar[XB_TMO], 1u); break; } }
    }
    nloc = mine > 0u ? mine : 1u; nx = cnt > 0u ? cnt : 1u;
}

__device__ __forceinline__ void xcd_barrier(const XcdBarrier& b) {
    asm volatile("s_waitcnt vmcnt(0)" ::: "memory");
    __syncthreads();
    if (threadIdx.x == 0) {
        unsigned* bar = b.bar;
        __builtin_amdgcn_s_waitcnt(0);
        unsigned nloc = b.st[0], nx = b.st[1];
        if (nloc == 0u) { xcd_barrier_complete(bar, b.x, nloc, nx); b.st[0] = nloc; b.st[1] = nx; }
        const unsigned old = xb_add(&bar[XB_XSUB(b.x)], 1u);
        const unsigned gen = old / nloc;
        if (old + 1u == (gen + 1u) * nloc) {
            __builtin_amdgcn_fence(__ATOMIC_RELEASE, "agent");
            asm volatile("s_waitcnt vmcnt(0)" ::: "memory");
            const unsigned og = xb_add(&bar[XB_TOP], 1u);
            const unsigned tg = og / nx;
            if (og + 1u == (tg + 1u) * nx) xb_add(&bar[XB_TOPGEN], 1u);
            else XB_SPIN(xb_ld(&bar[XB_TOPGEN]) == tg, bar);
            __builtin_amdgcn_fence(__ATOMIC_ACQUIRE, "agent");
            xb_add(&bar[XB_XGEN(b.x)], 1u);
            asm volatile("s_waitcnt vmcnt(0)" ::: "memory");
        } else {
            XB_SPIN(xb_ld(&bar[XB_XGEN(b.x)]) == gen, bar);
            __builtin_amdgcn_fence(__ATOMIC_ACQUIRE, "agent");
            asm volatile("s_waitcnt vmcnt(0)" ::: "memory");
        }
    }
    __syncthreads();
}

struct Params {
    const float* x; const float* norm_mix_pre; const float* norm_mix_post; const float* norm_ffn_pre; const float* norm_ffn_post;
    const float* w_in; const float* w_out; const float* diff_lambda; const float* diff_subln; const float* conv_dw; const float* conv_dw_b;
    const float* conv_ln_g; const float* conv_ln_b; const float* conv_pw; const float* conv_pw_b; const float* gqa_q_norm; const float* gqa_k_norm;
    const float* na_rpb; const float* ffn_gate; const float* ffn_up; const float* ffn_down;
    float* out; unsigned char* ws;
};

__device__ __forceinline__ void transpose_item(const float* __restrict__ W, int K, int N, bf16* WT, int k0, int n0, int dst_row0, LAS float* scr, int lane) {
    const int r = lane >> 3, q = lane & 7;
    f32x4 v[8];
#pragma unroll
    for (int i = 0; i < 8; ++i) v[i] = __builtin_nontemporal_load((const f32x4*)(W + (size_t)(k0 + 8 * i + r) * N + n0 + 4 * q));
#pragma unroll
    for (int i = 0; i < 8; ++i) { LAS float* d = scr + (8 * i + r) * 33 + 4 * q; d[0] = v[i].x; d[1] = v[i].y; d[2] = v[i].z; d[3] = v[i].w; }
    LDS_WAIT(); asm volatile("" ::: "memory");
    const int c = lane & 7;
#pragma unroll
    for (int j = 0; j < 4; ++j) { const int n = (lane >> 3) + 8 * j; const LAS float* s = scr + (8 * c) * 33 + n;
        v4u o; o.x = pk2(s[0 * 33], s[1 * 33]); o.y = pk2(s[2 * 33], s[3 * 33]); o.z = pk2(s[4 * 33], s[5 * 33]); o.w = pk2(s[6 * 33], s[7 * 33]);
        __builtin_nontemporal_store(o, (v4u*)(WT + (size_t)(dst_row0 + n) * K + k0 + 8 * c)); }
    LDS_WAIT(); asm volatile("" ::: "memory");
}
__device__ __forceinline__ void norm_row_bf16(const f32x4* v, const float* __restrict__ g, bf16* orow, int lane) {
    float s = 0.f;
#pragma unroll
    for (int j = 0; j < 8; ++j) s += (v[j].x * v[j].x + v[j].y * v[j].y) + (v[j].z * v[j].z + v[j].w * v[j].w);
    const float rstd = 1.0f / sqrtf(wave_sum(s) * (1.0f / DM) + EPS);
#pragma unroll
    for (int j = 0; j < 8; ++j) { const f32x4 gv = *(const f32x4*)(g + 4 * (lane + 64 * j));
        v2u o; o.x = pk2(v[j].x * rstd * gv.x, v[j].y * rstd * gv.y); o.y = pk2(v[j].z * rstd * gv.z, v[j].w * rstd * gv.w);
        *(v2u*)(orow + 4 * (lane + 64 * j)) = o; }
}
__device__ __forceinline__ void rows_update(const float* xin, const float* mix, const float* __restrict__ g_post, float* xout, const float* __restrict__ g_next, bf16* XN, int gw, int ngw, int lane) {
    for (int m = gw; m < M; m += ngw) {
        f32x4 a[8], v[8]; float s = 0.f;
#pragma unroll
        for (int j = 0; j < 8; ++j) { a[j] = *(const f32x4*)(mix + (size_t)m * DM + 4 * (lane + 64 * j)); v[j] = *(const f32x4*)(xin + (size_t)m * DM + 4 * (lane + 64 * j));
            s += (a[j].x * a[j].x + a[j].y * a[j].y) + (a[j].z * a[j].z + a[j].w * a[j].w); }
        const float rstd = 1.0f / sqrtf(wave_sum(s) * (1.0f / DM) + EPS);
#pragma unroll
        for (int j = 0; j < 8; ++j) { const f32x4 gv = *(const f32x4*)(g_post + 4 * (lane + 64 * j)); v[j] = v[j] + a[j] * rstd * gv;
            *(f32x4*)(xout + (size_t)m * DM + 4 * (lane + 64 * j)) = v[j]; }
        if (g_next) norm_row_bf16(v, g_next, XN + (size_t)m * DM, lane);
    }
}

constexpr int I_IN = 32 * 160, I_OUT = 32 * 64, I_G = 32 * 176, I_D = 88 * 64, I_PW = 8 * 16;
constexpr int I_LAYER = I_IN + I_OUT + 2 * I_G + I_D + I_PW;
constexpr int TAIL_ITEMS = 7168;
__device__ __forceinline__ void convert_item(const Params& p, unsigned char* ws, int l, int r, LAS float* scr, int lane) {
    bf16* WIN = (bf16*)(ws + WS_WIN); bf16* WOUT = (bf16*)(ws + WS_WOUT); bf16* WGU = (bf16*)(ws + WS_WGU); bf16* WDN = (bf16*)(ws + WS_WDN); bf16* WPW = (bf16*)(ws + WS_WPW);
    if (r < I_IN) { const int kb = r / 160, nb = r % 160, n0 = 32 * nb, tile = n0 >> 8, lc = n0 & 255; const bool rt = tile < 4 || (tile >= 10 && tile <= 12);
        transpose_item(p.w_in + (size_t)l * DM * NIN, DM, NIN, WIN + (size_t)l * NIN * DM, 64 * kb, n0, rt ? tile * 256 + 128 * ((lc >> 5) & 1) + 32 * (lc >> 6) : n0, scr, lane); return; } r -= I_IN;
    if (r < I_OUT) { const int kb = r / 64, nb = r % 64; transpose_item(p.w_out + (size_t)l * DM * DM, DM, DM, WOUT + (size_t)l * DM * DM, 64 * kb, 32 * nb, 32 * nb, scr, lane); return; } r -= I_OUT;
    if (r < I_G) { const int kb = r / 176, nb = r % 176, n0 = 32 * nb; transpose_item(p.ffn_gate + (size_t)l * DM * FF, DM, FF, WGU + (size_t)l * 2 * FF * DM, 64 * kb, n0, (n0 >> 7) * 256 + (n0 & 127), scr, lane); return; } r -= I_G;
    if (r < I_G) { const int kb = r / 176, nb = r % 176, n0 = 32 * nb; transpose_item(p.ffn_up + (size_t)l * DM * FF, DM, FF, WGU + (size_t)l * 2 * FF * DM, 64 * kb, n0, (n0 >> 7) * 256 + 128 + (n0 & 127), scr, lane); return; } r -= I_G;
    if (r < I_D) { const int kb = r / 64, nb = r % 64; transpose_item(p.ffn_down + (size_t)l * FF * DM, FF, DM, WDN + (size_t)l * DM * FF, 64 * kb, 32 * nb, 32 * nb, scr, lane); return; } r -= I_D;
    { const int kb = r / 16, nb = r % 16; transpose_item(p.conv_pw + (size_t)l * CC * CC, CC, CC, WPW + (size_t)l * CC * CC, 64 * kb, 32 * nb, 32 * nb, scr, lane); }
}
__device__ __forceinline__ void slot_item(int slot, int idx, int& l, int& r) {
    if (slot == 0) { l = 0; r = 5120 + idx; }
    else if (slot == 1) { if (idx < 5632) { l = 0; r = 18432 + idx; } else { l = 1; r = idx - 5632; } }
    else if (slot == 2) { l = 1; r = 7168 + idx; }
    else { l = 1; r = 18432 + idx; }
}
__device__ __forceinline__ void p0_item(int it, int& l, int& r) {
    if (it < 5120) { l = 0; r = it; return; } it -= 5120;
    if (it < 128) { l = 0; r = 24064 + it; return; } it -= 128;
    l = 1; r = 24064 + it;
}
constexpr int P0_ITEMS = 5376;
__device__ __forceinline__ void tail_convert(const Params& p, unsigned char* ws, int slot, PG8_LAS unsigned char* ldsl, int bx) {
    if (bx < 128) return;
    const int tid = opaque_tid(), lane = tid & 63, wave = __builtin_amdgcn_readfirstlane(tid >> 6);
    LAS float* scr = (LAS float*)(ldsl + wave * 16384);
    const int gwt = (bx - 128) * NWAVES + wave, count = slot == 0 ? 13312 : (slot == 1 ? 12800 : (slot == 2 ? 11264 : 5632));
    for (int it = gwt; it < count; it += 1024) { int l, r; slot_item(slot, it, l, r); convert_item(p, ws, l, r, scr, lane); }
}

__device__ __forceinline__ float wave_reduce32(const float (&v)[32], int lane) {
    float a[16], b[8], c[4], d[2], e;
    { const bool h = lane & 32;
#pragma unroll
      for (int t = 0; t < 16; ++t) { const float keep = h ? v[t + 16] : v[t], send = h ? v[t] : v[t + 16]; a[t] = keep + __shfl_xor(send, 32); } }
    { const bool h = lane & 16;
#pragma unroll
      for (int t = 0; t < 8; ++t) { const float keep = h ? a[t + 8] : a[t], send = h ? a[t] : a[t + 8]; b[t] = keep + __shfl_xor(send, 16); } }
    { const bool h = lane & 8;
#pragma unroll
      for (int t = 0; t < 4; ++t) { const float keep = h ? b[t + 4] : b[t], send = h ? b[t] : b[t + 4]; c[t] = keep + __shfl_xor(send, 8); } }
    { const bool h = lane & 4;
#pragma unroll
      for (int t = 0; t < 2; ++t) { const float keep = h ? c[t + 2] : c[t], send = h ? c[t] : c[t + 2]; d[t] = keep + __shfl_xor(send, 4); } }
    { const bool h = lane & 2; const float keep = h ? d[1] : d[0], send = h ? d[0] : d[1]; e = keep + __shfl_xor(send, 2); }
    e += __shfl_xor(e, 1);
    return e;
}
__device__ __forceinline__ void conv_tile(const Params& p, int l, int item, const bf16* PROJ, bf16* CV, LAS float* sl) {
    const int tid = opaque_tid(), lane = tid & 63, wave = __builtin_amdgcn_readfirstlane(tid >> 6), c = tid;
    const int m0 = item * 32, b = m0 / SEQ, s0 = m0 % SEQ;
    LAS float* part = sl; LAS float* stat = sl + 512;
    float u[62];
#pragma unroll
    for (int rr = 0; rr < 62; ++rr) { const int sq = s0 - 15 + rr; const bool ok = sq >= 0 && sq < SEQ; const bf16* pr = PROJ + (size_t)(b * SEQ + (ok ? sq : s0)) * NIN;
        const float a = bf2f(pr[PB_A + c]), g = bf2f(pr[PB_G + c]); u[rr] = ok ? a / (1.0f + __expf(-g)) : 0.f; }
    float w[31];
#pragma unroll
    for (int j = 0; j < 31; ++j) w[j] = p.conv_dw[(size_t)(l * 31 + j) * CC + c];
    const float bias = p.conv_dw_b[l * CC + c];
    float y[32], y2[32];
#pragma unroll
    for (int t = 0; t < 32; ++t) { float acc = bias;
#pragma unroll
        for (int j = 0; j < 31; ++j) acc = fmaf(u[t + j], w[j], acc);
        y[t] = acc; y2[t] = acc * acc; }
    const float r1 = wave_reduce32(y, lane), r2 = wave_reduce32(y2, lane);
    const int tl = 16 * ((lane >> 5) & 1) + 8 * ((lane >> 4) & 1) + 4 * ((lane >> 3) & 1) + 2 * ((lane >> 2) & 1) + ((lane >> 1) & 1);
    __syncthreads();
    if ((lane & 1) == 0) { part[(tl * 8 + wave) * 2] = r1; part[(tl * 8 + wave) * 2 + 1] = r2; }
    __syncthreads();
    if (tid < 32) { float S1 = 0.f, S2 = 0.f;
#pragma unroll
        for (int w8 = 0; w8 < 8; ++w8) { S1 += part[(tid * 8 + w8) * 2]; S2 += part[(tid * 8 + w8) * 2 + 1]; }
        const float mean = S1 * (1.0f / CC); float var = S2 * (1.0f / CC) - mean * mean; var = var < 0.f ? 0.f : var;
        stat[tid * 2] = mean; stat[tid * 2 + 1] = 1.0f / sqrtf(var + EPS); }
    __syncthreads();
    const float lg = p.conv_ln_g[l * CC + c], lb = p.conv_ln_b[l * CC + c];
#pragma unroll
    for (int t = 0; t < 32; ++t) { float v = (y[t] - stat[t * 2]) * stat[t * 2 + 1] * lg + lb; v = v / (1.0f + __expf(-v)); CV[(size_t)(m0 + t) * CC + c] = (bf16)f2bf(v); }
}
#ifndef QL64
#define QL64 false
#endif
#ifndef QL128
#define QL128 true
#endif
#ifndef SD64
#define SD64 2
#endif
#ifndef SD128
#define SD128 2
#endif
#ifndef SDNA
#define SDNA 1
#endif
#ifndef USE_CG_SYNC
#define USE_CG_SYNC 0
#endif
#define GSYNC() do { if (USE_CG_SYNC) grid.sync(); else xcd_barrier(xbar); } while (0)
#ifndef ROPE_PROBE
#define ROPE_PROBE 0
#endif
#ifndef REP_CONV
#define REP_CONV 1
#endif
#ifndef EXTRA_SYNC
#define EXTRA_SYNC 0
#endif
#ifndef REP_S3
#define REP_S3 1
#endif
#ifndef REP_GEMM
#define REP_GEMM 1
#endif
#ifndef REP_P0
#define REP_P0 1
#endif
#ifndef ON_DIFF
#define ON_DIFF 1
#endif
#ifndef ON_GQA
#define ON_GQA 1
#endif
#ifndef ON_NA
#define ON_NA 1
#endif
#ifndef ON_CONV
#define ON_CONV 1
#endif
#ifndef ON_ROPE
#define ON_ROPE 1
#endif
#ifndef ON_P0
#define ON_P0 1
#endif
#ifndef ON_GEMM
#define ON_GEMM 1
#endif
__device__ __forceinline__ void store_o_bf16(const att::f32x16 (&o)[4], bf16* base  , unsigned char* lds) {
    const int tid = opaque_tid(), lane = tid & 63, wave = __builtin_amdgcn_readfirstlane(tid >> 6), r32 = lane & 31, hi = lane >> 5;
    __syncthreads();
    float* T = (float*)(lds + wave * 16896);
#pragma unroll
    for (int r = 0; r < 16; ++r) { float* tp = T + att::crow(r, hi) * 132 + r32;
#pragma unroll
        for (int d = 0; d < 4; ++d) tp[32 * d] = o[d][r]; }
#pragma unroll
    for (int k = 0; k < 8; ++k) { const int chunk = k * 64 + lane, row = chunk >> 4, c8 = chunk & 15;
        const f32x4 a = *(const f32x4*)(T + row * 132 + c8 * 8), b = *(const f32x4*)(T + row * 132 + c8 * 8 + 4);
        v4u w; w.x = att::cvtpk(a.x, a.y); w.y = att::cvtpk(a.z, a.w); w.z = att::cvtpk(b.x, b.y); w.w = att::cvtpk(b.z, b.w);
        *(v4u*)(base + (size_t)(wave * 32 + row) * DM + c8 * 8) = w; }
}

__global__ void __launch_bounds__(NTHR) mega_fwd(Params p) {
    extern __shared__ __attribute__((aligned(16))) unsigned char lds[];
    cg::grid_group grid = cg::this_grid();
    const int G = gridDim.x, bx = blockIdx.x, ngw = G * NWAVES;
    unsigned char* ws = p.ws;
    bf16* WIN = (bf16*)(ws + WS_WIN); bf16* WOUT = (bf16*)(ws + WS_WOUT); bf16* WGU = (bf16*)(ws + WS_WGU); bf16* WDN = (bf16*)(ws + WS_WDN); bf16* WPW = (bf16*)(ws + WS_WPW);
    bf16* XN = (bf16*)(ws + WS_XN); bf16* PROJ = (bf16*)(ws + WS_PROJ); bf16* CAT = (bf16*)(ws + WS_CAT); bf16* HB = (bf16*)(ws + WS_H); bf16* CV = (bf16*)(ws + WS_CV);
    float* MIX = (float*)(ws + WS_MIX); unsigned long long* XSLOT = (unsigned long long*)(ws + WS_MIX + 48 * MiB); bf16* XB = (bf16*)(ws + WS_MIX + 16 * MiB);
    unsigned* CTL = (unsigned*)ws; f32x2* ROPE = (f32x2*)(ws + WS_ROPE);
    PG8_LAS unsigned char* ldsl = (PG8_LAS unsigned char*)lds;
    volatile LAS unsigned* bst = (volatile LAS unsigned*)(ldsl + LDS_BYTES - 16);
    if (threadIdx.x < 4) bst[threadIdx.x] = 0u;
    __syncthreads();
    const XcdBarrier xbar = xcd_barrier_post((unsigned*)ws, bst);

    for (int rp0 = 0; rp0 < REP_P0; ++rp0) {
        const int tid = opaque_tid(), lane = tid & 63, wave = __builtin_amdgcn_readfirstlane(tid >> 6), gw = bx * NWAVES + wave; (void)tid; (void)lane; (void)gw;
        LAS float* scr = (LAS float*)(ldsl + wave * 16384);
        for (int it = gw; it < ON_P0 * P0_ITEMS; it += ngw) { int cl, cr; p0_item(it, cl, cr); convert_item(p, ws, cl, cr, scr, lane); }
        for (int m = gw; m < M; m += ngw) { f32x4 v[8];
#pragma unroll
            for (int j = 0; j < 8; ++j) v[j] = __builtin_nontemporal_load((const f32x4*)(p.x + (size_t)m * DM + 4 * (lane + 64 * j)));
#pragma unroll
            for (int j = 0; j < 8; ++j) { v2u o; o.x = pk2(v[j].x, v[j].y); o.y = pk2(v[j].z, v[j].w); __builtin_nontemporal_store(o, (v2u*)(XB + (size_t)m * DM + 4 * (lane + 64 * j))); }
            norm_row_bf16(v, p.norm_mix_pre, XN + (size_t)m * DM, lane); }
    }
    if (G != 256) grid.sync(); else GSYNC();
    for (int es = 0; es < EXTRA_SYNC; ++es) GSYNC();

    for (int l = 0; l < DEPTH; ++l) {
        _Pragma("unroll") for (int rg = 0; rg < REP_GEMM; ++rg) { pg8::Gemm g{XN, WIN + (size_t)l * NIN * DM, M, NIN, DM}; pg8::StaticOrder S; S.init(M, NIN, G, bx);
          pg8::EpiProj E{PROJ, NIN, (const float*)ROPE, p.gqa_q_norm + l * 128, p.gqa_k_norm + l * 128, (PG8_LAS float*)(ldsl + 131072)};
          pg8::gemm_phase<pg8::EpiProj, pg8::StaticOrder, true, true>(ldsl, g, S, E); }
        tail_convert(p, ws, l == 0 ? 0 : 2, ldsl, bx);
        GSYNC();

        for (int rep3 = 0; rep3 < REP_S3; ++rep3) {
            const int tid = opaque_tid(), lane = tid & 63, wave = __builtin_amdgcn_readfirstlane(tid >> 6), gw = bx * NWAVES + wave; (void)tid; (void)lane; (void)gw;
            const float lam_init = l == 0 ? 0.2f : 0.35550906759096934f;
            float lam; { const float* lp = p.diff_lambda + l * 256; const float sa = wave_sum(lp[lane] * lp[64 + lane]), sb = wave_sum(lp[128 + lane] * lp[192 + lane]); lam = expf(sa) - expf(sb) + lam_init; }
            constexpr float C64 = 0.125f * 1.4426950408889634f, THR64 = att::THR / 0.125f;
            constexpr float SC128 = 0.08838834764831845f, C128 = SC128 * 1.4426950408889634f, THR128 = att::THR / SC128;
            const int r32 = lane & 31, hi = lane >> 5;
            unsigned* ccnt = CTL + 32768 + l * 2048;
            if (ON_CONV && bx >= 128) {
                for (int ci = 0; ci < 2; ++ci) { const int item = 2 * (bx - 128) + ci;
                    conv_tile(p, l, item, PROJ, CV, (LAS float*)(ldsl + 131072));
                    asm volatile("s_waitcnt vmcnt(0)" ::: "memory"); __syncthreads();
                    if (tid == 0) { __builtin_amdgcn_fence(__ATOMIC_RELEASE, "agent"); asm volatile("s_waitcnt vmcnt(0)" ::: "memory"); __hip_atomic_fetch_add(ccnt + 64 * (item >> 3), 1u, __ATOMIC_RELAXED, __HIP_MEMORY_SCOPE_AGENT); } }
            }
            for (int round = 0;; ++round) {
                const int pc = (round & 1) ? (round + 1) * G - 1 - bx : round * G + bx;
                if (pc >= 384) break;
                const int kind = pc >> 7, xq = bx & 7, b = xq >> 2, h = xq & 3, qb = (bx & 127) >> 3;
                const size_t rowq = (size_t)b * SEQ + qb * 256, rowk = (size_t)b * SEQ;
                att::f32x16 o[4];
                __syncthreads();
                if (ON_DIFF && kind == 0) {
                    att::attn_body<64, false, QL64, SD64>(PROJ + rowq * NIN + PA_Q + h * 128, PROJ + rowk * NIN + PA_K + h * 128, PROJ + rowk * NIN + PA_V + h * 128, SEQ / 64, (char*)lds, C64, THR64, o, 0, 0, 0, 0.f);
                    { const int t2 = opaque_tid(); v4u* STv = (v4u*)((char*)lds + 69632) + t2;
#pragma unroll
                      for (int k = 0; k < 8; ++k) { const int d = k >> 1, r0 = 8 * (k & 1); v4u w;
                          w.x = att::cvtpk(o[d][r0], o[d][r0 + 1]); w.y = att::cvtpk(o[d][r0 + 2], o[d][r0 + 3]); w.z = att::cvtpk(o[d][r0 + 4], o[d][r0 + 5]); w.w = att::cvtpk(o[d][r0 + 6], o[d][r0 + 7]);
                          STv[k * 512] = w; } }
                    att::attn_body<64, false, QL64, SD64>(PROJ + rowq * NIN + PA_Q + h * 128 + 64, PROJ + rowk * NIN + PA_K + h * 128 + 64, PROJ + rowk * NIN + PA_V + h * 128, SEQ / 64, (char*)lds, C64, THR64, o, 0, 0, 0, 0.f);
                    { const int t3 = opaque_tid(), l3 = t3 & 63, r32 = l3 & 31; const v4u* STv = (const v4u*)((char*)lds + 69632) + t3;
                      const float* sg = p.diff_subln + l * 128;
                      float gsub[4], ss[16];
#pragma unroll
                      for (int d = 0; d < 4; ++d) gsub[d] = sg[32 * d + r32] * (1.0f - lam_init);
#pragma unroll
                      for (int r = 0; r < 16; ++r) ss[r] = 0.f;
#pragma unroll
                      for (int k = 0; k < 8; ++k) { const int d = k >> 1, r0 = 8 * (k & 1); const v4u w = STv[k * 512];
#pragma unroll
                          for (int i = 0; i < 4; ++i) { const unsigned wi = i == 0 ? w.x : (i == 1 ? w.y : (i == 2 ? w.z : w.w));
                              const float va = bf2f((unsigned short)(wi & 0xffffu)) - lam * o[d][r0 + 2 * i], vb = bf2f((unsigned short)(wi >> 16)) - lam * o[d][r0 + 2 * i + 1];
                              o[d][r0 + 2 * i] = va; o[d][r0 + 2 * i + 1] = vb; ss[r0 + 2 * i] += va * va; ss[r0 + 2 * i + 1] += vb * vb; } }
#pragma unroll
                      for (int r = 0; r < 16; ++r) { float q = ss[r]; q += __shfl_xor(q, 1); q += __shfl_xor(q, 2); q += __shfl_xor(q, 4); q += __shfl_xor(q, 8); q += __shfl_xor(q, 16);
                          const float rstd = 1.0f / sqrtf(q * (1.0f / 128.0f) + EPS);
#pragma unroll
                          for (int d = 0; d < 4; ++d) o[d][r] *= rstd * gsub[d]; } }
                    store_o_bf16(o, CAT + rowq * DM + h * 128, lds);
                } else if (ON_GQA && kind == 1) {
                    att::attn_body<128, false, QL128, SD128>(PROJ + rowq * NIN + PC_Q + h * 128, PROJ + rowk * NIN + PC_K + (h >> 1) * 128, PROJ + rowk * NIN + PC_V + (h >> 1) * 128, SEQ / 64, (char*)lds, C128, THR128, o, 0, 0, 0, 0.f);
                    store_o_bf16(o, CAT + rowq * DM + 1024 + h * 128, lds);
                } else if (ON_NA) {
                    { const float* rsrc = p.na_rpb + (size_t)(l * 4 + h) * 465; float* rdst = (float*)((char*)lds + att::RPB_OFF); for (int e = tid; e < 465; e += NTHR) rdst[e] = rsrc[e]; }
                    int krow0 = 4 * qb - 4; krow0 = krow0 < 0 ? 0 : (krow0 > 52 ? 52 : krow0);
                    const size_t rowkn = rowk + (size_t)krow0 * 64;
                    att::attn_body<128, true, QL128, SDNA>(PROJ + rowq * NIN + PD_Q + h * 128, PROJ + rowkn * NIN + PD_K + h * 128, PROJ + rowkn * NIN + PD_V + h * 128, 12, (char*)lds, C128, THR128, o,
                                              krow0, 4 * qb + (wave >> 1), (wave & 1) * 32 + r32, 11.313708498984761f);
                    store_o_bf16(o, CAT + rowq * DM + 1536 + h * 128, lds);
                }
            }
            __syncthreads();
            if (G - 1 - bx < 64) {
                if (tid == 0) { unsigned sp = 0; while (__hip_atomic_load(ccnt + 64 * ((G - 1 - bx) >> 1), __ATOMIC_RELAXED, __HIP_MEMORY_SCOPE_AGENT) < 8u) { __builtin_amdgcn_s_sleep(2); if (++sp > (1u << 24)) break; }
                    __builtin_amdgcn_fence(__ATOMIC_ACQUIRE, "agent"); asm volatile("s_waitcnt vmcnt(0)" ::: "memory"); }
                __syncthreads();
            }
            { pg8::Gemm g{CV, WPW + (size_t)l * CC * CC, M, CC, CC}; pg8::StrideOrder S{G - 1 - bx, G, 64, 2};
              pg8::EpiBf16<0> E{CAT + 512, DM, p.conv_pw_b + l * CC, 0, 0, 1.f};
              pg8::gemm_phase<pg8::EpiBf16<0>, pg8::StrideOrder, true, true>(ldsl, g, S, E); }
        }
        GSYNC();

        { pg8::Gemm g{CAT, WOUT + (size_t)l * DM * DM, M, DM, DM}; pg8::StaticOrder S; S.init(M, DM, G, bx);
          pg8::EpiRmsFused E{XB, nullptr, XB, XN, p.norm_mix_post + l * DM, p.norm_ffn_pre + l * DM, XSLOT + (size_t)(l * 2 + 0) * 131072, CTL + 16384 + (l * 2 + 0) * 2048};
          pg8::gemm_phase<pg8::EpiRmsFused, pg8::StaticOrder, false, true>(ldsl, g, S, E); }
        GSYNC();
        _Pragma("unroll") for (int rg = 0; rg < REP_GEMM; ++rg) { pg8::Gemm g{XN, WGU + (size_t)l * 2 * FF * DM, M, 2 * FF, DM}; pg8::StaticOrder S; S.init(M, 2 * FF, G, bx);
          pg8::EpiSwiGLU E{HB, FF};
          pg8::gemm_phase<pg8::EpiSwiGLU, pg8::StaticOrder, true, true>(ldsl, g, S, E); }
        tail_convert(p, ws, l == 0 ? 1 : 3, ldsl, bx);
        GSYNC();
        { pg8::Gemm g{HB, WDN + (size_t)l * DM * FF, M, DM, FF}; pg8::StaticOrder S; S.init(M, DM, G, bx);
          pg8::EpiRmsFused E{XB, l + 1 < DEPTH ? nullptr : p.out, XB, XN, p.norm_ffn_post + l * DM, l + 1 < DEPTH ? p.norm_mix_pre + (l + 1) * DM : nullptr, XSLOT + (size_t)(l * 2 + 1) * 131072, CTL + 16384 + (l * 2 + 1) * 2048};
          pg8::gemm_phase<pg8::EpiRmsFused, pg8::StaticOrder, false, true>(ldsl, g, S, E); }
        if (l + 1 < DEPTH) GSYNC();
    }
}

extern "C" void kernel_launch(void* const* d_in, const int* in_sizes, int n_in, void* d_out, int out_size, void* d_ws, size_t ws_size, hipStream_t stream) {
    static int grid = 0;
    if (grid == 0) {
        if (n_in != 21 || out_size != M * DM || ws_size < WS_END) { fprintf(stderr, "kernel_launch: unexpected shapes: n_in %d out %d ws %zu (need %zu)\n", n_in, out_size, ws_size, (size_t)WS_END); grid = -1; return; }
        int dev = 0, cus = 0, per_cu = 0;
        if (hipGetDevice(&dev) != hipSuccess || hipDeviceGetAttribute(&cus, hipDeviceAttributeMultiprocessorCount, dev) != hipSuccess) { fprintf(stderr, "kernel_launch: device query failed\n"); grid = -1; return; }
        if (hipFuncSetAttribute((const void*)mega_fwd, hipFuncAttributeMaxDynamicSharedMemorySize, LDS_BYTES) != hipSuccess) { fprintf(stderr, "kernel_launch: hipFuncSetAttribute failed\n"); grid = -1; return; }
        if (hipOccupancyMaxActiveBlocksPerMultiprocessor(&per_cu, (const void*)mega_fwd, NTHR, LDS_BYTES) != hipSuccess || per_cu < 1) { fprintf(stderr, "kernel_launch: occupancy query says %d\n", per_cu); (void)hipGetLastError(); per_cu = 1; }
        grid = cus * per_cu;
        if (grid < 256) { fprintf(stderr, "kernel_launch: needs 256 co-resident workgroups, device offers %d\n", grid); grid = -1; return; }
        grid = 256;
    }
    if (grid < 0) return;
    if (hipMemsetAsync(d_ws, 0, 196608, stream) != hipSuccess) { fprintf(stderr, "kernel_launch: memset failed\n"); return; }
    Params p{};
    const float** pp = (const float**)&p;
    for (int i = 0; i < 21; ++i) pp[i] = (const float*)d_in[i];
    p.out = (float*)d_out; p.ws = (unsigned char*)d_ws;
    void* args[] = {&p};
    hipError_t e = hipLaunchCooperativeKernel((const void*)mega_fwd, dim3(grid), dim3(NTHR), args, LDS_BYTES, stream);
    if (e != hipSuccess) fprintf(stderr, "cooperative launch failed: %s (grid %d)\n", hipGetErrorString(e), grid);
}
```
